# Optimizing an MI355X kernel written in HIP

```python
import jax, jax.numpy as jnp
from jax import lax
import numpy as np

D_MODEL = 1024
BATCH = 32
SEQ = 2048
DEPTH = 1

GRID_W = 64
CTX_LEN = 256
MLA_HEADS = 8
QK_NOPE = 64
QK_ROPE = 32
QK_HEAD = QK_NOPE + QK_ROPE
V_HEAD = 64
Q_LORA = 256
KV_LORA = 128
AXIS_DIM = QK_ROPE // 2
ROPE_BASE = 10000.0
Q_BLOCK = 128
MLA_WIDTH = MLA_HEADS * V_HEAD
GMLP_GROUPS = 8
GMLP_GROUP_DIM = 64
GMLP_WIDTH = GMLP_GROUPS * GMLP_GROUP_DIM
CHUNK = 128
D_MIX = MLA_WIDTH + GMLP_WIDTH
KV_COLS = KV_LORA + QK_ROPE
Q_START = KV_COLS
U_START = KV_COLS + Q_LORA
V_START = U_START + GMLP_WIDTH
IN_COLS = V_START + GMLP_WIDTH
D_FF = 2816
N_MOD = 9
EPS = 1e-6

kernel_name = "hymba_mla_gmlp_macaron_dit_layer"


def rms_norm(x, w):
    xf = x.astype(jnp.float32)
    y = xf * lax.rsqrt(jnp.mean(xf * xf, axis=-1, keepdims=True) + EPS)
    return (y * w.astype(jnp.float32)).astype(x.dtype)


def modulate(h, shift, scale):
    return h * (1 + scale) + shift


def swiglu(h, w1, w3, w2):
    return (jax.nn.silu(h @ w1) * (h @ w3)) @ w2


def ffn_sublayer(h_in, shift, scale, gate, norm_w, w1, w3, w2):
    h = modulate(rms_norm(h_in, norm_w), shift, scale)
    return h_in + 0.5 * gate * swiglu(h, w1, w3, w2)


def axial_rope(x, cos, sin):
    xr = x.reshape(x.shape[:-1] + (2, 2, AXIS_DIM // 2))
    rot = jnp.stack([-xr[..., 1, :], xr[..., 0, :]], axis=-2).reshape(x.shape)
    return x * cos[:, None, :] + rot * sin[:, None, :]


def rope_part(x, rope):
    if rope is None:
        return x
    return jnp.concatenate([x[..., :QK_NOPE], axial_rope(x[..., QK_NOPE:], *rope)], axis=-1)


def mla_keys_values(kv_proj, kv_a_norm_w, w_ukv, k_norm_w, rope):
    B, S, _ = kv_proj.shape
    c_kv = rms_norm(kv_proj[..., :KV_LORA], kv_a_norm_w)
    k_pe = kv_proj[..., KV_LORA:]
    kv = (c_kv @ w_ukv).reshape(B, S, MLA_HEADS, QK_NOPE + V_HEAD)
    k_nope, v = kv[..., :QK_NOPE], kv[..., QK_NOPE:]
    k_pe = jnp.broadcast_to(k_pe[:, :, None, :], (B, S, MLA_HEADS, QK_ROPE))
    k = rms_norm(jnp.concatenate([k_nope, k_pe], axis=-1), k_norm_w)
    return rope_part(k, rope), v


def mla_queries(q_proj, q_a_norm_w, w_uq, q_norm_w, rope):
    B, S, _ = q_proj.shape
    c_q = rms_norm(q_proj, q_a_norm_w)
    q = (c_q @ w_uq).reshape(B, S, MLA_HEADS, QK_HEAD)
    return rope_part(rms_norm(q, q_norm_w), rope)


def block_attention(q, k_all, v_all):
    B, S, H, Dk = q.shape
    nb = S // Q_BLOCK
    scale = Dk ** -0.5
    qb = jnp.moveaxis(q.reshape(B, nb, Q_BLOCK, H, Dk), 1, 0)

    def one_block(q_blk):
        s = jnp.einsum('bqhd,bkhd->bhqk', q_blk, k_all).astype(jnp.float32) * scale
        p = jax.nn.softmax(s, axis=-1).astype(v_all.dtype)
        return jnp.einsum('bhqk,bkhd->bqhd', p, v_all)

    out = lax.map(one_block, qb)
    return jnp.moveaxis(out, 0, 1).reshape(B, S, H * V_HEAD)


def chunk_gmlp(u, v, v_norm_w, w_s, b_s):
    B, S, _ = u.shape
    n = S // CHUNK
    u = jax.nn.gelu(u).reshape(B, n, CHUNK, GMLP_GROUPS, GMLP_GROUP_DIM)
    v = rms_norm(jax.nn.gelu(v).reshape(B, n, CHUNK, GMLP_GROUPS, GMLP_GROUP_DIM), v_norm_w)
    s = jnp.einsum('gpq,bnqgc->bnpgc', w_s, v) + b_s.T[:, :, None]
    return (u * s).reshape(B, S, GMLP_WIDTH)


def token_mix(proj, k_all, v_all, rope, q_a_norm_w, w_uq, q_norm_w, v_norm_w, w_s, b_s, w_out):
    q = mla_queries(proj[..., Q_START:U_START], q_a_norm_w, w_uq, q_norm_w, rope)
    attn = block_attention(q, k_all, v_all)
    sg = chunk_gmlp(proj[..., U_START:V_START], proj[..., V_START:], v_norm_w, w_s, b_s)
    return jnp.concatenate([attn, sg], axis=-1) @ w_out


def hybrid_layer(x, ctx, c, c_ctx, cos, sin,
                 w_ada, b_ada, norm1_w, ffn1_w1, ffn1_w3, ffn1_w2,
                 norm2_w, w_in, q_a_norm_w, w_uq, kv_a_norm_w, w_ukv, q_norm_w, k_norm_w,
                 v_norm_w, w_s, b_s, w_out,
                 norm3_w, ffn2_w1, ffn2_w3, ffn2_w2, update_ctx):
    mx = jnp.split((jax.nn.silu(c) @ w_ada + b_ada)[:, None, :], N_MOD, axis=-1)
    mc = jnp.split((jax.nn.silu(c_ctx) @ w_ada + b_ada)[None, None, :], N_MOD, axis=-1)
    rope = (cos, sin)

    x = ffn_sublayer(x, mx[0], mx[1], mx[2], norm1_w, ffn1_w1, ffn1_w3, ffn1_w2)
    ctx = ffn_sublayer(ctx, mc[0], mc[1], mc[2], norm1_w, ffn1_w1, ffn1_w3, ffn1_w2)

    proj = modulate(rms_norm(x, norm2_w), mx[3], mx[4]) @ w_in
    hc = modulate(rms_norm(ctx, norm2_w), mc[3], mc[4])
    proj_c = hc @ (w_in if update_ctx else w_in[:, :KV_COLS])
    k_lat, v_lat = mla_keys_values(proj[..., :KV_COLS], kv_a_norm_w, w_ukv, k_norm_w, rope)
    k_ctx, v_ctx = mla_keys_values(proj_c[..., :KV_COLS], kv_a_norm_w, w_ukv, k_norm_w, None)
    k_all = jnp.concatenate([k_lat, k_ctx], axis=1)
    v_all = jnp.concatenate([v_lat, v_ctx], axis=1)
    x = x + mx[5] * token_mix(proj, k_all, v_all, rope, q_a_norm_w, w_uq, q_norm_w,
                              v_norm_w, w_s, b_s, w_out)
    if update_ctx:
        ctx = ctx + mc[5] * token_mix(proj_c, k_ctx, v_ctx, None, q_a_norm_w, w_uq, q_norm_w,
                                      v_norm_w, w_s, b_s, w_out)
        ctx = ffn_sublayer(ctx, mc[6], mc[7], mc[8], norm3_w, ffn2_w1, ffn2_w3, ffn2_w2)

    x = ffn_sublayer(x, mx[6], mx[7], mx[8], norm3_w, ffn2_w1, ffn2_w3, ffn2_w2)
    return x, ctx


def setup_inputs(seed: int = 0) -> dict:
    key = jax.random.key(seed)
    ks = jax.random.split(key, 26)
    f32 = jnp.float32

    def dense(k, shape, fan_in, gain=1.0):
        return jax.random.normal(k, shape, f32) * (gain * fan_in ** -0.5)

    def gain_vec(k, shape):
        return 1.0 + 0.02 * jax.random.normal(k, shape, f32)

    L = DEPTH
    return {
        "x": jax.random.normal(ks[0], (BATCH, SEQ, D_MODEL), f32),
        "c": jax.random.normal(ks[1], (BATCH, D_MODEL), f32),
        "ctx": jax.random.normal(ks[2], (BATCH, CTX_LEN, D_MODEL), f32),
        "c_ctx": jax.random.normal(ks[3], (D_MODEL,), f32),
        "w_ada": dense(ks[4], (L, D_MODEL, N_MOD * D_MODEL), D_MODEL, 0.5),
        "b_ada": 0.02 * jax.random.normal(ks[5], (L, N_MOD * D_MODEL), f32),
        "norm1_w": gain_vec(ks[6], (L, D_MODEL)),
        "ffn1_w1": dense(ks[7], (L, D_MODEL, D_FF), D_MODEL),
        "ffn1_w3": dense(ks[8], (L, D_MODEL, D_FF), D_MODEL),
        "ffn1_w2": dense(ks[9], (L, D_FF, D_MODEL), D_FF),
        "norm2_w": gain_vec(ks[10], (L, D_MODEL)),
        "w_in": dense(ks[11], (L, D_MODEL, IN_COLS), D_MODEL),
        "q_a_norm_w": gain_vec(ks[12], (L, Q_LORA)),
        "w_uq": dense(ks[13], (L, Q_LORA, MLA_HEADS * QK_HEAD), Q_LORA),
        "kv_a_norm_w": gain_vec(ks[14], (L, KV_LORA)),
        "w_ukv": dense(ks[15], (L, KV_LORA, MLA_HEADS * (QK_NOPE + V_HEAD)), KV_LORA),
        "q_norm_w": gain_vec(ks[16], (L, QK_HEAD)),
        "k_norm_w": gain_vec(ks[17], (L, QK_HEAD)),
        "v_norm_w": gain_vec(ks[18], (L, GMLP_GROUPS, GMLP_GROUP_DIM)),
        "w_s": dense(ks[19], (L, GMLP_GROUPS, CHUNK, CHUNK), CHUNK),
        "b_s": gain_vec(ks[20], (L, GMLP_GROUPS, CHUNK)),
        "w_out": dense(ks[21], (L, D_MIX, D_MODEL), D_MIX),
        "norm3_w": gain_vec(ks[22], (L, D_MODEL)),
        "ffn2_w1": dense(ks[23], (L, D_MODEL, D_FF), D_MODEL),
        "ffn2_w3": dense(ks[24], (L, D_MODEL, D_FF), D_MODEL),
        "ffn2_w2": dense(ks[25], (L, D_FF, D_MODEL), D_FF),
    }


def reference(x, c, ctx, c_ctx, w_ada, b_ada, norm1_w, ffn1_w1, ffn1_w3, ffn1_w2,
              norm2_w, w_in, q_a_norm_w, w_uq, kv_a_norm_w, w_ukv, q_norm_w, k_norm_w,
              v_norm_w, w_s, b_s, w_out, norm3_w, ffn2_w1, ffn2_w3, ffn2_w2):
    S = x.shape[1]
    ROWS = S // GRID_W
    f32 = jnp.float32
    rows = jnp.repeat(jnp.arange(ROWS, dtype=f32), GRID_W)
    cols = jnp.tile(jnp.arange(GRID_W, dtype=f32), ROWS)
    inv = ROPE_BASE ** (-jnp.arange(0, AXIS_DIM, 2, dtype=f32) / AXIS_DIM)
    ang_r = rows[:, None] * inv
    ang_c = cols[:, None] * inv
    ang = jnp.concatenate([ang_r, ang_r, ang_c, ang_c], axis=-1)
    cos = jnp.cos(ang).astype(x.dtype)
    sin = jnp.sin(ang).astype(x.dtype)

    layer_weights = (w_ada, b_ada, norm1_w, ffn1_w1, ffn1_w3, ffn1_w2,
                     norm2_w, w_in, q_a_norm_w, w_uq, kv_a_norm_w, w_ukv, q_norm_w, k_norm_w,
                     v_norm_w, w_s, b_s, w_out, norm3_w, ffn2_w1, ffn2_w3, ffn2_w2)
    for i in range(DEPTH):
        x, ctx = hybrid_layer(x, ctx, c, c_ctx, cos, sin, *[w[i] for w in layer_weights],
                              update_ctx=i < DEPTH - 1)
    return x
```

```cpp
#include <hip/hip_runtime.h>
#include <hip/hip_cooperative_groups.h>
#include <cstdio>
#include <cstdint>
namespace cg = cooperative_groups;

#ifndef MK_ONE_LAUNCH
#define MK_ONE_LAUNCH 1
#endif

#define LAS __attribute__((address_space(3)))
typedef unsigned short bf16_t;
typedef short bf16x8 __attribute__((ext_vector_type(8)));
typedef float f32x4 __attribute__((ext_vector_type(4)));
typedef float f32x16 __attribute__((ext_vector_type(16)));
typedef unsigned u32x4 __attribute__((ext_vector_type(4)));
typedef unsigned u32x2 __attribute__((ext_vector_type(2)));

constexpr int DM = 1024, NB = 32, SEQ = 2048, CTXL = 256, DFF = 2816;
constexpr int MX = NB * SEQ;
constexpr int MC = NB * CTXL;
constexpr int MT = MX + MC;
constexpr int NMOD = 9 * DM;
constexpr int NPROJ = 1536;
constexpr int NH = 8, DQK = 96, DV = 64;
constexpr float EPS = 1e-6f;
constexpr float QSCALE = 0.10206207261596577f * 1.4426950408889634f;

constexpr size_t MiB = 1u << 20;
constexpr size_t WS_MOD = 1 * MiB, WS_RSQ = 3 * MiB, WS_RSKV = 3 * MiB + 512 * 1024;
constexpr size_t WS_W13A = 4 * MiB, WS_W2A = 15 * MiB, WS_W13B = 21 * MiB, WS_W2B = 32 * MiB, WS_WIN = 38 * MiB;
constexpr size_t WS_WUQ = 41 * MiB, WS_WK = 41 * MiB + 512 * 1024, WS_WV = 41 * MiB + 768 * 1024, WS_WOUT = 42 * MiB, WS_WS = 44 * MiB;
constexpr size_t WS_X1C = 46 * MiB, WS_H = 80 * MiB, WS_ACT = 224 * MiB;
constexpr size_t WS_PROJ = 224 * MiB, WS_QRAW = 440 * MiB, WS_KNOPE = 536 * MiB;
constexpr size_t WS_KF = 620 * MiB, WS_VT = 728 * MiB, WS_END = 800 * MiB;
constexpr size_t WS_MIX = WS_H;
constexpr size_t WS_SWIN = 44 * MiB + 512 * 1024, WS_SW13 = 45 * MiB, WS_SS2 = 78 * MiB, WS_SS3 = 78 * MiB + 512 * 1024;
constexpr size_t WS_H3 = WS_KF;

constexpr int LDS_BYTES = 147456;

__device__ __forceinline__ unsigned pk2(float lo, float hi) {
    typedef float f2 __attribute__((ext_vector_type(2))); typedef __bf16 b2 __attribute__((ext_vector_type(2)));
    f2 v = {lo, hi}; b2 b = __builtin_convertvector(v, b2); return __builtin_bit_cast(unsigned, b);
}
__device__ __forceinline__ float bflo(unsigned w) { return __uint_as_float(w << 16); }
__device__ __forceinline__ float bfhi(unsigned w) { return __uint_as_float(w & 0xffff0000u); }
__device__ __forceinline__ float fexp2(float x) { return __builtin_amdgcn_exp2f(x); }
__device__ __forceinline__ float frcp(float x) { return __builtin_amdgcn_rcpf(x); }
__device__ __forceinline__ float silu_f(float a) { return a * frcp(1.f + fexp2(-1.4426950408889634f * a)); }
__device__ __forceinline__ float gelu_f(float x) { const float y = 0.7978845608028654f * (x + 0.044715f * x * x * x); return x * frcp(1.f + fexp2(-2.8853900817779268f * y)); }
__device__ __forceinline__ float wave_sum(float v) {
#pragma unroll
    for (int o = 1; o < 64; o <<= 1) v += __shfl_xor(v, o);
    return v;
}
#define LDS_WAIT() asm volatile("s_waitcnt lgkmcnt(0)" ::: "memory")

namespace pg8 {
constexpr int BM = 256, BK = 64, HALF = 128, HTB = HALF * BK * 2, STAGE_BYTES = 8 * HTB, NXCD = 8, WGM = 2;
__host__ __device__ __forceinline__ int lds_byte(int r, int c) { const int st = (r >> 4) * 2 + (c >> 5), rr = r & 15, cc = c & 31, ob = rr * 64 + cc * 2; return st * 1024 + (ob ^ (((ob >> 9) & 1) << 5)); }
__host__ __device__ __forceinline__ void stage_rc(int b, int& R, int& C) { const int st = b / 1024, sb = b % 1024, swz = sb ^ (((sb >> 9) & 1) << 5); R = (st >> 1) * 16 + swz / 64; C = (st & 1) * 32 + (swz % 64) / 2; }
__host__ __device__ __forceinline__ int perm32(int rho) { const int n = rho >> 4, i = rho & 15; return 8 * (i >> 2) + 4 * n + (i & 3); }

struct Unit { int pm, pn; };
struct Gemm { const bf16_t* A; const bf16_t* Bt; int M, N, K, lda, ldb; };

struct StaticOrder {
    int nM, nN, nwg, G, c;
    __device__ void init(int M, int N, int G_, int c_) { nM = M / BM; nN = N / BM; nwg = nM * nN; G = G_; c = c_; }
    __device__ bool next(int i, Unit& u) const {
        const long L = (long)i * G + c; if (L >= nwg) return false;
        int wgid = (int)L; { const int q = nwg / NXCD, r = nwg % NXCD, xcd = wgid % NXCD, off = wgid / NXCD; wgid = (xcd < r ? xcd * (q + 1) : r * (q + 1) + (xcd - r) * q) + off; }
        const int nig = WGM * nN, gid = wgid / nig, fm = gid * WGM, gsz = (nM - fm) < WGM ? (nM - fm) : WGM;
        u.pm = fm + ((wgid % nig) % gsz); u.pn = (wgid % nig) / gsz; return true;
    }
};

template <bool NORM, bool TILED = true> struct EpiSwigluT {
    static constexpr bool PERM = true;
    bf16_t* O; int ldc; const float* SSn; const float* cb;
    __device__ __forceinline__ void operator()(const f32x4 (&acc)[2][2][4][2], const Unit& u, int wr, int wc, int fr, int fq) const {
        const int row0 = u.pm * BM + wr * 64 + fr, col0 = u.pn * HALF + wc * 32 + 8 * fq;
        f32x4 cv[2][2];
        if (NORM) {
            const float* cbp = cb + (size_t)(u.pm >> 3) * (2 * DFF) + u.pn * BM + wc * 32 + 8 * fq;
#pragma unroll
            for (int bj = 0; bj < 2; ++bj)
#pragma unroll
                for (int n = 0; n < 2; ++n) cv[bj][n] = *(const f32x4*)(cbp + bj * HALF + 4 * n);
        }
#pragma unroll
        for (int ai = 0; ai < 2; ++ai)
#pragma unroll
            for (int m = 0; m < 4; ++m) {
                const int row = row0 + ai * HALF + m * 16;
                bf16_t* rowp = TILED ? O + ((size_t)((row >> 4) * (ldc >> 5) + (col0 >> 5)) * 512 + (row & 15) * 32 + (col0 & 31)) : O + (size_t)row * ldc + col0;
                f32x4 a0 = acc[ai][0][m][0], a1 = acc[ai][0][m][1], b0 = acc[ai][1][m][0], b1 = acc[ai][1][m][1];
                if (NORM) { const float r = rsqrtf(SSn[row] * (1.f / DM) + EPS); a0 = a0 * r + cv[0][0]; a1 = a1 * r + cv[0][1]; b0 = b0 * r + cv[1][0]; b1 = b1 * r + cv[1][1]; }
                u32x4 w;
                w.x = pk2(silu_f(a0[0]) * b0[0], silu_f(a0[1]) * b0[1]); w.y = pk2(silu_f(a0[2]) * b0[2], silu_f(a0[3]) * b0[3]);
                w.z = pk2(silu_f(a1[0]) * b1[0], silu_f(a1[1]) * b1[1]); w.w = pk2(silu_f(a1[2]) * b1[2], silu_f(a1[3]) * b1[3]);
                *(u32x4*)rowp = w;
            }
    }
};
template <int ctx_tile0, int COEF2, bool NORM> struct EpiRes {
    static constexpr bool PERM = true;
    const float* bx; const float* bc; float* ox; float* oc; const float* gate;
    const float* nw; const float* nscale; bf16_t* Hn; float* SS;
    __device__ __forceinline__ void operator()(const f32x4 (&acc)[2][2][4][2], const Unit& u, int wr, int wc, int fr, int fq) const {
        asm volatile("" : "+v"(fr), "+v"(fq));
        const bool isc = u.pm >= ctx_tile0;
        const int mrow = isc ? 32 : (u.pm >> 3);
        const int prow = isc ? (u.pm - ctx_tile0) : u.pm;
        const float* base = isc ? bc : bx; float* out = isc ? oc : ox;
        const int col0 = u.pn * BM + wc * 32 + 8 * fq;
        f32x4 gv[2][2], G[2][2]; float ssv[2][4];
#pragma unroll
        for (int bj = 0; bj < 2; ++bj)
#pragma unroll
            for (int n = 0; n < 2; ++n) { const int c = col0 + bj * HALF + 4 * n; gv[bj][n] = *(const f32x4*)(gate + (size_t)mrow * NMOD + c) * (0.5f * COEF2);
                if (NORM) G[bj][n] = *(const f32x4*)(nw + c) * (*(const f32x4*)(nscale + (size_t)mrow * NMOD + c) + 1.f); }
#pragma unroll
        for (int ai = 0; ai < 2; ++ai)
#pragma unroll
            for (int m = 0; m < 4; ++m) {
                const int rl = ai * HALF + wr * 64 + m * 16 + fr;
                const size_t off = (size_t)(prow * BM + rl) * DM + col0;
                const size_t hrow = (size_t)u.pm * BM + rl;
                float ss = 0.f;
#pragma unroll
                for (int bj = 0; bj < 2; ++bj) {
                    const f32x4 o0 = *(const f32x4*)(base + off + bj * HALF) + gv[bj][0] * acc[ai][bj][m][0];
                    const f32x4 o1 = *(const f32x4*)(base + off + bj * HALF + 4) + gv[bj][1] * acc[ai][bj][m][1];
                    if (!isc) { *(f32x4*)(out + off + bj * HALF) = o0; *(f32x4*)(out + off + bj * HALF + 4) = o1; }
                    if (NORM) {
                        ss += (o0[0] * o0[0] + o0[1] * o0[1]) + (o0[2] * o0[2] + o0[3] * o0[3]) + (o1[0] * o1[0] + o1[1] * o1[1]) + (o1[2] * o1[2] + o1[3] * o1[3]);
                        const f32x4 h0 = o0 * G[bj][0], h1 = o1 * G[bj][1];
                        u32x4 w; w.x = pk2(h0[0], h0[1]); w.y = pk2(h0[2], h0[3]); w.z = pk2(h1[0], h1[1]); w.w = pk2(h1[2], h1[3]);
                        *(u32x4*)(Hn + hrow * DM + col0 + bj * HALF) = w;
                    }
                }
                if (NORM) { ss += __shfl_xor(ss, 16); ss += __shfl_xor(ss, 32); ssv[ai][m] = ss; }
            }
        if (NORM) {
            asm volatile("" ::: "memory");
#pragma unroll
            for (int ai = 0; ai < 2; ++ai)
#pragma unroll
                for (int m = 0; m < 4; ++m)
                    if (fq == 0) __hip_atomic_fetch_add(SS + (size_t)u.pm * BM + ai * HALF + wr * 64 + m * 16 + fr, ssv[ai][m], __ATOMIC_RELAXED, __HIP_MEMORY_SCOPE_AGENT);
        }
    }
};
struct EpiBf16S {
    static constexpr bool PERM = true;
    bf16_t* O; int ldc; const float* rs; const float* cs; const float* SSn; const float* cb; int ldcb; int mrow_fixed;
    __device__ __forceinline__ void operator()(const f32x4 (&acc)[2][2][4][2], const Unit& u, int wr, int wc, int fr, int fq) const {
        const int row0 = u.pm * BM + wr * 64 + fr, col0 = u.pn * BM + wc * 32 + 8 * fq;
        const int mrow = mrow_fixed >= 0 ? mrow_fixed : (u.pm >> 3);
        f32x4 cv[2][2], bv[2][2];
#pragma unroll
        for (int bj = 0; bj < 2; ++bj)
#pragma unroll
            for (int n = 0; n < 2; ++n) { cv[bj][n] = cs ? *(const f32x4*)(cs + col0 + bj * HALF + 4 * n) : (f32x4){1.f, 1.f, 1.f, 1.f};
                bv[bj][n] = cb ? *(const f32x4*)(cb + (size_t)mrow * ldcb + col0 + bj * HALF + 4 * n) : (f32x4){0.f, 0.f, 0.f, 0.f}; }
#pragma unroll
        for (int ai = 0; ai < 2; ++ai)
#pragma unroll
            for (int m = 0; m < 4; ++m) {
                const int row = row0 + ai * HALF + m * 16;
                const float r = SSn ? rsqrtf(SSn[row] * (1.f / DM) + EPS) : (rs ? rs[row] : 1.f);
                bf16_t* rowp = O + (size_t)row * ldc + col0;
#pragma unroll
                for (int bj = 0; bj < 2; ++bj) {
                    const f32x4 v0 = acc[ai][bj][m][0] * cv[bj][0] * r + bv[bj][0], v1 = acc[ai][bj][m][1] * cv[bj][1] * r + bv[bj][1];
                    u32x4 w; w.x = pk2(v0[0], v0[1]); w.y = pk2(v0[2], v0[3]); w.z = pk2(v1[0], v1[1]); w.w = pk2(v1[2], v1[3]);
                    *(u32x4*)(rowp + bj * HALF) = w;
                }
            }
    }
};

template <class Epi, class Sched, bool TILEDA = false>
__device__ __forceinline__ void gemm_phase(LAS unsigned char* lds, const Gemm g, const Sched& S, const Epi& E) {
    const int tid = threadIdx.x, wid = __builtin_amdgcn_readfirstlane(tid >> 6), lane = tid & 63, wr = wid >> 2, wc = wid & 3, fr = lane & 15, fq = lane >> 4;
    const int K = g.K, nt = K / BK;
    unsigned voffA[2], voffB[2];
#pragma unroll
    for (int i = 0; i < 2; ++i) { int R, C; stage_rc(tid * 16 + i * 8192, R, C); const int Rb = Epi::PERM ? ((R & ~31) + perm32(R & 31)) : R;
        voffA[i] = TILEDA ? (unsigned)(((R >> 4) * (g.lda >> 5) + (C >> 5)) * 1024 + (R & 15) * 64 + (C & 31) * 2) : (unsigned)(R * g.lda + C) * 2u;
        voffB[i] = (unsigned)(Rb * g.ldb + C) * 2u; }
    const size_t kstep = (size_t)(BK * 2), kstepA = TILEDA ? (size_t)2048 : kstep;
    const size_t hA = TILEDA ? (size_t)(HALF / 16) * (g.lda >> 5) * 1024 : (size_t)HALF * g.lda * 2, hB = (size_t)HALF * g.ldb * 2;
    const size_t tA = 2 * hA, tB = 2 * hB;
    const unsigned ldsw = (unsigned)wid * 1024u;
    const int aoff = lds_byte(wr * 64 + fr, fq * 8), boff = lds_byte(wc * 32 + fr, fq * 8);
#define PG8_SA(b, h) (((b) * 2 + (h)) * HTB)
#define PG8_SB(b, h) ((4 + (b) * 2 + (h)) * HTB)
#define PG8_STAGE(bufoff, gbase, voff) do { _Pragma("unroll") for (int _i = 0; _i < 2; ++_i) \
        __builtin_amdgcn_global_load_lds((const unsigned*)((const char*)(gbase) + (voff)[_i]), (LAS unsigned*)(lds + (bufoff) + ldsw + _i * 8192), 16, 0, 0); } while (0)
#define PG8_LDA(dst, b, h) do { _Pragma("unroll") for (int m = 0; m < 4; ++m) _Pragma("unroll") for (int k = 0; k < 2; ++k) dst[m][k] = *(const LAS bf16x8*)(lds + PG8_SA(b, h) + aoff + m * 2048 + k * 1024); } while (0)
#define PG8_LDB(dst, b, h) do { _Pragma("unroll") for (int n = 0; n < 2; ++n) _Pragma("unroll") for (int k = 0; k < 2; ++k) dst[n][k] = *(const LAS bf16x8*)(lds + PG8_SB(b, h) + boff + n * 2048 + k * 1024); } while (0)
#define PG8_MMA(ai, bj, At, Bt) do { __builtin_amdgcn_s_setprio(1); _Pragma("unroll") for (int m = 0; m < 4; ++m) _Pragma("unroll") for (int n = 0; n < 2; ++n) _Pragma("unroll") for (int k = 0; k < 2; ++k) \
        acc[ai][bj][m][n] = __builtin_amdgcn_mfma_f32_16x16x32_bf16(Bt[n][k], At[m][k], acc[ai][bj][m][n], 0, 0, 0); __builtin_amdgcn_s_setprio(0); } while (0)
#define PG8_WAIT_V(n) asm volatile("s_waitcnt vmcnt(" #n ")" ::: "memory")
#define PG8_WAIT_L(n) asm volatile("s_waitcnt lgkmcnt(" #n ")" ::: "memory")
#define PG8_BAR __builtin_amdgcn_s_barrier()
#define PG8_SCHED __builtin_amdgcn_sched_barrier(0)
    Unit cur, nxt; int ui = 0;
    if (!S.next(0, cur)) return;
    f32x4 acc[2][2][4][2];
#pragma unroll
    for (int a = 0; a < 2; ++a)
#pragma unroll
        for (int b = 0; b < 2; ++b)
#pragma unroll
            for (int m = 0; m < 4; ++m)
#pragma unroll
                for (int n = 0; n < 2; ++n) acc[a][b][m][n] = (f32x4){0.f, 0.f, 0.f, 0.f};
    bf16x8 At[4][2], B0[2][2], B1[2][2];
    const char* cA = (const char*)g.A + (size_t)cur.pm * tA; const char* cB = (const char*)g.Bt + (size_t)cur.pn * tB;
    PG8_STAGE(PG8_SB(0, 0), cB, voffB); PG8_STAGE(PG8_SB(0, 1), cB + hB, voffB); PG8_STAGE(PG8_SA(0, 0), cA, voffA); PG8_STAGE(PG8_SA(0, 1), cA + hA, voffA);
    if (wr == 1) PG8_BAR;
    PG8_WAIT_V(2); PG8_BAR;
    PG8_STAGE(PG8_SB(1, 0), cB + kstep, voffB); PG8_STAGE(PG8_SA(1, 0), cA + kstepA, voffA); PG8_STAGE(PG8_SB(1, 1), cB + hB + kstep, voffB);
    PG8_WAIT_V(6); PG8_BAR;
    for (;;) {
        const bool has_next = S.next(ui + 1, nxt);
        const char* nA = has_next ? (const char*)g.A + (size_t)nxt.pm * tA : cA; const char* nB = has_next ? (const char*)g.Bt + (size_t)nxt.pn * tB : cB;
        for (int t = 0; t < nt; t += 2) {
            const bool last = (t == nt - 2);
            const char* a1 = cA + (size_t)(t + 1) * kstepA;
            const char* a2 = last ? nA : cA + (size_t)(t + 2) * kstepA; const char* b2 = last ? nB : cB + (size_t)(t + 2) * kstep;
            const char* a3 = a2 + kstepA; const char* b3 = b2 + kstep;
            PG8_LDB(B0, 0, 0); PG8_LDB(B1, 0, 1); PG8_SCHED; PG8_LDA(At, 0, 0); PG8_STAGE(PG8_SA(1, 1), a1 + hA, voffA);
            PG8_WAIT_V(8); PG8_WAIT_L(0); PG8_BAR; PG8_MMA(0, 0, At, B0); PG8_MMA(0, 1, At, B1); PG8_BAR; PG8_SCHED;
            PG8_LDA(At, 0, 1); PG8_STAGE(PG8_SB(0, 0), b2, voffB); PG8_STAGE(PG8_SB(0, 1), b2 + hB, voffB); PG8_STAGE(PG8_SA(0, 0), a2, voffA);
            PG8_WAIT_V(8); PG8_WAIT_L(0); PG8_BAR; PG8_MMA(1, 0, At, B0); PG8_MMA(1, 1, At, B1); PG8_BAR; PG8_SCHED;
            PG8_LDB(B0, 1, 0); PG8_LDB(B1, 1, 1); PG8_SCHED; PG8_LDA(At, 1, 0); PG8_STAGE(PG8_SA(0, 1), a2 + hA, voffA);
            PG8_WAIT_V(8); PG8_WAIT_L(0); PG8_BAR; PG8_MMA(0, 0, At, B0); PG8_MMA(0, 1, At, B1); PG8_BAR; PG8_SCHED;
            PG8_LDA(At, 1, 1); PG8_STAGE(PG8_SB(1, 0), b3, voffB); PG8_STAGE(PG8_SB(1, 1), b3 + hB, voffB); PG8_STAGE(PG8_SA(1, 0), a3, voffA);
            PG8_WAIT_V(8); PG8_WAIT_L(0); PG8_BAR; PG8_MMA(1, 0, At, B0); PG8_MMA(1, 1, At, B1); PG8_BAR; PG8_SCHED;
        }
        if (wr == 0) PG8_BAR;
        E(acc, cur, wr, wc, fr, fq);
        if (!has_next) break;
#pragma unroll
        for (int a = 0; a < 2; ++a)
#pragma unroll
            for (int b = 0; b < 2; ++b)
#pragma unroll
                for (int m = 0; m < 4; ++m)
#pragma unroll
                    for (int n = 0; n < 2; ++n) acc[a][b][m][n] = (f32x4){0.f, 0.f, 0.f, 0.f};
        cur = nxt; cA = nA; cB = nB; ++ui;
        if (wr == 1) PG8_BAR;
    }
    PG8_WAIT_V(0);
    PG8_BAR;
#undef PG8_SA
#undef PG8_SB
#undef PG8_STAGE
#undef PG8_LDA
#undef PG8_LDB
#undef PG8_MMA
#undef PG8_WAIT_V
#undef PG8_WAIT_L
#undef PG8_BAR
#undef PG8_SCHED
}
}

struct Params {
    const float *x, *c, *ctx, *cctx, *w_ada, *b_ada, *norm1, *f1w1, *f1w3, *f1w2, *norm2, *w_in, *qan, *w_uq, *kvan, *w_ukv, *qn, *kn, *vn, *w_s, *b_s, *w_out, *norm3, *f2w1, *f2w3, *f2w2;
    float* out; unsigned char* ws; int ph_lo, ph_hi;
};

__device__ __forceinline__ void tr_item(const float* W, int N, int k0, int n0, bf16_t* dst, int ldd, const float* kscale, float* scr, int lane) {
#pragma unroll 8
    for (int i = 0; i < 32; ++i) { const int kk = 2 * i + (lane >> 5); float v = W[(size_t)(k0 + kk) * N + n0 + (lane & 31)]; if (kscale) v *= kscale[k0 + kk]; scr[kk * 33 + (lane & 31)] = v; }
    LDS_WAIT();
    const int c = lane & 7;
#pragma unroll
    for (int j = 0; j < 4; ++j) { const int n = (lane >> 3) + 8 * j; const float* s = scr + (8 * c) * 33 + n;
        u32x4 o; o.x = pk2(s[0 * 33], s[1 * 33]); o.y = pk2(s[2 * 33], s[3 * 33]); o.z = pk2(s[4 * 33], s[5 * 33]); o.w = pk2(s[6 * 33], s[7 * 33]);
        *(u32x4*)(dst + (size_t)n * ldd + 8 * c) = o; }
    LDS_WAIT();
}
__device__ __forceinline__ int win_row(int n) {
    if (n < 128) return 256 + n;
    if (n < 160) return 384 + (n - 128);
    if (n < 416) return n - 160;
    if (n < 928) return 512 + (n - 416);
    return 1024 + (n - 928);
}
template <bool SILU>
__device__ __forceinline__ void rowmat_item(const float* in, int istr, const float* in32, const float* W, int N, int j, const float* bias, float* out, int ldo, int cmap, float* lds, int tid) {
    const int wave = tid >> 6, lane = tid & 63, col = 64 * j + lane; const bool cok = col < N; const int colc = cok ? col : N - 1;
    float acc[33];
#pragma unroll
    for (int r = 0; r < 33; ++r) acc[r] = 0.f;
    for (int pass = 0; pass < 2; ++pass) {
        __syncthreads();
        {
            float cvv[33];
#pragma unroll
            for (int r = 0; r < 33; ++r) cvv[r] = (r < 32) ? in[(size_t)r * istr + 512 * pass + tid] : in32[512 * pass + tid];
#pragma unroll
            for (int r = 0; r < 33; ++r) lds[r * 512 + tid] = SILU ? cvv[r] / (1.f + __expf(-cvv[r])) : cvv[r];
        }
        __syncthreads();
        const int kb = 512 * pass + 64 * wave;
        const float* Wc = W + (size_t)kb * N + colc;
        float w0 = Wc[0], w1 = Wc[(size_t)N], w2 = Wc[(size_t)2 * N], w3 = Wc[(size_t)3 * N];
        float x0 = Wc[(size_t)4 * N], x1 = Wc[(size_t)5 * N], x2 = Wc[(size_t)6 * N], x3 = Wc[(size_t)7 * N];
        for (int k4 = 0; k4 < 16; ++k4) {
            const int kn = (k4 + 2 < 16) ? 4 * (k4 + 2) : 0;
            const float y0 = Wc[(size_t)(kn + 0) * N], y1 = Wc[(size_t)(kn + 1) * N], y2 = Wc[(size_t)(kn + 2) * N], y3 = Wc[(size_t)(kn + 3) * N];
#pragma unroll
            for (int r = 0; r < 33; ++r) { const f32x4 s = *(const f32x4*)(lds + r * 512 + 64 * wave + 4 * k4); acc[r] += s[0] * w0 + s[1] * w1 + s[2] * w2 + s[3] * w3; }
            w0 = x0; w1 = x1; w2 = x2; w3 = x3; x0 = y0; x1 = y1; x2 = y2; x3 = y3;
        }
    }
    __syncthreads();
#pragma unroll
    for (int r = 0; r < 33; ++r) lds[(wave * 33 + r) * 64 + lane] = acc[r];
    __syncthreads();
    for (int idx = tid; idx < 33 * 64; idx += 512) { const int r = idx >> 6, l = idx & 63, c = 64 * j + l; float s = 0.f;
#pragma unroll
        for (int w = 0; w < 8; ++w) s += lds[(w * 33 + r) * 64 + l];
        if (c < N) { const int oc = cmap == 0 ? c : cmap == 1 ? win_row(c) : (256 * (c >> 7) + (c & 127) + (cmap == 3 ? 128 : 0));
            out[(size_t)r * ldo + oc] = s + (bias ? bias[c] : 0.f); } }
    __syncthreads();
}
constexpr int I_UP = 16 * 88, I_DN = 44 * 32, I_IN = 16 * 45, I_UQ = 4 * 24, I_UKV = 2 * 32, I_OUT = 16 * 32;
constexpr int NITEMS = 4 * I_UP + 2 * I_DN + I_IN + I_UQ + I_UKV + I_OUT;
__device__ __forceinline__ void tr_dispatch(const Params& p, int it, float* scr, int lane) {
    unsigned char* ws = p.ws;
    int r = it;
    if (r < 4 * I_UP) { const int which = r / I_UP; r -= which * I_UP; const int kb = r / 88, nb = r % 88, k0 = 64 * kb, n0 = 32 * nb;
        const float* W = which == 0 ? p.f1w1 : which == 1 ? p.f1w3 : which == 2 ? p.f2w1 : p.f2w3;
        bf16_t* D = (bf16_t*)(ws + (which < 2 ? WS_W13A : WS_W13B));
        const int row = 256 * (n0 >> 7) + (n0 & 127) + ((which & 1) ? 128 : 0);
        tr_item(W, DFF, k0, n0, D + (size_t)row * DM + k0, DM, nullptr, scr, lane); return; }
    r -= 4 * I_UP;
    if (r < 2 * I_DN) { const int which = r / I_DN; r -= which * I_DN; const int kb = r / 32, nb = r % 32, k0 = 64 * kb, n0 = 32 * nb;
        tr_item(which ? p.f2w2 : p.f1w2, DM, k0, n0, (bf16_t*)(ws + (which ? WS_W2B : WS_W2A)) + (size_t)n0 * DFF + k0, DFF, nullptr, scr, lane); return; }
    r -= 2 * I_DN;
    if (r < I_IN) { const int kb = r / 45, nb = r % 45, k0 = 64 * kb, n0 = 32 * nb;
        tr_item(p.w_in, 1440, k0, n0, (bf16_t*)(ws + WS_WIN) + (size_t)win_row(n0) * DM + k0, DM, nullptr, scr, lane); return; }
    r -= I_IN;
    if (r < I_UQ) { const int kb = r / 24, nb = r % 24, k0 = 64 * kb, n0 = 32 * nb;
        tr_item(p.w_uq, 768, k0, n0, (bf16_t*)(ws + WS_WUQ) + (size_t)n0 * 256 + k0, 256, p.qan, scr, lane); return; }
    r -= I_UQ;
    if (r < I_UKV) { const int kb = r / 32, nb = r % 32, k0 = 64 * kb, n0 = 32 * nb; const int h = n0 >> 7, j = n0 & 127;
        bf16_t* D = (j < 64) ? (bf16_t*)(ws + WS_WK) + (size_t)(h * 64 + j) * 256 : (bf16_t*)(ws + WS_WV) + (size_t)(h * 64 + j - 64) * 256;
        tr_item(p.w_ukv, 1024, k0, n0, D + k0, 256, p.kvan, scr, lane); return; }
    r -= I_UKV;
    { const int kb = r / 32, nb = r % 32, k0 = 64 * kb, n0 = 32 * nb;
        tr_item(p.w_out, DM, k0, n0, (bf16_t*)(ws + WS_WOUT) + (size_t)n0 * DM + k0, DM, nullptr, scr, lane); }
}
__device__ __forceinline__ void tr_set(const Params& p, int set, int widx, int nw, float* scr, int lane, int j0 = 0, int j1 = 1 << 30) {
    const int nall = set == 1 ? (I_IN + I_UQ + I_UKV + I_OUT) : (2 * I_UP + I_DN); const int n = j1 < nall ? j1 : nall;
    for (int j = j0 + widx; j < n; j += nw) {
        const int it = set == 0 ? (j < 2 * I_UP ? j : 4 * I_UP + (j - 2 * I_UP))
                     : set == 1 ? (4 * I_UP + 2 * I_DN + j)
                     : (j < 2 * I_UP ? 2 * I_UP + j : 4 * I_UP + I_DN + (j - 2 * I_UP));
        tr_dispatch(p, it, scr, lane);
    }
}
__device__ __forceinline__ void phase0(const Params& p, float* lds) {
    unsigned char* ws = p.ws;
    const int tid = threadIdx.x, lane = tid & 63, wave = tid >> 6, G = gridDim.x;
    float* MOD = (float*)(ws + WS_MOD);
    if ((int)blockIdx.x < 144) rowmat_item<true>(p.c, DM, p.cctx, p.w_ada, NMOD, blockIdx.x, p.b_ada, MOD, NMOD, 0, lds, tid);
    {
        const int gt = blockIdx.x * 512 + tid, NT = G * 512;
        { f32x4* zs = (f32x4*)(ws + WS_SWIN); for (int i = gt; i < 33 * NPROJ / 4; i += NT) zs[i] = (f32x4){0.f, 0.f, 0.f, 0.f}; }
        { f32x4* zs = (f32x4*)(ws + WS_SS2); for (int i = gt; i < MT / 4; i += NT) zs[i] = (f32x4){0.f, 0.f, 0.f, 0.f}; }
        { f32x4* zs = (f32x4*)(ws + WS_SS3); for (int i = gt; i < MX / 4; i += NT) zs[i] = (f32x4){0.f, 0.f, 0.f, 0.f}; }
        u32x4* z0 = (u32x4*)((bf16_t*)(ws + WS_WIN) + (size_t)416 * 1024);
        for (int i = gt; i < 96 * 1024 / 8; i += NT) z0[i] = (u32x4){0u, 0u, 0u, 0u};
        for (int i = gt; i < 512 * 16; i += NT) { const int r = i >> 4, cpart = i & 15;
            *(u32x4*)((bf16_t*)(ws + WS_WK) + (size_t)r * 256 + 128 + cpart * 8) = (u32x4){0u, 0u, 0u, 0u};
            *(u32x4*)((bf16_t*)(ws + WS_WV) + (size_t)r * 256 + 128 + cpart * 8) = (u32x4){0u, 0u, 0u, 0u}; }
        for (int i = gt; i < 8 * 128 * 128 / 8; i += NT) { const f32x4 a = *(const f32x4*)(p.w_s + (size_t)i * 8), b = *(const f32x4*)(p.w_s + (size_t)i * 8 + 4);
            u32x4 o; o.x = pk2(a[0], a[1]); o.y = pk2(a[2], a[3]); o.z = pk2(b[0], b[1]); o.w = pk2(b[2], b[3]); *(u32x4*)((bf16_t*)(ws + WS_WS) + (size_t)i * 8) = o; }
    }
    if (G > 144) { if ((int)blockIdx.x >= 144) tr_set(p, 0, ((int)blockIdx.x - 144) * 8 + wave, (G - 144) * 8, lds + wave * 4096, lane, 1152);
                   else tr_set(p, 0, (int)blockIdx.x * 8 + wave, 1152, lds + wave * 4096, lane, 0, 1152); }
    else tr_set(p, 0, blockIdx.x * 8 + wave, G * 8, lds + wave * 4096, lane);
    __syncthreads();
}

__device__ __forceinline__ void norm_mod_phase(const float* srcx, const float* srcc, int nrows, const float* w, const float* MOD, int ishift, bf16_t* H) {
    const int tid = threadIdx.x, lane = tid & 63, wave = tid >> 6;
    const int gw = blockIdx.x * 8 + wave, NGW = gridDim.x * 8, nch = nrows / 8;
    for (int ch = gw; ch < nch; ch += NGW) {
        const int row0 = ch * 8; const bool isc = row0 >= MX; const int mrow = isc ? 32 : (row0 >> 11);
        const float* src = isc ? srcc + (size_t)(row0 - MX) * DM : srcx + (size_t)row0 * DM;
        const float* sh = MOD + (size_t)mrow * NMOD + ishift * DM; const float* sc = sh + DM;
        f32x4 g[4], s[4];
#pragma unroll
        for (int j = 0; j < 4; ++j) { const int c = 4 * lane + 256 * j; const f32x4 wv = *(const f32x4*)(w + c), scv = *(const f32x4*)(sc + c); g[j] = wv * (scv + 1.f); s[j] = *(const f32x4*)(sh + c); }
        f32x4 nx[4];
#pragma unroll
        for (int j = 0; j < 4; ++j) nx[j] = ((const f32x4*)src + lane)[64 * j];
        for (int rr = 0; rr < 8; ++rr) {
            f32x4 v[4]; float ss = 0.f;
#pragma unroll
            for (int j = 0; j < 4; ++j) v[j] = nx[j];
            if (rr < 7) { const f32x4* xr = (const f32x4*)(src + (size_t)(rr + 1) * DM) + lane;
#pragma unroll
                for (int j = 0; j < 4; ++j) nx[j] = xr[64 * j]; }
#pragma unroll
            for (int j = 0; j < 4; ++j) ss += (v[j][0] * v[j][0] + v[j][1] * v[j][1]) + (v[j][2] * v[j][2] + v[j][3] * v[j][3]);
            const float rstd = rsqrtf(wave_sum(ss) * (1.f / DM) + EPS);
            u32x2* o = (u32x2*)(H + (size_t)(row0 + rr) * DM) + lane;
#pragma unroll
            for (int j = 0; j < 4; ++j) { const f32x4 y = v[j] * rstd * g[j] + s[j]; u32x2 ov; ov.x = pk2(y[0], y[1]); ov.y = pk2(y[2], y[3]); o[64 * j] = ov; }
        }
    }
}

__device__ __forceinline__ void rstd_phase(const bf16_t* PROJ, float* RSQ, float* RSKV) {
    const int tid = threadIdx.x, lane = tid & 63, wave = tid >> 6;
    const int gw = blockIdx.x * 8 + wave, NGW = gridDim.x * 8;
    for (int r4 = gw; r4 < MT / 4; r4 += NGW) {
        unsigned kv[4]; u32x2 q[4];
#pragma unroll
        for (int i = 0; i < 4; ++i) { const int row = 4 * r4 + i; const bf16_t* pr = PROJ + (size_t)row * NPROJ;
            kv[i] = *((const unsigned*)(pr + 256) + lane); q[i] = (row < MX) ? *((const u32x2*)pr + lane) : (u32x2){0u, 0u}; }
#pragma unroll
        for (int i = 0; i < 4; ++i) { const int row = 4 * r4 + i;
            float s2 = bflo(kv[i]) * bflo(kv[i]) + bfhi(kv[i]) * bfhi(kv[i]);
            float s1 = (bflo(q[i].x) * bflo(q[i].x) + bfhi(q[i].x) * bfhi(q[i].x)) + (bflo(q[i].y) * bflo(q[i].y) + bfhi(q[i].y) * bfhi(q[i].y));
            s2 = wave_sum(s2); s1 = wave_sum(s1);
            if (lane == 0) { RSKV[row] = rsqrtf(s2 * (1.f / 128.f) + EPS); if (row < MX) RSQ[row] = rsqrtf(s1 * (1.f / 256.f) + EPS); } }
    }
}

__device__ __forceinline__ void gmlp_phase(const Params& p, unsigned char* lds) {
    unsigned char* ws = p.ws;
    const bf16_t* PROJ = (const bf16_t*)(ws + WS_PROJ); const bf16_t* WSb = (const bf16_t*)(ws + WS_WS); bf16_t* MIX = (bf16_t*)(ws + WS_MIX);
    const int tid = threadIdx.x, lane = tid & 63, wave = tid >> 6, r32 = lane & 31, hi = lane >> 5;
    bf16_t* Vt = (bf16_t*)lds;
    const int pp = tid >> 2, cp = tid & 3;
    const int c0 = 32 * (wave >> 2), p0 = 32 * (wave & 3), pos = p0 + r32;
    u32x4 va, vb2;
    constexpr int NU = NB * 16 * 8;
    const bool bal = gridDim.x == 256;
    const int ubase = bal ? ((int)blockIdx.x < 64 ? (int)blockIdx.x * 13 : 832 + ((int)blockIdx.x - 64) * 17) : (int)blockIdx.x;
    const int ustep = bal ? 1 : (int)gridDim.x;
    const int uend = bal ? ubase + ((int)blockIdx.x < 64 ? 13 : 17) : NU;
    { const int unit = ubase; if (unit < uend) { const int g = unit & 7, n = (unit >> 3) & 15, b = unit >> 7;
        const bf16_t* src0 = PROJ + ((size_t)b * SEQ + n * 128 + pp) * NPROJ + 1024 + 64 * g + 16 * cp; va = *(const u32x4*)src0; vb2 = *(const u32x4*)(src0 + 8); } }
    for (int unit = ubase; unit < uend; unit += ustep) {
        const int g = unit & 7, n = (unit >> 3) & 15, b = unit >> 7;
        const size_t r0 = (size_t)b * SEQ + n * 128;
        bf16x8 wf[8];
        const bf16_t* wrow = WSb + ((size_t)g * 128 + pos) * 128 + 8 * hi;
#pragma unroll
        for (int s = 0; s < 8; ++s) wf[s] = *(const bf16x8*)(wrow + 16 * s);
        const bf16_t* urow = PROJ + (r0 + pos) * NPROJ + 512 + 64 * g + c0 + 4 * hi;
        u32x2 uu[4];
#pragma unroll
        for (int q = 0; q < 4; ++q) uu[q] = *(const u32x2*)(urow + 8 * q);
        const float bias = p.b_s[g * 128 + pos];
        f32x4 vw[4];
#pragma unroll
        for (int i = 0; i < 4; ++i) vw[i] = *(const f32x4*)(p.vn + 64 * g + 16 * cp + 4 * i);
        {
            float v[16];
            v[0] = bflo(va.x); v[1] = bfhi(va.x); v[2] = bflo(va.y); v[3] = bfhi(va.y); v[4] = bflo(va.z); v[5] = bfhi(va.z); v[6] = bflo(va.w); v[7] = bfhi(va.w);
            v[8] = bflo(vb2.x); v[9] = bfhi(vb2.x); v[10] = bflo(vb2.y); v[11] = bfhi(vb2.y); v[12] = bflo(vb2.z); v[13] = bfhi(vb2.z); v[14] = bflo(vb2.w); v[15] = bfhi(vb2.w);
            float ss = 0.f;
#pragma unroll
            for (int i = 0; i < 16; ++i) { v[i] = gelu_f(v[i]); ss += v[i] * v[i]; }
            ss += __shfl_xor(ss, 1); ss += __shfl_xor(ss, 2);
            const float rstd = rsqrtf(ss * (1.f / 64.f) + EPS);
#pragma unroll
            for (int i = 0; i < 16; ++i) { const int c = 16 * cp + i; const float y = v[i] * rstd * vw[i >> 2][i & 3]; Vt[c * 136 + pp] = (bf16_t)(pk2(y, 0.f) & 0xffffu); }
        }
        {
            const int un = unit + ustep; if (un < uend) { const int g2 = un & 7, n2 = (un >> 3) & 15, b2 = un >> 7;
                const bf16_t* src0 = PROJ + ((size_t)b2 * SEQ + n2 * 128 + pp) * NPROJ + 1024 + 64 * g2 + 16 * cp; va = *(const u32x4*)src0; vb2 = *(const u32x4*)(src0 + 8); } }
        __syncthreads();
        {
            f32x16 acc = {};
            const bf16_t* vrow = Vt + (c0 + r32) * 136 + 8 * hi;
#pragma unroll
            for (int s = 0; s < 8; ++s) { const bf16x8 av = *(const bf16x8*)(vrow + 16 * s);
                acc = __builtin_amdgcn_mfma_f32_32x32x16_bf16(av, wf[s], acc, 0, 0, 0); }
            bf16_t* orow = MIX + (r0 + pos) * DM + 512 + 64 * g + c0 + 4 * hi;
#pragma unroll
            for (int q = 0; q < 4; ++q) {
                const float o0 = gelu_f(bflo(uu[q].x)) * (acc[4 * q + 0] + bias), o1 = gelu_f(bfhi(uu[q].x)) * (acc[4 * q + 1] + bias);
                const float o2 = gelu_f(bflo(uu[q].y)) * (acc[4 * q + 2] + bias), o3 = gelu_f(bfhi(uu[q].y)) * (acc[4 * q + 3] + bias);
                u32x2 ov; ov.x = pk2(o0, o1); ov.y = pk2(o2, o3); *(u32x2*)(orow + 8 * q) = ov; }
        }
        __syncthreads();
    }
}

__device__ __forceinline__ void unpack8(float* v, const u32x4 a) { v[0] = bflo(a.x); v[1] = bfhi(a.x); v[2] = bflo(a.y); v[3] = bfhi(a.y); v[4] = bflo(a.z); v[5] = bfhi(a.z); v[6] = bflo(a.w); v[7] = bfhi(a.w); }
__device__ __forceinline__ u32x4 pack8(const float* v) { u32x4 o; o.x = pk2(v[0], v[1]); o.y = pk2(v[2], v[3]); o.z = pk2(v[4], v[5]); o.w = pk2(v[6], v[7]); return o; }
__device__ __forceinline__ float rope_inv(int f) { return f == 0 ? 1.0f : f == 1 ? 0.316227766f : f == 2 ? 0.1f : f == 3 ? 0.0316227766f : f == 4 ? 0.01f : f == 5 ? 0.00316227766f : f == 6 ? 0.001f : 0.000316227766f; }
__device__ __forceinline__ void kprep_phase(const Params& p) {
    unsigned char* ws = p.ws;
    const bf16_t* KN = (const bf16_t*)(ws + WS_KNOPE); const bf16_t* PROJ = (const bf16_t*)(ws + WS_PROJ); bf16_t* KF = (bf16_t*)(ws + WS_KF);
    const int tid = threadIdx.x, lane = tid & 63, wave = tid >> 6, h = lane >> 3, j = lane & 7;
    const int gw = blockIdx.x * 8 + wave, NGW = gridDim.x * 8;
    float wn[8], wp[8];
#pragma unroll
    for (int i = 0; i < 8; ++i) { wn[i] = p.kn[8 * j + i]; wp[i] = p.kn[64 + 8 * (j & 3) + i]; }
    u32x4 na = {}, ne = {};
    if (gw < MT) { na = *(const u32x4*)(KN + (size_t)gw * 512 + h * 64 + 8 * j); ne = *(const u32x4*)(PROJ + (size_t)gw * NPROJ + 384 + 8 * (j & 3)); }
    for (int row = gw; row < MT; row += NGW) {
        float a[8], e[8];
        unpack8(a, na); unpack8(e, ne);
        { const int rn = row + NGW; if (rn < MT) { na = *(const u32x4*)(KN + (size_t)rn * 512 + h * 64 + 8 * j); ne = *(const u32x4*)(PROJ + (size_t)rn * NPROJ + 384 + 8 * (j & 3)); } }
        float ss = 0.f;
#pragma unroll
        for (int i = 0; i < 8; ++i) ss += a[i] * a[i];
        if (j < 4) {
#pragma unroll
            for (int i = 0; i < 8; ++i) ss += e[i] * e[i];
        }
        ss += __shfl_xor(ss, 1); ss += __shfl_xor(ss, 2); ss += __shfl_xor(ss, 4);
        const float rs = rsqrtf(ss * (1.f / 96.f) + EPS);
#pragma unroll
        for (int i = 0; i < 8; ++i) { a[i] *= rs * wn[i]; e[i] *= rs * wp[i]; }
        bf16_t* ko = KF + (size_t)row * 768 + h * 96;
        *(u32x4*)(ko + 8 * j) = pack8(a);
        const bool lat = row < MX; const int pos = row & (SEQ - 1);
        const float fpos = (float)(((j >> 1) & 1) ? (pos & 63) : (pos >> 6));
#pragma unroll
        for (int f = 0; f < 8; ++f) {
            const float partner = __shfl_xor(e[f], 1);
            float sn = 0.f, cs = 1.f;
            if (lat) { const float rev = (fpos * rope_inv(f)) * 0.15915494309189535f; sn = __builtin_amdgcn_sinf(rev); cs = __builtin_amdgcn_cosf(rev); }
            e[f] = e[f] * cs + ((j & 1) ? partner : -partner) * sn;
        }
        if (j < 4) *(u32x4*)(ko + 64 + 8 * j) = pack8(e);
    }
}

constexpr int KSTR = 208, VSTR = 144, KBUF = 64 * KSTR, VBUF = 64 * VSTR;
__device__ __forceinline__ float max3f(float a, float b, float c) { float r; asm("v_max3_f32 %0, %1, %2, %3" : "=v"(r) : "v"(a), "v"(b), "v"(c)); return r; }
__device__ __forceinline__ float swapmax(float m) { auto rr = __builtin_amdgcn_permlane32_swap(__float_as_uint(m), __float_as_uint(m), false, false); return fmaxf(__uint_as_float(rr[0]), __uint_as_float(rr[1])); }
__device__ __forceinline__ float swapadd(float m) { auto rr = __builtin_amdgcn_permlane32_swap(__float_as_uint(m), __float_as_uint(m), false, false); return __uint_as_float(rr[0]) + __uint_as_float(rr[1]); }
#define ASB() __builtin_amdgcn_sched_barrier(0)
struct AttStage { u32x4 k0, k1, v; };
struct AttCtx {
    const bf16_t* KF; const bf16_t* VT; unsigned char* Ks; unsigned char* Vs;
    int tid, b, h, kkey0, kpart0, kkey1, kpart1, vd, vpart, vdst, koff, voff;
};
__device__ __forceinline__ void att_load(const AttCtx& c, int t, AttStage& s) {
    const size_t kr = (t < 32) ? (size_t)c.b * SEQ + t * 64 : (size_t)MX + (size_t)c.b * CTXL + (t - 32) * 64;
    s.k0 = *(const u32x4*)(c.KF + (kr + c.kkey0) * 768 + c.h * 96 + 8 * c.kpart0);
    if (c.tid < 256) s.k1 = *(const u32x4*)(c.KF + (kr + c.kkey1) * 768 + c.h * 96 + 8 * c.kpart1);
    s.v = *(const u32x4*)(c.VT + (size_t)(c.h * 64 + c.vd) * MT + kr + 8 * c.vpart);
}
__device__ __forceinline__ void att_store(const AttCtx& c, int kbuf, int vbuf, const AttStage& s) {
    *(u32x4*)(c.Ks + kbuf * KBUF + c.kkey0 * KSTR + c.kpart0 * 16) = s.k0;
    if (c.tid < 256) *(u32x4*)(c.Ks + kbuf * KBUF + c.kkey1 * KSTR + c.kpart1 * 16) = s.k1;
    *(u32x2*)(c.Vs + vbuf * VBUF + c.vdst) = (u32x2){s.v.x, s.v.y}; *(u32x2*)(c.Vs + vbuf * VBUF + c.vdst + 16) = (u32x2){s.v.z, s.v.w};
}
#define LDK(s_, A, C) do { A = *(const bf16x8*)(kb + (s_) * 32); C = *(const bf16x8*)(kb + 32 * KSTR + (s_) * 32); } while (0)
#define LDV(s_, A, C) do { A = *(const bf16x8*)(vb + (s_) * 32); C = *(const bf16x8*)(vb + 32 * VSTR + (s_) * 32); } while (0)
#define MMA(Acc, A, B) Acc = __builtin_amdgcn_mfma_f32_32x32x16_bf16(A, B, Acc, 0, 0, 0)
#define EXP4(V, i) do { V[i] = fexp2(V[i]); V[i + 1] = fexp2(V[i + 1]); V[i + 2] = fexp2(V[i + 2]); V[i + 3] = fexp2(V[i + 3]); } while (0)
__device__ __forceinline__ void att_iter(const AttCtx& c, int t, int& vcur, const bf16x8 (&qf)[6], f32x16& s0, f32x16& s1, f32x16& o0, f32x16& o1, float& mref, float& lsum, AttStage& L, const AttStage& S) {
    const bool more = t < 36;
    if (t + 2 < 36) att_load(c, t + 2, L);
    const unsigned char* kb = c.Ks + (t & 1) * KBUF + c.koff;
    const unsigned char* vb = c.Vs + vcur * VBUF + c.voff;
    f32x16 n0 = {}, n1 = {};
    u32x4 pw0, pw1, pw2, pw3;
    bf16x8 ka0, kc0, ka1, kc1, va0, vc0, va1, vc1;
    LDK(0, ka0, kc0);
    ASB();
    LDK(1, ka1, kc1);
    if (more) MMA(n0, ka0, qf[0]);
    float ma = max3f(s0[0], s0[1], s0[2]); ma = max3f(ma, s0[3], s0[4]); ma = max3f(ma, s0[5], s0[6]); ma = max3f(ma, s0[7], s0[8]);
    ASB();
    if (more) MMA(n1, kc0, qf[0]);
    ma = max3f(ma, s0[9], s0[10]); ma = max3f(ma, s0[11], s0[12]); ma = max3f(ma, s0[13], s0[14]); ma = fmaxf(ma, s0[15]);
    ASB();
    LDK(2, ka0, kc0);
    if (more) MMA(n0, ka1, qf[1]);
    float mb = max3f(s1[0], s1[1], s1[2]); mb = max3f(mb, s1[3], s1[4]); mb = max3f(mb, s1[5], s1[6]); mb = max3f(mb, s1[7], s1[8]);
    ASB();
    if (more) MMA(n1, kc1, qf[1]);
    mb = max3f(mb, s1[9], s1[10]); mb = max3f(mb, s1[11], s1[12]); mb = max3f(mb, s1[13], s1[14]); mb = max3f(mb, s1[15], ma);
    const float mx = swapmax(mb);
    if (__any(mx > mref + 8.f)) {
        const float mn = fmaxf(mref, mx), alpha = fexp2(mref - mn); mref = mn; lsum *= alpha;
#pragma unroll
        for (int r = 0; r < 16; ++r) { o0[r] *= alpha; o1[r] *= alpha; }
    }
    ASB();
    LDK(3, ka1, kc1);
    if (more) MMA(n0, ka0, qf[2]);
    s0 = s0 - mref; EXP4(s0, 0);
    ASB();
    if (more) MMA(n1, kc0, qf[2]);
    EXP4(s0, 4);
    pw0 = (u32x4){pk2(s0[0], s0[1]), pk2(s0[2], s0[3]), pk2(s0[4], s0[5]), pk2(s0[6], s0[7])};
    ASB();
    LDK(4, ka0, kc0);
    if (more) MMA(n0, ka1, qf[3]);
    EXP4(s0, 8);
    ASB();
    if (more) MMA(n1, kc1, qf[3]);
    EXP4(s0, 12);
    pw1 = (u32x4){pk2(s0[8], s0[9]), pk2(s0[10], s0[11]), pk2(s0[12], s0[13]), pk2(s0[14], s0[15])};
    ASB();
    LDK(5, ka1, kc1);
    if (more) MMA(n0, ka0, qf[4]);
    s1 = s1 - mref; EXP4(s1, 0);
    ASB();
    if (more) MMA(n1, kc0, qf[4]);
    EXP4(s1, 4);
    pw2 = (u32x4){pk2(s1[0], s1[1]), pk2(s1[2], s1[3]), pk2(s1[4], s1[5]), pk2(s1[6], s1[7])};
    ASB();
    LDV(0, va0, vc0);
    if (more) MMA(n0, ka1, qf[5]);
    EXP4(s1, 8);
    ASB();
    if (more) MMA(n1, kc1, qf[5]);
    EXP4(s1, 12);
    pw3 = (u32x4){pk2(s1[8], s1[9]), pk2(s1[10], s1[11]), pk2(s1[12], s1[13]), pk2(s1[14], s1[15])};
    ASB();
    LDV(1, va1, vc1);
    MMA(o0, va0, __builtin_bit_cast(bf16x8, pw0)); MMA(o1, vc0, __builtin_bit_cast(bf16x8, pw0));
    { const f32x16 sv = s0 + s1; lsum += ((sv[0] + sv[1]) + (sv[2] + sv[3])) + ((sv[4] + sv[5]) + (sv[6] + sv[7])) + ((sv[8] + sv[9]) + (sv[10] + sv[11])) + ((sv[12] + sv[13]) + (sv[14] + sv[15])); }
    ASB();
    LDV(2, va0, vc0);
    MMA(o0, va1, __builtin_bit_cast(bf16x8, pw1)); MMA(o1, vc1, __builtin_bit_cast(bf16x8, pw1));
    ASB();
    LDV(3, va1, vc1);
    MMA(o0, va0, __builtin_bit_cast(bf16x8, pw2)); MMA(o1, vc0, __builtin_bit_cast(bf16x8, pw2));
    ASB();
    MMA(o0, va1, __builtin_bit_cast(bf16x8, pw3)); MMA(o1, vc1, __builtin_bit_cast(bf16x8, pw3));
    ASB();
    if (t + 1 < 36) { const int vn = (vcur == 0) ? 2 : vcur - 1; att_store(c, (t + 1) & 1, vn, S); }
    asm volatile("s_waitcnt lgkmcnt(0)" ::: "memory"); __builtin_amdgcn_s_barrier(); asm volatile("" ::: "memory");
    s0 = n0; s1 = n1; vcur = (vcur == 2) ? 0 : vcur + 1;
}
__device__ __forceinline__ void attn_phase(const Params& p, unsigned char* lds) {
    unsigned char* ws = p.ws;
    const bf16_t* Q = (const bf16_t*)(ws + WS_QRAW); bf16_t* MIX = (bf16_t*)(ws + WS_MIX);
    const int tid = threadIdx.x, lane = tid & 63, wave = tid >> 6, r32 = lane & 31, hi = lane >> 5;
    AttCtx c; c.KF = (const bf16_t*)(ws + WS_KF); c.VT = (const bf16_t*)(ws + WS_VT); c.Ks = lds; c.Vs = lds + 2 * KBUF; c.tid = tid;
    const int bx = blockIdx.x, G = gridDim.x;
    const int vcu = (G % 8 == 0) ? (bx % 8) * (G / 8) + bx / 8 : bx;
    c.kkey0 = tid / 12; c.kpart0 = tid % 12; c.kkey1 = (tid + 512) / 12; c.kpart1 = (tid + 512) % 12;
    c.vd = tid >> 3; c.vpart = tid & 7;
    c.vdst = c.vd * VSTR + (c.vpart >> 1) * 32 + (c.vpart & 1) * 8;
    c.koff = r32 * KSTR + hi * 16; c.voff = r32 * VSTR + hi * 16;
    for (int unit = vcu; unit < NB * NH * 8; unit += G) {
        const int qb = unit & 7, h = (unit >> 3) & 7, b = unit >> 6;
        c.b = b; c.h = h;
        const size_t qrow = (size_t)b * SEQ + qb * 256 + wave * 32 + r32;
        bf16x8 qf[6];
        {
            float qv[6][8]; float ss = 0.f;
#pragma unroll
            for (int s = 0; s < 6; ++s) { unpack8(qv[s], *(const u32x4*)(Q + qrow * 768 + h * 96 + 16 * s + 8 * hi));
#pragma unroll
                for (int i = 0; i < 8; ++i) ss += qv[s][i] * qv[s][i]; }
            ss += __shfl_xor(ss, 32);
            const float rs = rsqrtf(ss * (1.f / 96.f) + EPS) * QSCALE;
#pragma unroll
            for (int s = 0; s < 6; ++s)
#pragma unroll
                for (int i = 0; i < 8; ++i) qv[s][i] *= rs * p.qn[16 * s + 8 * hi + i];
            const int pos = (int)(qrow & (SEQ - 1));
#pragma unroll
            for (int s = 4; s < 6; ++s) { const float fpos = (float)(s == 4 ? (pos >> 6) : (pos & 63));
#pragma unroll
                for (int f = 0; f < 8; ++f) { const float partner = __shfl_xor(qv[s][f], 32);
                    const float rev = (fpos * rope_inv(f)) * 0.15915494309189535f; const float sn = __builtin_amdgcn_sinf(rev), cs = __builtin_amdgcn_cosf(rev);
                    qv[s][f] = qv[s][f] * cs + (hi ? partner : -partner) * sn; } }
#pragma unroll
            for (int s = 0; s < 6; ++s) qf[s] = __builtin_bit_cast(bf16x8, pack8(qv[s]));
        }
        float mref = -1e30f, lsum = 0.f; f32x16 o0 = {}, o1 = {};
        AttStage A, B; A.k1 = (u32x4){0u, 0u, 0u, 0u}; B.k1 = A.k1;
        att_load(c, 0, A); att_store(c, 0, 0, A);
        asm volatile("s_waitcnt lgkmcnt(0)" ::: "memory"); __builtin_amdgcn_s_barrier(); asm volatile("" ::: "memory");
        att_load(c, 1, A); att_load(c, 2, B);
        f32x16 s0 = {}, s1 = {};
        { const unsigned char* kb = c.Ks + c.koff; bf16x8 ka, kc;
#pragma unroll
          for (int s = 0; s < 6; ++s) { LDK(s, ka, kc); MMA(s0, ka, qf[s]); MMA(s1, kc, qf[s]); } }
        att_store(c, 1, 1, A);
        asm volatile("s_waitcnt lgkmcnt(0)" ::: "memory"); __builtin_amdgcn_s_barrier(); asm volatile("" ::: "memory");
        int vcur = 0;
        for (int t = 1; t <= 35; t += 2) {
            att_iter(c, t, vcur, qf, s0, s1, o0, o1, mref, lsum, A, B);
            att_iter(c, t + 1, vcur, qf, s0, s1, o0, o1, mref, lsum, B, A);
        }
        lsum = swapadd(lsum);
        const float il = 1.f / lsum;
        bf16_t* orow = MIX + qrow * DM + h * 64 + 4 * hi;
#pragma unroll
        for (int q = 0; q < 4; ++q) {
            u32x2 a; a.x = pk2(o0[4 * q] * il, o0[4 * q + 1] * il); a.y = pk2(o0[4 * q + 2] * il, o0[4 * q + 3] * il); *(u32x2*)(orow + 8 * q) = a;
            u32x2 cc; cc.x = pk2(o1[4 * q] * il, o1[4 * q + 1] * il); cc.y = pk2(o1[4 * q + 2] * il, o1[4 * q + 3] * il); *(u32x2*)(orow + 32 + 8 * q) = cc;
        }
    }
}
#undef LDK
#undef LDV
#undef MMA
#undef EXP4
#undef ASB

constexpr int NPHASE = 12;
__global__ void __launch_bounds__(512, 2) mega_fwd(Params p) {
    extern __shared__ __attribute__((aligned(16))) unsigned char lds[];
    LAS unsigned char* ldsl = (LAS unsigned char*)lds;
    unsigned char* ws = p.ws;
    const int G = gridDim.x, bx = blockIdx.x;
    float* MOD = (float*)(ws + WS_MOD);
    bf16_t* H = (bf16_t*)(ws + WS_H); bf16_t* ACT = (bf16_t*)(ws + WS_ACT); bf16_t* PROJ = (bf16_t*)(ws + WS_PROJ);
    float* X1C = (float*)(ws + WS_X1C); float* RSQ = (float*)(ws + WS_RSQ); float* RSKV = (float*)(ws + WS_RSKV);
    const int lo = p.ph_lo, hi = p.ph_hi;
#define IN(k) (lo <= (k) && (k) < hi)
#define SEAM(k) do { if (IN(k) && IN((k) + 1)) { cg::this_grid().sync(); } } while (0)
    using pg8::Gemm; using pg8::StaticOrder;

    if (IN(0)) { phase0(p, (float*)lds); } SEAM(0);
    if (IN(1)) { norm_mod_phase(p.x, p.ctx, MT, p.norm1, MOD, 0, H); } SEAM(1);
    if (IN(2)) { Gemm g{H, (const bf16_t*)(ws + WS_W13A), MT, 2 * DFF, DM, DM, DM}; StaticOrder S; S.init(MT, 2 * DFF, G, bx);
        pg8::EpiSwigluT<false> E{ACT, DFF, nullptr, nullptr}; pg8::gemm_phase(ldsl, g, S, E);
        { const int fi = S.nwg % G, np = fi ? G - fi : G, wi = fi ? bx - fi : bx; const int wave = threadIdx.x >> 6, lane = threadIdx.x & 63;
          if (wi >= 0) { tr_set(p, 1, wi * 8 + wave, np * 8, (float*)lds + wave * 4096, lane); } __syncthreads(); } } SEAM(2);
    if (IN(3)) { Gemm g{ACT, (const bf16_t*)(ws + WS_W2A), MT, DM, DFF, DFF, DFF}; StaticOrder S; S.init(MT, DM, G, bx);
        pg8::EpiRes<MX / 256, 1, true> E{p.x, p.ctx, p.out, X1C, MOD + 2 * DM, p.norm2, MOD + 4 * DM, H, (float*)(ws + WS_SS2)}; pg8::gemm_phase<pg8::EpiRes<MX / 256, 1, true>, StaticOrder, true>(ldsl, g, S, E);
        { const int fi = S.nwg % G, np = fi ? G - fi : G, wi = fi ? bx - fi : bx; const int tid = threadIdx.x, wave = tid >> 6, lane = tid & 63;
          if (wi >= 0) {
            for (int it = wi; it < 111; it += np) {
                if (it < 23) rowmat_item<false>(MOD + 3 * DM, NMOD, MOD + (size_t)32 * NMOD + 3 * DM, p.w_in, 1440, it, nullptr, (float*)(ws + WS_SWIN), NPROJ, 1, (float*)lds, tid);
                else if (it < 67) rowmat_item<false>(MOD + 6 * DM, NMOD, MOD + (size_t)32 * NMOD + 6 * DM, p.f2w1, DFF, it - 23, nullptr, (float*)(ws + WS_SW13), 2 * DFF, 2, (float*)lds, tid);
                else rowmat_item<false>(MOD + 6 * DM, NMOD, MOD + (size_t)32 * NMOD + 6 * DM, p.f2w3, DFF, it - 67, nullptr, (float*)(ws + WS_SW13), 2 * DFF, 3, (float*)lds, tid);
            }
            tr_set(p, 2, wi * 8 + wave, np * 8, (float*)lds + wave * 4096, lane); } __syncthreads(); } } SEAM(3);
    if (IN(4)) {
        { Gemm g{H, (const bf16_t*)(ws + WS_WIN), MX, NPROJ, DM, DM, DM}; StaticOrder S; S.init(MX, NPROJ, G, bx);
          pg8::EpiBf16S E{PROJ, NPROJ, nullptr, nullptr, (const float*)(ws + WS_SS2), (const float*)(ws + WS_SWIN), NPROJ, -1}; pg8::gemm_phase(ldsl, g, S, E); }
        { Gemm g{H + (size_t)MX * DM, (const bf16_t*)(ws + WS_WIN) + (size_t)256 * DM, MC, 256, DM, DM, DM}; StaticOrder S; S.init(MC, 256, G, bx);
          pg8::EpiBf16S E{PROJ + (size_t)MX * NPROJ + 256, NPROJ, nullptr, nullptr, (const float*)(ws + WS_SS2) + MX, (const float*)(ws + WS_SWIN) + 256, NPROJ, 32}; pg8::gemm_phase(ldsl, g, S, E); }
    } SEAM(4);
    if (IN(5)) { rstd_phase(PROJ, RSQ, RSKV); } SEAM(5);
    if (IN(6)) {
        { Gemm g{PROJ, (const bf16_t*)(ws + WS_WUQ), MX, 768, 256, NPROJ, 256}; StaticOrder S; S.init(MX, 768, G, bx);
          pg8::EpiBf16S E{(bf16_t*)(ws + WS_QRAW), 768, RSQ, nullptr, nullptr, nullptr, 0, 0}; pg8::gemm_phase(ldsl, g, S, E); }
        { Gemm g{PROJ + 256, (const bf16_t*)(ws + WS_WK), MT, 512, 256, NPROJ, 256}; StaticOrder S; S.init(MT, 512, G, bx);
          pg8::EpiBf16S E{(bf16_t*)(ws + WS_KNOPE), 512, RSKV, nullptr, nullptr, nullptr, 0, 0}; pg8::gemm_phase(ldsl, g, S, E); }
        { Gemm g{(const bf16_t*)(ws + WS_WV), PROJ + 256, 512, MT, 256, 256, NPROJ}; StaticOrder S; S.init(512, MT, G, bx);
          pg8::EpiBf16S E{(bf16_t*)(ws + WS_VT), MT, nullptr, RSKV, nullptr, nullptr, 0, 0}; pg8::gemm_phase(ldsl, g, S, E); }
        gmlp_phase(p, lds);
    } SEAM(6);
    if (IN(7)) { kprep_phase(p); } SEAM(7);
    if (IN(8)) { attn_phase(p, lds); } SEAM(8);
    if (IN(9)) { Gemm g{(const bf16_t*)(ws + WS_MIX), (const bf16_t*)(ws + WS_WOUT), MX, DM, DM, DM, DM}; StaticOrder S; S.init(MX, DM, G, bx);
        pg8::EpiRes<(1 << 30), 2, true> E{p.out, nullptr, p.out, nullptr, MOD + 5 * DM, p.norm3, MOD + 7 * DM, (bf16_t*)(ws + WS_H3), (float*)(ws + WS_SS3)}; pg8::gemm_phase(ldsl, g, S, E); } SEAM(9);
    if (IN(10)) { Gemm g{(const bf16_t*)(ws + WS_H3), (const bf16_t*)(ws + WS_W13B), MX, 2 * DFF, DM, DM, DM}; StaticOrder S; S.init(MX, 2 * DFF, G, bx);
        pg8::EpiSwigluT<true> E{ACT, DFF, (const float*)(ws + WS_SS3), (const float*)(ws + WS_SW13)}; pg8::gemm_phase(ldsl, g, S, E); } SEAM(10);
    if (IN(11)) { Gemm g{ACT, (const bf16_t*)(ws + WS_W2B), MX, DM, DFF, DFF, DFF}; StaticOrder S; S.init(MX, DM, G, bx);
        pg8::EpiRes<(1 << 30), 1, false> E{p.out, nullptr, p.out, nullptr, MOD + 8 * DM, nullptr, nullptr, nullptr, nullptr}; pg8::gemm_phase<pg8::EpiRes<(1 << 30), 1, false>, StaticOrder, true>(ldsl, g, S, E); }
#undef IN
#undef SEAM
}

extern "C" void kernel_launch(void* const* d_in, const int* in_sizes, int n_in, void* d_out, int out_size, void* d_ws, size_t ws_size, hipStream_t stream) {
    static int grid = 0;
    if (grid == 0) {
        if (n_in != 26 || in_sizes[0] != MX * DM || out_size != MX * DM || ws_size < WS_END) { fprintf(stderr, "kernel_launch: unexpected shapes (n_in %d, in0 %d, out %d, ws %zu)\n", n_in, n_in > 0 ? in_sizes[0] : -1, out_size, ws_size); grid = -1; return; }
        int dev = 0, cus = 0, per_cu = 0;
        if (hipGetDevice(&dev) != hipSuccess || hipDeviceGetAttribute(&cus, hipDeviceAttributeMultiprocessorCount, dev) != hipSuccess) { grid = -1; return; }
        if (hipFuncSetAttribute((const void*)mega_fwd, hipFuncAttributeMaxDynamicSharedMemorySize, LDS_BYTES) != hipSuccess) { fprintf(stderr, "kernel_launch: hipFuncSetAttribute failed\n"); grid = -1; return; }
        if (hipOccupancyMaxActiveBlocksPerMultiprocessor(&per_cu, (const void*)mega_fwd, 512, LDS_BYTES) != hipSuccess || per_cu < 1) { fprintf(stderr, "kernel_launch: occupancy query says %d\n", per_cu); per_cu = 1; }
        (void)hipGetLastError();
        grid = cus;
    }
    if (grid < 0) return;
    Params p{};
    const float** pp = (const float**)&p;
    for (int i = 0; i < 26; ++i) pp[i] = (const float*)d_in[i];
    p.out = (float*)d_out; p.ws = (unsigned char*)d_ws;
#if MK_ONE_LAUNCH
    p.ph_lo = 0; p.ph_hi = NPHASE;
    void* args[] = {&p};
    hipError_t e = hipLaunchCooperativeKernel((const void*)mega_fwd, dim3(grid), dim3(512), args, LDS_BYTES, stream);
    if (e != hipSuccess) fprintf(stderr, "cooperative launch failed: %s (grid %d)\n", hipGetErrorString(e), grid);
#else
    for (int ph = 0; ph < NPHASE; ++ph) {
        p.ph_lo = ph; p.ph_hi = ph + 1;
        hipLaunchKernelGGL(mega_fwd, dim3(grid), dim3(512), LDS_BYTES, stream, p);
    }
#endif
}
```

```cpp
#include <hip/hip_runtime.h>
#include <hip/hip_cooperative_groups.h>
#include <cstdio>
#include <cstdint>
namespace cg = cooperative_groups;

#ifndef MK_ONE_LAUNCH
#define MK_ONE_LAUNCH 1
#endif

#define LAS __attribute__((address_space(3)))
typedef unsigned short bf16_t;
typedef short bf16x8 __attribute__((ext_vector_type(8)));
typedef float f32x4 __attribute__((ext_vector_type(4)));
typedef float f32x16 __attribute__((ext_vector_type(16)));
typedef unsigned u32x4 __attribute__((ext_vector_type(4)));
typedef unsigned u32x2 __attribute__((ext_vector_type(2)));

constexpr int DM = 1024, NB = 32, SEQ = 2048, CTXL = 256, DFF = 2816;
constexpr int MX = NB * SEQ;
constexpr int MC = NB * CTXL;
constexpr int MT = MX + MC;
constexpr int NMOD = 9 * DM;
constexpr int NPROJ = 1536;
constexpr int NH = 8, DQK = 96, DV = 64;
constexpr float EPS = 1e-6f;
constexpr float QSCALE = 0.10206207261596577f * 1.4426950408889634f;

constexpr size_t MiB = 1u << 20;
constexpr size_t WS_MOD = 1 * MiB, WS_RSQ = 3 * MiB, WS_RSKV = 3 * MiB + 512 * 1024;
constexpr size_t WS_W13A = 4 * MiB, WS_W2A = 15 * MiB, WS_W13B = 21 * MiB, WS_W2B = 32 * MiB, WS_WIN = 38 * MiB;
constexpr size_t WS_WUQ = 41 * MiB, WS_WK = 41 * MiB + 512 * 1024, WS_WV = 41 * MiB + 768 * 1024, WS_WOUT = 42 * MiB, WS_WS = 44 * MiB;
constexpr size_t WS_X1C = 46 * MiB, WS_H = 80 * MiB, WS_ACT = 224 * MiB;
constexpr size_t WS_PROJ = 224 * MiB, WS_QRAW = 440 * MiB, WS_KNOPE = 536 * MiB;
constexpr size_t WS_KF = 620 * MiB, WS_VT = 728 * MiB, WS_END = 800 * MiB;
constexpr size_t WS_MIX = WS_H;
constexpr size_t WS_SWIN = 44 * MiB + 512 * 1024, WS_SW13 = 45 * MiB, WS_SS2 = 78 * MiB, WS_SS3 = 78 * MiB + 512 * 1024;
constexpr size_t WS_H3 = WS_KF;

constexpr int LDS_BYTES = 147456;

__device__ __forceinline__ unsigned pk2(float lo, float hi) {
    typedef float f2 __attribute__((ext_vector_type(2))); typedef __bf16 b2 __attribute__((ext_vector_type(2)));
    f2 v = {lo, hi}; b2 b = __builtin_convertvector(v, b2); return __builtin_bit_cast(unsigned, b);
}
__device__ __forceinline__ float bflo(unsigned w) { return __uint_as_float(w << 16); }
__device__ __forceinline__ float bfhi(unsigned w) { return __uint_as_float(w & 0xffff0000u); }
__device__ __forceinline__ float fexp2(float x) { return __builtin_amdgcn_exp2f(x); }
__device__ __forceinline__ float frcp(float x) { return __builtin_amdgcn_rcpf(x); }
__device__ __forceinline__ float silu_f(float a) { return a * frcp(1.f + fexp2(-1.4426950408889634f * a)); }
__device__ __forceinline__ float gelu_f(float x) { const float y = 0.7978845608028654f * (x + 0.044715f * x * x * x); return x * frcp(1.f + fexp2(-2.8853900817779268f * y)); }
__device__ __forceinline__ float wave_sum(float v) {
#pragma unroll
    for (int o = 1; o < 64; o <<= 1) v += __shfl_xor(v, o);
    return v;
}
#define LDS_WAIT() asm volatile("s_waitcnt lgkmcnt(0)" ::: "memory")

namespace pg8 {
constexpr int BM = 256, BK = 64, HALF = 128, HTB = HALF * BK * 2, STAGE_BYTES = 8 * HTB, NXCD = 8, WGM = 4;
__host__ __device__ __forceinline__ int lds_byte(int r, int c) { const int st = (r >> 4) * 2 + (c >> 5), rr = r & 15, cc = c & 31, ob = rr * 64 + cc * 2; return st * 1024 + (ob ^ (((ob >> 9) & 1) << 5)); }
__host__ __device__ __forceinline__ void stage_rc(int b, int& R, int& C) { const int st = b / 1024, sb = b % 1024, swz = sb ^ (((sb >> 9) & 1) << 5); R = (st >> 1) * 16 + swz / 64; C = (st & 1) * 32 + (swz % 64) / 2; }
__host__ __device__ __forceinline__ int perm32(int rho) { const int n = rho >> 4, i = rho & 15; return 8 * (i >> 2) + 4 * n + (i & 3); }

struct Unit { int pm, pn; };
struct Gemm { const bf16_t* A; const bf16_t* Bt; int M, N, K, lda, ldb; };

struct StaticOrder {
    int nM, nN, nwg, G, c;
    __device__ void init(int M, int N, int G_, int c_) { nM = M / BM; nN = N / BM; nwg = nM * nN; G = G_; c = c_; }
    __device__ bool next(int i, Unit& u) const {
        const long L = (long)i * G + c; if (L >= nwg) return false;
        int wgid = (int)L; { const int q = nwg / NXCD, r = nwg % NXCD, xcd = wgid % NXCD, off = wgid / NXCD; wgid = (xcd < r ? xcd * (q + 1) : r * (q + 1) + (xcd - r) * q) + off; }
        const int nig = WGM * nN, gid = wgid / nig, fm = gid * WGM, gsz = (nM - fm) < WGM ? (nM - fm) : WGM;
        u.pm = fm + ((wgid % nig) % gsz); u.pn = (wgid % nig) / gsz; return true;
    }
};

template <bool NORM, bool TILED = true> struct EpiSwigluT {
    static constexpr bool PERM = true;
    bf16_t* O; int ldc; const float* SSn; const float* cb;
    __device__ __forceinline__ void operator()(const f32x4 (&acc)[2][2][4][2], const Unit& u, int wr, int wc, int fr, int fq) const {
        const int row0 = u.pm * BM + wr * 64 + fr, col0 = u.pn * HALF + wc * 32 + 8 * fq;
        f32x4 cv[2][2];
        if (NORM) {
            const float* cbp = cb + (size_t)(u.pm >> 3) * (2 * DFF) + u.pn * BM + wc * 32 + 8 * fq;
#pragma unroll
            for (int bj = 0; bj < 2; ++bj)
#pragma unroll
                for (int n = 0; n < 2; ++n) cv[bj][n] = *(const f32x4*)(cbp + bj * HALF + 4 * n);
        }
#pragma unroll
        for (int ai = 0; ai < 2; ++ai)
#pragma unroll
            for (int m = 0; m < 4; ++m) {
                const int row = row0 + ai * HALF + m * 16;
                bf16_t* rowp = TILED ? O + ((size_t)((row >> 4) * (ldc >> 5) + (col0 >> 5)) * 512 + (row & 15) * 32 + (col0 & 31)) : O + (size_t)row * ldc + col0;
                f32x4 a0 = acc[ai][0][m][0], a1 = acc[ai][0][m][1], b0 = acc[ai][1][m][0], b1 = acc[ai][1][m][1];
                if (NORM) { const float r = rsqrtf(SSn[row] * (1.f / DM) + EPS); a0 = a0 * r + cv[0][0]; a1 = a1 * r + cv[0][1]; b0 = b0 * r + cv[1][0]; b1 = b1 * r + cv[1][1]; }
                u32x4 w;
                w.x = pk2(silu_f(a0[0]) * b0[0], silu_f(a0[1]) * b0[1]); w.y = pk2(silu_f(a0[2]) * b0[2], silu_f(a0[3]) * b0[3]);
                w.z = pk2(silu_f(a1[0]) * b1[0], silu_f(a1[1]) * b1[1]); w.w = pk2(silu_f(a1[2]) * b1[2], silu_f(a1[3]) * b1[3]);
                *(u32x4*)rowp = w;
            }
    }
};
template <int ctx_tile0, int COEF2, bool NORM> struct EpiRes {
    static constexpr bool PERM = true;
    const float* bx; const float* bc; float* ox; float* oc; const float* gate;
    const float* nw; const float* nscale; bf16_t* Hn; float* SS;
    __device__ __forceinline__ void operator()(const f32x4 (&acc)[2][2][4][2], const Unit& u, int wr, int wc, int fr, int fq) const {
        asm volatile("" : "+v"(fr), "+v"(fq));
        const bool isc = u.pm >= ctx_tile0;
        const int mrow = isc ? 32 : (u.pm >> 3);
        const int prow = isc ? (u.pm - ctx_tile0) : u.pm;
        const float* base = isc ? bc : bx; float* out = isc ? oc : ox;
        const int col0 = u.pn * BM + wc * 32 + 8 * fq;
        f32x4 gv[2][2], G[2][2]; float ssv[2][4];
#pragma unroll
        for (int bj = 0; bj < 2; ++bj)
#pragma unroll
            for (int n = 0; n < 2; ++n) { const int c = col0 + bj * HALF + 4 * n; gv[bj][n] = *(const f32x4*)(gate + (size_t)mrow * NMOD + c) * (0.5f * COEF2);
                if (NORM) G[bj][n] = *(const f32x4*)(nw + c) * (*(const f32x4*)(nscale + (size_t)mrow * NMOD + c) + 1.f); }
#pragma unroll
        for (int ai = 0; ai < 2; ++ai)
#pragma unroll
            for (int m = 0; m < 4; ++m) {
                const int rl = ai * HALF + wr * 64 + m * 16 + fr;
                const size_t off = (size_t)(prow * BM + rl) * DM + col0;
                const size_t hrow = (size_t)u.pm * BM + rl;
                float ss = 0.f;
#pragma unroll
                for (int bj = 0; bj < 2; ++bj) {
                    const f32x4 o0 = *(const f32x4*)(base + off + bj * HALF) + gv[bj][0] * acc[ai][bj][m][0];
                    const f32x4 o1 = *(const f32x4*)(base + off + bj * HALF + 4) + gv[bj][1] * acc[ai][bj][m][1];
                    if (!isc) { *(f32x4*)(out + off + bj * HALF) = o0; *(f32x4*)(out + off + bj * HALF + 4) = o1; }
                    if (NORM) {
                        ss += (o0[0] * o0[0] + o0[1] * o0[1]) + (o0[2] * o0[2] + o0[3] * o0[3]) + (o1[0] * o1[0] + o1[1] * o1[1]) + (o1[2] * o1[2] + o1[3] * o1[3]);
                        const f32x4 h0 = o0 * G[bj][0], h1 = o1 * G[bj][1];
                        u32x4 w; w.x = pk2(h0[0], h0[1]); w.y = pk2(h0[2], h0[3]); w.z = pk2(h1[0], h1[1]); w.w = pk2(h1[2], h1[3]);
                        *(u32x4*)(Hn + hrow * DM + col0 + bj * HALF) = w;
                    }
                }
                if (NORM) { ss += __shfl_xor(ss, 16); ss += __shfl_xor(ss, 32); ssv[ai][m] = ss; }
            }
        if (NORM) {
            asm volatile("" ::: "memory");
#pragma unroll
            for (int ai = 0; ai < 2; ++ai)
#pragma unroll
                for (int m = 0; m < 4; ++m)
                    if (fq == 0) __hip_atomic_fetch_add(SS + (size_t)u.pm * BM + ai * HALF + wr * 64 + m * 16 + fr, ssv[ai][m], __ATOMIC_RELAXED, __HIP_MEMORY_SCOPE_AGENT);
        }
    }
};
struct EpiBf16S {
    static constexpr bool PERM = true;
    bf16_t* O; int ldc; const float* rs; const float* cs; const float* SSn; const float* cb; int ldcb; int mrow_fixed;
    __device__ __forceinline__ void operator()(const f32x4 (&acc)[2][2][4][2], const Unit& u, int wr, int wc, int fr, int fq) const {
        const int row0 = u.pm * BM + wr * 64 + fr, col0 = u.pn * BM + wc * 32 + 8 * fq;
        const int mrow = mrow_fixed >= 0 ? mrow_fixed : (u.pm >> 3);
        f32x4 cv[2][2], bv[2][2];
#pragma unroll
        for (int bj = 0; bj < 2; ++bj)
#pragma unroll
            for (int n = 0; n < 2; ++n) { cv[bj][n] = cs ? *(const f32x4*)(cs + col0 + bj * HALF + 4 * n) : (f32x4){1.f, 1.f, 1.f, 1.f};
                bv[bj][n] = cb ? *(const f32x4*)(cb + (size_t)mrow * ldcb + col0 + bj * HALF + 4 * n) : (f32x4){0.f, 0.f, 0.f, 0.f}; }
#pragma unroll
        for (int ai = 0; ai < 2; ++ai)
#pragma unroll
            for (int m = 0; m < 4; ++m) {
                const int row = row0 + ai * HALF + m * 16;
                const float r = SSn ? rsqrtf(SSn[row] * (1.f / DM) + EPS) : (rs ? rs[row] : 1.f);
                bf16_t* rowp = O + (size_t)row * ldc + col0;
#pragma unroll
                for (int bj = 0; bj < 2; ++bj) {
                    const f32x4 v0 = acc[ai][bj][m][0] * cv[bj][0] * r + bv[bj][0], v1 = acc[ai][bj][m][1] * cv[bj][1] * r + bv[bj][1];
                    u32x4 w; w.x = pk2(v0[0], v0[1]); w.y = pk2(v0[2], v0[3]); w.z = pk2(v1[0], v1[1]); w.w = pk2(v1[2], v1[3]);
                    *(u32x4*)(rowp + bj * HALF) = w;
                }
            }
    }
};

template <class Epi, class Sched, bool TILEDA = false>
__device__ __forceinline__ void gemm_phase(LAS unsigned char* lds, const Gemm g, const Sched& S, const Epi& E) {
    const int tid = threadIdx.x, wid = __builtin_amdgcn_readfirstlane(tid >> 6), lane = tid & 63, wr = wid >> 2, wc = wid & 3, fr = lane & 15, fq = lane >> 4;
    const int K = g.K, nt = K / BK;
    unsigned voffA[2], voffB[2];
#pragma unroll
    for (int i = 0; i < 2; ++i) { int R, C; stage_rc(tid * 16 + i * 8192, R, C); const int Rb = Epi::PERM ? ((R & ~31) + perm32(R & 31)) : R;
        voffA[i] = TILEDA ? (unsigned)(((R >> 4) * (g.lda >> 5) + (C >> 5)) * 1024 + (R & 15) * 64 + (C & 31) * 2) : (unsigned)(R * g.lda + C) * 2u;
        voffB[i] = (unsigned)(Rb * g.ldb + C) * 2u; }
    const size_t kstep = (size_t)(BK * 2), kstepA = TILEDA ? (size_t)2048 : kstep;
    const size_t hA = TILEDA ? (size_t)(HALF / 16) * (g.lda >> 5) * 1024 : (size_t)HALF * g.lda * 2, hB = (size_t)HALF * g.ldb * 2;
    const size_t tA = 2 * hA, tB = 2 * hB;
    const unsigned ldsw = (unsigned)wid * 1024u;
    const int aoff = lds_byte(wr * 64 + fr, fq * 8), boff = lds_byte(wc * 32 + fr, fq * 8);
#define PG8_SA(b, h) (((b) * 2 + (h)) * HTB)
#define PG8_SB(b, h) ((4 + (b) * 2 + (h)) * HTB)
#define PG8_STAGE(bufoff, gbase, voff) do { _Pragma("unroll") for (int _i = 0; _i < 2; ++_i) \
        __builtin_amdgcn_global_load_lds((const unsigned*)((const char*)(gbase) + (voff)[_i]), (LAS unsigned*)(lds + (bufoff) + ldsw + _i * 8192), 16, 0, 0); } while (0)
#define PG8_LDA(dst, b, h) do { _Pragma("unroll") for (int m = 0; m < 4; ++m) _Pragma("unroll") for (int k = 0; k < 2; ++k) dst[m][k] = *(const LAS bf16x8*)(lds + PG8_SA(b, h) + aoff + m * 2048 + k * 1024); } while (0)
#define PG8_LDB(dst, b, h) do { _Pragma("unroll") for (int n = 0; n < 2; ++n) _Pragma("unroll") for (int k = 0; k < 2; ++k) dst[n][k] = *(const LAS bf16x8*)(lds + PG8_SB(b, h) + boff + n * 2048 + k * 1024); } while (0)
#define PG8_MMA(ai, bj, At, Bt) do { __builtin_amdgcn_s_setprio(1); _Pragma("unroll") for (int m = 0; m < 4; ++m) _Pragma("unroll") for (int n = 0; n < 2; ++n) _Pragma("unroll") for (int k = 0; k < 2; ++k) \
        acc[ai][bj][m][n] = __builtin_amdgcn_mfma_f32_16x16x32_bf16(Bt[n][k], At[m][k], acc[ai][bj][m][n], 0, 0, 0); __builtin_amdgcn_s_setprio(0); } while (0)
#define PG8_WAIT_V(n) asm volatile("s_waitcnt vmcnt(" #n ")" ::: "memory")
#define PG8_WAIT_L(n) asm volatile("s_waitcnt lgkmcnt(" #n ")" ::: "memory")
#define PG8_BAR __builtin_amdgcn_s_barrier()
#define PG8_SCHED __builtin_amdgcn_sched_barrier(0)
    Unit cur, nxt; int ui = 0;
    if (!S.next(0, cur)) return;
    f32x4 acc[2][2][4][2];
#pragma unroll
    for (int a = 0; a < 2; ++a)
#pragma unroll
        for (int b = 0; b < 2; ++b)
#pragma unroll
            for (int m = 0; m < 4; ++m)
#pragma unroll
                for (int n = 0; n < 2; ++n) acc[a][b][m][n] = (f32x4){0.f, 0.f, 0.f, 0.f};
    bf16x8 At[4][2], B0[2][2], B1[2][2];
    const char* cA = (const char*)g.A + (size_t)cur.pm * tA; const char* cB = (const char*)g.Bt + (size_t)cur.pn * tB;
    PG8_STAGE(PG8_SB(0, 0), cB, voffB); PG8_STAGE(PG8_SB(0, 1), cB + hB, voffB); PG8_STAGE(PG8_SA(0, 0), cA, voffA); PG8_STAGE(PG8_SA(0, 1), cA + hA, voffA);
    if (wr == 1) PG8_BAR;
    PG8_WAIT_V(2); PG8_BAR;
    PG8_STAGE(PG8_SB(1, 0), cB + kstep, voffB); PG8_STAGE(PG8_SA(1, 0), cA + kstepA, voffA); PG8_STAGE(PG8_SB(1, 1), cB + hB + kstep, voffB);
    PG8_WAIT_V(6); PG8_BAR;
    for (;;) {
        const bool has_next = S.next(ui + 1, nxt);
        const char* nA = has_next ? (const char*)g.A + (size_t)nxt.pm * tA : cA; const char* nB = has_next ? (const char*)g.Bt + (size_t)nxt.pn * tB : cB;
        for (int t = 0; t < nt; t += 2) {
            const bool last = (t == nt - 2);
            const char* a1 = cA + (size_t)(t + 1) * kstepA;
            const char* a2 = last ? nA : cA + (size_t)(t + 2) * kstepA; const char* b2 = last ? nB : cB + (size_t)(t + 2) * kstep;
            const char* a3 = a2 + kstepA; const char* b3 = b2 + kstep;
            PG8_LDB(B0, 0, 0); PG8_LDB(B1, 0, 1); PG8_SCHED; PG8_LDA(At, 0, 0); PG8_STAGE(PG8_SA(1, 1), a1 + hA, voffA);
            PG8_WAIT_V(8); PG8_WAIT_L(0); PG8_BAR; PG8_MMA(0, 0, At, B0); PG8_MMA(0, 1, At, B1); PG8_BAR; PG8_SCHED;
            PG8_LDA(At, 0, 1); PG8_STAGE(PG8_SB(0, 0), b2, voffB); PG8_STAGE(PG8_SB(0, 1), b2 + hB, voffB); PG8_STAGE(PG8_SA(0, 0), a2, voffA);
            PG8_WAIT_V(8); PG8_WAIT_L(0); PG8_BAR; PG8_MMA(1, 0, At, B0); PG8_MMA(1, 1, At, B1); PG8_BAR; PG8_SCHED;
            PG8_LDB(B0, 1, 0); PG8_LDB(B1, 1, 1); PG8_SCHED; PG8_LDA(At, 1, 0); PG8_STAGE(PG8_SA(0, 1), a2 + hA, voffA);
            PG8_WAIT_V(8); PG8_WAIT_L(0); PG8_BAR; PG8_MMA(0, 0, At, B0); PG8_MMA(0, 1, At, B1); PG8_BAR; PG8_SCHED;
            PG8_LDA(At, 1, 1); PG8_STAGE(PG8_SB(1, 0), b3, voffB); PG8_STAGE(PG8_SB(1, 1), b3 + hB, voffB); PG8_STAGE(PG8_SA(1, 0), a3, voffA);
            PG8_WAIT_V(8); PG8_WAIT_L(0); PG8_BAR; PG8_MMA(1, 0, At, B0); PG8_MMA(1, 1, At, B1); PG8_BAR; PG8_SCHED;
        }
        if (wr == 0) PG8_BAR;
        E(acc, cur, wr, wc, fr, fq);
        if (!has_next) break;
#pragma unroll
        for (int a = 0; a < 2; ++a)
#pragma unroll
            for (int b = 0; b < 2; ++b)
#pragma unroll
                for (int m = 0; m < 4; ++m)
#pragma unroll
                    for (int n = 0; n < 2; ++n) acc[a][b][m][n] = (f32x4){0.f, 0.f, 0.f, 0.f};
        cur = nxt; cA = nA; cB = nB; ++ui;
        if (wr == 1) PG8_BAR;
    }
    PG8_WAIT_V(0);
    PG8_BAR;
#undef PG8_SA
#undef PG8_SB
#undef PG8_STAGE
#undef PG8_LDA
#undef PG8_LDB
#undef PG8_MMA
#undef PG8_WAIT_V
#undef PG8_WAIT_L
#undef PG8_BAR
#undef PG8_SCHED
}
}

struct Params {
    const float *x, *c, *ctx, *cctx, *w_ada, *b_ada, *norm1, *f1w1, *f1w3, *f1w2, *norm2, *w_in, *qan, *w_uq, *kvan, *w_ukv, *qn, *kn, *vn, *w_s, *b_s, *w_out, *norm3, *f2w1, *f2w3, *f2w2;
    float* out; unsigned char* ws; int ph_lo, ph_hi;
};

__device__ __forceinline__ void tr_item(const float* W, int N, int k0, int n0, bf16_t* dst, int ldd, const float* kscale, float* scr, int lane) {
#pragma unroll 8
    for (int i = 0; i < 32; ++i) { const int kk = 2 * i + (lane >> 5); float v = W[(size_t)(k0 + kk) * N + n0 + (lane & 31)]; if (kscale) v *= kscale[k0 + kk]; scr[kk * 33 + (lane & 31)] = v; }
    LDS_WAIT();
    const int c = lane & 7;
#pragma unroll
    for (int j = 0; j < 4; ++j) { const int n = (lane >> 3) + 8 * j; const float* s = scr + (8 * c) * 33 + n;
        u32x4 o; o.x = pk2(s[0 * 33], s[1 * 33]); o.y = pk2(s[2 * 33], s[3 * 33]); o.z = pk2(s[4 * 33], s[5 * 33]); o.w = pk2(s[6 * 33], s[7 * 33]);
        *(u32x4*)(dst + (size_t)n * ldd + 8 * c) = o; }
    LDS_WAIT();
}
__device__ __forceinline__ int win_row(int n) {
    if (n < 128) return 256 + n;
    if (n < 160) return 384 + (n - 128);
    if (n < 416) return n - 160;
    if (n < 928) return 512 + (n - 416);
    return 1024 + (n - 928);
}
template <bool SILU>
__device__ __forceinline__ void rowmat_item(const float* in, int istr, const float* in32, const float* W, int N, int j, const float* bias, float* out, int ldo, int cmap, float* lds, int tid) {
    const int wave = tid >> 6, lane = tid & 63, col = 64 * j + lane; const bool cok = col < N; const int colc = cok ? col : N - 1;
    float acc[33];
#pragma unroll
    for (int r = 0; r < 33; ++r) acc[r] = 0.f;
    for (int pass = 0; pass < 2; ++pass) {
        __syncthreads();
        {
            float cvv[33];
#pragma unroll
            for (int r = 0; r < 33; ++r) cvv[r] = (r < 32) ? in[(size_t)r * istr + 512 * pass + tid] : in32[512 * pass + tid];
#pragma unroll
            for (int r = 0; r < 33; ++r) lds[r * 512 + tid] = SILU ? cvv[r] / (1.f + __expf(-cvv[r])) : cvv[r];
        }
        __syncthreads();
        const int kb = 512 * pass + 64 * wave;
        const float* Wc = W + (size_t)kb * N + colc;
        float w0 = Wc[0], w1 = Wc[(size_t)N], w2 = Wc[(size_t)2 * N], w3 = Wc[(size_t)3 * N];
        float x0 = Wc[(size_t)4 * N], x1 = Wc[(size_t)5 * N], x2 = Wc[(size_t)6 * N], x3 = Wc[(size_t)7 * N];
        for (int k4 = 0; k4 < 16; ++k4) {
            const int kn = (k4 + 2 < 16) ? 4 * (k4 + 2) : 0;
            const float y0 = Wc[(size_t)(kn + 0) * N], y1 = Wc[(size_t)(kn + 1) * N], y2 = Wc[(size_t)(kn + 2) * N], y3 = Wc[(size_t)(kn + 3) * N];
#pragma unroll
            for (int r = 0; r < 33; ++r) { const f32x4 s = *(const f32x4*)(lds + r * 512 + 64 * wave + 4 * k4); acc[r] += s[0] * w0 + s[1] * w1 + s[2] * w2 + s[3] * w3; }
            w0 = x0; w1 = x1; w2 = x2; w3 = x3; x0 = y0; x1 = y1; x2 = y2; x3 = y3;
        }
    }
    __syncthreads();
#pragma unroll
    for (int r = 0; r < 33; ++r) lds[(wave * 33 + r) * 64 + lane] = acc[r];
    __syncthreads();
    for (int idx = tid; idx < 33 * 64; idx += 512) { const int r = idx >> 6, l = idx & 63, c = 64 * j + l; float s = 0.f;
#pragma unroll
        for (int w = 0; w < 8; ++w) s += lds[(w * 33 + r) * 64 + l];
        if (c < N) { const int oc = cmap == 0 ? c : cmap == 1 ? win_row(c) : (256 * (c >> 7) + (c & 127) + (cmap == 3 ? 128 : 0));
            out[(size_t)r * ldo + oc] = s + (bias ? bias[c] : 0.f); } }
    __syncthreads();
}
constexpr int I_UP = 16 * 88, I_DN = 44 * 32, I_IN = 16 * 45, I_UQ = 4 * 24, I_UKV = 2 * 32, I_OUT = 16 * 32;
constexpr int NITEMS = 4 * I_UP + 2 * I_DN + I_IN + I_UQ + I_UKV + I_OUT;
__device__ __forceinline__ void tr_dispatch(const Params& p, int it, float* scr, int lane) {
    unsigned char* ws = p.ws;
    int r = it;
    if (r < 4 * I_UP) { const int which = r / I_UP; r -= which * I_UP; const int kb = r / 88, nb = r % 88, k0 = 64 * kb, n0 = 32 * nb;
        const float* W = which == 0 ? p.f1w1 : which == 1 ? p.f1w3 : which == 2 ? p.f2w1 : p.f2w3;
        bf16_t* D = (bf16_t*)(ws + (which < 2 ? WS_W13A : WS_W13B));
        const int row = 256 * (n0 >> 7) + (n0 & 127) + ((which & 1) ? 128 : 0);
        tr_item(W, DFF, k0, n0, D + (size_t)row * DM + k0, DM, nullptr, scr, lane); return; }
    r -= 4 * I_UP;
    if (r < 2 * I_DN) { const int which = r / I_DN; r -= which * I_DN; const int kb = r / 32, nb = r % 32, k0 = 64 * kb, n0 = 32 * nb;
        tr_item(which ? p.f2w2 : p.f1w2, DM, k0, n0, (bf16_t*)(ws + (which ? WS_W2B : WS_W2A)) + (size_t)n0 * DFF + k0, DFF, nullptr, scr, lane); return; }
    r -= 2 * I_DN;
    if (r < I_IN) { const int kb = r / 45, nb = r % 45, k0 = 64 * kb, n0 = 32 * nb;
        tr_item(p.w_in, 1440, k0, n0, (bf16_t*)(ws + WS_WIN) + (size_t)win_row(n0) * DM + k0, DM, nullptr, scr, lane); return; }
    r -= I_IN;
    if (r < I_UQ) { const int kb = r / 24, nb = r % 24, k0 = 64 * kb, n0 = 32 * nb;
        tr_item(p.w_uq, 768, k0, n0, (bf16_t*)(ws + WS_WUQ) + (size_t)n0 * 256 + k0, 256, p.qan, scr, lane); return; }
    r -= I_UQ;
    if (r < I_UKV) { const int kb = r / 32, nb = r % 32, k0 = 64 * kb, n0 = 32 * nb; const int h = n0 >> 7, j = n0 & 127;
        bf16_t* D = (j < 64) ? (bf16_t*)(ws + WS_WK) + (size_t)(h * 64 + j) * 256 : (bf16_t*)(ws + WS_WV) + (size_t)(h * 64 + j - 64) * 256;
        tr_item(p.w_ukv, 1024, k0, n0, D + k0, 256, p.kvan, scr, lane); return; }
    r -= I_UKV;
    { const int kb = r / 32, nb = r % 32, k0 = 64 * kb, n0 = 32 * nb;
        tr_item(p.w_out, DM, k0, n0, (bf16_t*)(ws + WS_WOUT) + (size_t)n0 * DM + k0, DM, nullptr, scr, lane); }
}
__device__ __forceinline__ void tr_set(const Params& p, int set, int widx, int nw, float* scr, int lane, int j0 = 0, int j1 = 1 << 30) {
    const int nall = set == 1 ? (I_IN + I_UQ + I_UKV + I_OUT) : (2 * I_UP + I_DN); const int n = j1 < nall ? j1 : nall;
    for (int j = j0 + widx; j < n; j += nw) {
        const int it = set == 0 ? (j < 2 * I_UP ? j : 4 * I_UP + (j - 2 * I_UP))
                     : set == 1 ? (4 * I_UP + 2 * I_DN + j)
                     : (j < 2 * I_UP ? 2 * I_UP + j : 4 * I_UP + I_DN + (j - 2 * I_UP));
        tr_dispatch(p, it, scr, lane);
    }
}
__device__ __forceinline__ void phase0(const Params& p, float* lds) {
    unsigned char* ws = p.ws;
    const int tid = threadIdx.x, lane = tid & 63, wave = tid >> 6, G = gridDim.x;
    float* MOD = (float*)(ws + WS_MOD);
    if ((int)blockIdx.x < 144) rowmat_item<true>(p.c, DM, p.cctx, p.w_ada, NMOD, blockIdx.x, p.b_ada, MOD, NMOD, 0, lds, tid);
    {
        const int gt = blockIdx.x * 512 + tid, NT = G * 512;
        { f32x4* zs = (f32x4*)(ws + WS_SWIN); for (int i = gt; i < 33 * NPROJ / 4; i += NT) zs[i] = (f32x4){0.f, 0.f, 0.f, 0.f}; }
        { f32x4* zs = (f32x4*)(ws + WS_SS2); for (int i = gt; i < MT / 4; i += NT) zs[i] = (f32x4){0.f, 0.f, 0.f, 0.f}; }
        { f32x4* zs = (f32x4*)(ws + WS_SS3); for (int i = gt; i < MX / 4; i += NT) zs[i] = (f32x4){0.f, 0.f, 0.f, 0.f}; }
        u32x4* z0 = (u32x4*)((bf16_t*)(ws + WS_WIN) + (size_t)416 * 1024);
        for (int i = gt; i < 96 * 1024 / 8; i += NT) z0[i] = (u32x4){0u, 0u, 0u, 0u};
        for (int i = gt; i < 512 * 16; i += NT) { const int r = i >> 4, cpart = i & 15;
            *(u32x4*)((bf16_t*)(ws + WS_WK) + (size_t)r * 256 + 128 + cpart * 8) = (u32x4){0u, 0u, 0u, 0u};
            *(u32x4*)((bf16_t*)(ws + WS_WV) + (size_t)r * 256 + 128 + cpart * 8) = (u32x4){0u, 0u, 0u, 0u}; }
        for (int i = gt; i < 8 * 128 * 128 / 8; i += NT) { const f32x4 a = *(const f32x4*)(p.w_s + (size_t)i * 8), b = *(const f32x4*)(p.w_s + (size_t)i * 8 + 4);
            u32x4 o; o.x = pk2(a[0], a[1]); o.y = pk2(a[2], a[3]); o.z = pk2(b[0], b[1]); o.w = pk2(b[2], b[3]); *(u32x4*)((bf16_t*)(ws + WS_WS) + (size_t)i * 8) = o; }
    }
    if (G > 144) { if ((int)blockIdx.x >= 144) tr_set(p, 0, ((int)blockIdx.x - 144) * 8 + wave, (G - 144) * 8, lds + wave * 4096, lane, 1152);
                   else tr_set(p, 0, (int)blockIdx.x * 8 + wave, 1152, lds + wave * 4096, lane, 0, 1152); }
    else tr_set(p, 0, blockIdx.x * 8 + wave, G * 8, lds + wave * 4096, lane);
    __syncthreads();
}

__device__ __forceinline__ void norm_mod_phase(const float* srcx, const float* srcc, int nrows, const float* w, const float* MOD, int ishift, bf16_t* H) {
    const int tid = threadIdx.x, lane = tid & 63, wave = tid >> 6;
    const int gw = blockIdx.x * 8 + wave, NGW = gridDim.x * 8, nch = nrows / 8;
    for (int ch = gw; ch < nch; ch += NGW) {
        const int row0 = ch * 8; const bool isc = row0 >= MX; const int mrow = isc ? 32 : (row0 >> 11);
        const float* src = isc ? srcc + (size_t)(row0 - MX) * DM : srcx + (size_t)row0 * DM;
        const float* sh = MOD + (size_t)mrow * NMOD + ishift * DM; const float* sc = sh + DM;
        f32x4 g[4], s[4];
#pragma unroll
        for (int j = 0; j < 4; ++j) { const int c = 4 * lane + 256 * j; const f32x4 wv = *(const f32x4*)(w + c), scv = *(const f32x4*)(sc + c); g[j] = wv * (scv + 1.f); s[j] = *(const f32x4*)(sh + c); }
        f32x4 nx[4];
#pragma unroll
        for (int j = 0; j < 4; ++j) nx[j] = ((const f32x4*)src + lane)[64 * j];
        for (int rr = 0; rr < 8; ++rr) {
            f32x4 v[4]; float ss = 0.f;
#pragma unroll
            for (int j = 0; j < 4; ++j) v[j] = nx[j];
            if (rr < 7) { const f32x4* xr = (const f32x4*)(src + (size_t)(rr + 1) * DM) + lane;
#pragma unroll
                for (int j = 0; j < 4; ++j) nx[j] = xr[64 * j]; }
#pragma unroll
            for (int j = 0; j < 4; ++j) ss += (v[j][0] * v[j][0] + v[j][1] * v[j][1]) + (v[j][2] * v[j][2] + v[j][3] * v[j][3]);
            const float rstd = rsqrtf(wave_sum(ss) * (1.f / DM) + EPS);
            u32x2* o = (u32x2*)(H + (size_t)(row0 + rr) * DM) + lane;
#pragma unroll
            for (int j = 0; j < 4; ++j) { const f32x4 y = v[j] * rstd * g[j] + s[j]; u32x2 ov; ov.x = pk2(y[0], y[1]); ov.y = pk2(y[2], y[3]); o[64 * j] = ov; }
        }
    }
}

__device__ __forceinline__ void rstd_phase(const bf16_t* PROJ, float* RSQ, float* RSKV) {
    const int tid = threadIdx.x, lane = tid & 63, wave = tid >> 6;
    const int gw = blockIdx.x * 8 + wave, NGW = gridDim.x * 8;
    for (int r4 = gw; r4 < MT / 4; r4 += NGW) {
        unsigned kv[4]; u32x2 q[4];
#pragma unroll
        for (int i = 0; i < 4; ++i) { const int row = 4 * r4 + i; const bf16_t* pr = PROJ + (size_t)row * NPROJ;
            kv[i] = *((const unsigned*)(pr + 256) + lane); q[i] = (row < MX) ? *((const u32x2*)pr + lane) : (u32x2){0u, 0u}; }
#pragma unroll
        for (int i = 0; i < 4; ++i) { const int row = 4 * r4 + i;
            float s2 = bflo(kv[i]) * bflo(kv[i]) + bfhi(kv[i]) * bfhi(kv[i]);
            float s1 = (bflo(q[i].x) * bflo(q[i].x) + bfhi(q[i].x) * bfhi(q[i].x)) + (bflo(q[i].y) * bflo(q[i].y) + bfhi(q[i].y) * bfhi(q[i].y));
            s2 = wave_sum(s2); s1 = wave_sum(s1);
            if (lane == 0) { RSKV[row] = rsqrtf(s2 * (1.f / 128.f) + EPS); if (row < MX) RSQ[row] = rsqrtf(s1 * (1.f / 256.f) + EPS); } }
    }
}

__device__ __forceinline__ void gmlp_phase(const Params& p, unsigned char* lds) {
    unsigned char* ws = p.ws;
    const bf16_t* PROJ = (const bf16_t*)(ws + WS_PROJ); const bf16_t* WSb = (const bf16_t*)(ws + WS_WS); bf16_t* MIX = (bf16_t*)(ws + WS_MIX);
    const int tid = threadIdx.x, lane = tid & 63, wave = tid >> 6, r32 = lane & 31, hi = lane >> 5;
    bf16_t* Vt = (bf16_t*)lds;
    float* vnl = (float*)(lds + 32768); float* bsl = vnl + 512;
    { vnl[tid] = p.vn[tid]; bsl[tid] = p.b_s[tid]; bsl[tid + 512] = p.b_s[tid + 512]; }
    __syncthreads();
    const int pp = tid >> 2, cp = tid & 3;
    const int c0 = 32 * (wave >> 2), p0 = 32 * (wave & 3), pos = p0 + r32;
    u32x4 va, vb2;
    constexpr int NU = NB * 16 * 8;
    const bool bal = gridDim.x == 256;
    const int ubase = bal ? ((int)blockIdx.x < 64 ? (int)blockIdx.x * 13 : 832 + ((int)blockIdx.x - 64) * 17) : (int)blockIdx.x;
    const int ustep = bal ? 1 : (int)gridDim.x;
    const int uend = bal ? ubase + ((int)blockIdx.x < 64 ? 13 : 17) : NU;
    { const int unit = ubase; if (unit < uend) { const int g = unit & 7, n = (unit >> 3) & 15, b = unit >> 7;
        const bf16_t* src0 = PROJ + ((size_t)b * SEQ + n * 128 + pp) * NPROJ + 1024 + 64 * g + 16 * cp; va = *(const u32x4*)src0; vb2 = *(const u32x4*)(src0 + 8); } }
    for (int unit = ubase; unit < uend; unit += ustep) {
        const int g = unit & 7, n = (unit >> 3) & 15, b = unit >> 7;
        const size_t r0 = (size_t)b * SEQ + n * 128;
        bf16x8 wf[8];
        const bf16_t* wrow = WSb + ((size_t)g * 128 + pos) * 128 + 8 * hi;
#pragma unroll
        for (int s = 0; s < 8; ++s) wf[s] = *(const bf16x8*)(wrow + 16 * s);
        const bf16_t* urow = PROJ + (r0 + pos) * NPROJ + 512 + 64 * g + c0 + 4 * hi;
        u32x2 uu[4];
#pragma unroll
        for (int q = 0; q < 4; ++q) uu[q] = *(const u32x2*)(urow + 8 * q);
        const float bias = bsl[g * 128 + pos];
        f32x4 vw[4];
#pragma unroll
        for (int i = 0; i < 4; ++i) vw[i] = *(const f32x4*)(vnl + 64 * g + 16 * cp + 4 * i);
        {
            float v[16];
            v[0] = bflo(va.x); v[1] = bfhi(va.x); v[2] = bflo(va.y); v[3] = bfhi(va.y); v[4] = bflo(va.z); v[5] = bfhi(va.z); v[6] = bflo(va.w); v[7] = bfhi(va.w);
            v[8] = bflo(vb2.x); v[9] = bfhi(vb2.x); v[10] = bflo(vb2.y); v[11] = bfhi(vb2.y); v[12] = bflo(vb2.z); v[13] = bfhi(vb2.z); v[14] = bflo(vb2.w); v[15] = bfhi(vb2.w);
            float ss = 0.f;
#pragma unroll
            for (int i = 0; i < 16; ++i) { v[i] = gelu_f(v[i]); ss += v[i] * v[i]; }
            ss += __shfl_xor(ss, 1); ss += __shfl_xor(ss, 2);
            const float rstd = rsqrtf(ss * (1.f / 64.f) + EPS);
#pragma unroll
            for (int i = 0; i < 16; ++i) { const int c = 16 * cp + i; const float y = v[i] * rstd * vw[i >> 2][i & 3]; Vt[c * 136 + pp] = (bf16_t)(pk2(y, 0.f) & 0xffffu); }
        }
        {
            const int un = unit + ustep; if (un < uend) { const int g2 = un & 7, n2 = (un >> 3) & 15, b2 = un >> 7;
                const bf16_t* src0 = PROJ + ((size_t)b2 * SEQ + n2 * 128 + pp) * NPROJ + 1024 + 64 * g2 + 16 * cp; va = *(const u32x4*)src0; vb2 = *(const u32x4*)(src0 + 8); } }
        __syncthreads();
        {
            f32x16 acc = {};
            const bf16_t* vrow = Vt + (c0 + r32) * 136 + 8 * hi;
#pragma unroll
            for (int s = 0; s < 8; ++s) { const bf16x8 av = *(const bf16x8*)(vrow + 16 * s);
                acc = __builtin_amdgcn_mfma_f32_32x32x16_bf16(av, wf[s], acc, 0, 0, 0); }
            bf16_t* orow = MIX + (r0 + pos) * DM + 512 + 64 * g + c0 + 4 * hi;
#pragma unroll
            for (int q = 0; q < 4; ++q) {
                const float o0 = gelu_f(bflo(uu[q].x)) * (acc[4 * q + 0] + bias), o1 = gelu_f(bfhi(uu[q].x)) * (acc[4 * q + 1] + bias);
                const float o2 = gelu_f(bflo(uu[q].y)) * (acc[4 * q + 2] + bias), o3 = gelu_f(bfhi(uu[q].y)) * (acc[4 * q + 3] + bias);
                u32x2 ov; ov.x = pk2(o0, o1); ov.y = pk2(o2, o3); *(u32x2*)(orow + 8 * q) = ov; }
        }
        __syncthreads();
    }
}

__device__ __forceinline__ void unpack8(float* v, const u32x4 a) { v[0] = bflo(a.x); v[1] = bfhi(a.x); v[2] = bflo(a.y); v[3] = bfhi(a.y); v[4] = bflo(a.z); v[5] = bfhi(a.z); v[6] = bflo(a.w); v[7] = bfhi(a.w); }
__device__ __forceinline__ u32x4 pack8(const float* v) { u32x4 o; o.x = pk2(v[0], v[1]); o.y = pk2(v[2], v[3]); o.z = pk2(v[4], v[5]); o.w = pk2(v[6], v[7]); return o; }
__device__ __forceinline__ float rope_inv(int f) { return f == 0 ? 1.0f : f == 1 ? 0.316227766f : f == 2 ? 0.1f : f == 3 ? 0.0316227766f : f == 4 ? 0.01f : f == 5 ? 0.00316227766f : f == 6 ? 0.001f : 0.000316227766f; }
__device__ __forceinline__ void kprep_phase(const Params& p) {
    unsigned char* ws = p.ws;
    const bf16_t* KN = (const bf16_t*)(ws + WS_KNOPE); const bf16_t* PROJ = (const bf16_t*)(ws + WS_PROJ); bf16_t* KF = (bf16_t*)(ws + WS_KF);
    const int tid = threadIdx.x, lane = tid & 63, wave = tid >> 6, h = lane >> 3, j = lane & 7;
    const int gw = blockIdx.x * 8 + wave, NGW = gridDim.x * 8;
    float wn[8], wp[8];
#pragma unroll
    for (int i = 0; i < 8; ++i) { wn[i] = p.kn[8 * j + i]; wp[i] = p.kn[64 + 8 * (j & 3) + i]; }
    u32x4 na = {}, ne = {};
    if (gw < MT) { na = *(const u32x4*)(KN + (size_t)gw * 512 + h * 64 + 8 * j); ne = *(const u32x4*)(PROJ + (size_t)gw * NPROJ + 384 + 8 * (j & 3)); }
    for (int row = gw; row < MT; row += NGW) {
        float a[8], e[8];
        unpack8(a, na); unpack8(e, ne);
        { const int rn = row + NGW; if (rn < MT) { na = *(const u32x4*)(KN + (size_t)rn * 512 + h * 64 + 8 * j); ne = *(const u32x4*)(PROJ + (size_t)rn * NPROJ + 384 + 8 * (j & 3)); } }
        float ss = 0.f;
#pragma unroll
        for (int i = 0; i < 8; ++i) ss += a[i] * a[i];
        if (j < 4) {
#pragma unroll
            for (int i = 0; i < 8; ++i) ss += e[i] * e[i];
        }
        ss += __shfl_xor(ss, 1); ss += __shfl_xor(ss, 2); ss += __shfl_xor(ss, 4);
        const float rs = rsqrtf(ss * (1.f / 96.f) + EPS);
#pragma unroll
        for (int i = 0; i < 8; ++i) { a[i] *= rs * wn[i]; e[i] *= rs * wp[i]; }
        bf16_t* ko = KF + (size_t)row * 768 + h * 96;
        *(u32x4*)(ko + 8 * j) = pack8(a);
        const bool lat = row < MX; const int pos = row & (SEQ - 1);
        const float fpos = (float)(((j >> 1) & 1) ? (pos & 63) : (pos >> 6));
#pragma unroll
        for (int f = 0; f < 8; ++f) {
            const float partner = __shfl_xor(e[f], 1);
            float sn = 0.f, cs = 1.f;
            if (lat) { const float rev = (fpos * rope_inv(f)) * 0.15915494309189535f; sn = __builtin_amdgcn_sinf(rev); cs = __builtin_amdgcn_cosf(rev); }
            e[f] = e[f] * cs + ((j & 1) ? partner : -partner) * sn;
        }
        if (j < 4) *(u32x4*)(ko + 64 + 8 * j) = pack8(e);
    }
}

constexpr int KSTR = 208, VSTR = 144, KBUF = 64 * KSTR, VBUF = 64 * VSTR;
__device__ __forceinline__ float max3f(float a, float b, float c) { float r; asm("v_max3_f32 %0, %1, %2, %3" : "=v"(r) : "v"(a), "v"(b), "v"(c)); return r; }
__device__ __forceinline__ float swapmax(float m) { auto rr = __builtin_amdgcn_permlane32_swap(__float_as_uint(m), __float_as_uint(m), false, false); return fmaxf(__uint_as_float(rr[0]), __uint_as_float(rr[1])); }
__device__ __forceinline__ float swapadd(float m) { auto rr = __builtin_amdgcn_permlane32_swap(__float_as_uint(m), __float_as_uint(m), false, false); return __uint_as_float(rr[0]) + __uint_as_float(rr[1]); }
#define ASB() __builtin_amdgcn_sched_barrier(0)
struct AttStage { u32x4 k0, k1, v; };
struct AttCtx {
    const bf16_t* KF; const bf16_t* VT; unsigned char* Ks; unsigned char* Vs;
    int tid, b, h, kkey0, kpart0, kkey1, kpart1, vd, vpart, vdst, koff, voff;
};
__device__ __forceinline__ void att_load(const AttCtx& c, int t, AttStage& s) {
    const size_t kr = (t < 32) ? (size_t)c.b * SEQ + t * 64 : (size_t)MX + (size_t)c.b * CTXL + (t - 32) * 64;
    s.k0 = *(const u32x4*)(c.KF + (kr + c.kkey0) * 768 + c.h * 96 + 8 * c.kpart0);
    if (c.tid < 256) s.k1 = *(const u32x4*)(c.KF + (kr + c.kkey1) * 768 + c.h * 96 + 8 * c.kpart1);
    s.v = *(const u32x4*)(c.VT + (size_t)(c.h * 64 + c.vd) * MT + kr + 8 * c.vpart);
}
__device__ __forceinline__ void att_store(const AttCtx& c, int kbuf, int vbuf, const AttStage& s) {
    *(u32x4*)(c.Ks + kbuf * KBUF + c.kkey0 * KSTR + c.kpart0 * 16) = s.k0;
    if (c.tid < 256) *(u32x4*)(c.Ks + kbuf * KBUF + c.kkey1 * KSTR + c.kpart1 * 16) = s.k1;
    *(u32x2*)(c.Vs + vbuf * VBUF + c.vdst) = (u32x2){s.v.x, s.v.y}; *(u32x2*)(c.Vs + vbuf * VBUF + c.vdst + 16) = (u32x2){s.v.z, s.v.w};
}
#define LDK(s_, A, C) do { A = *(const bf16x8*)(kb + (s_) * 32); C = *(const bf16x8*)(kb + 32 * KSTR + (s_) * 32); } while (0)
#define LDV(s_, A, C) do { A = *(const bf16x8*)(vb + (s_) * 32); C = *(const bf16x8*)(vb + 32 * VSTR + (s_) * 32); } while (0)
#define MMA(Acc, A, B) Acc = __builtin_amdgcn_mfma_f32_32x32x16_bf16(A, B, Acc, 0, 0, 0)
#define EXP4(V, i) do { V[i] = fexp2(V[i]); V[i + 1] = fexp2(V[i + 1]); V[i + 2] = fexp2(V[i + 2]); V[i + 3] = fexp2(V[i + 3]); } while (0)
__device__ __forceinline__ void att_iter(const AttCtx& c, int t, int& vcur, const bf16x8 (&qf)[6], f32x16& s0, f32x16& s1, f32x16& o0, f32x16& o1, float& mref, float& lsum, AttStage& L, const AttStage& S) {
    const bool more = t < 36;
    if (t + 2 < 36) att_load(c, t + 2, L);
    const unsigned char* kb = c.Ks + (t & 1) * KBUF + c.koff;
    const unsigned char* vb = c.Vs + vcur * VBUF + c.voff;
    f32x16 n0 = {}, n1 = {};
    u32x4 pw0, pw1, pw2, pw3;
    bf16x8 ka0, kc0, ka1, kc1, va0, vc0, va1, vc1;
    LDK(0, ka0, kc0);
    ASB();
    LDK(1, ka1, kc1);
    if (more) MMA(n0, ka0, qf[0]);
    float ma = max3f(s0[0], s0[1], s0[2]); ma = max3f(ma, s0[3], s0[4]); ma = max3f(ma, s0[5], s0[6]); ma = max3f(ma, s0[7], s0[8]);
    ASB();
    if (more) MMA(n1, kc0, qf[0]);
    ma = max3f(ma, s0[9], s0[10]); ma = max3f(ma, s0[11], s0[12]); ma = max3f(ma, s0[13], s0[14]); ma = fmaxf(ma, s0[15]);
    ASB();
    LDK(2, ka0, kc0);
    if (more) MMA(n0, ka1, qf[1]);
    float mb = max3f(s1[0], s1[1], s1[2]); mb = max3f(mb, s1[3], s1[4]); mb = max3f(mb, s1[5], s1[6]); mb = max3f(mb, s1[7], s1[8]);
    ASB();
    if (more) MMA(n1, kc1, qf[1]);
    mb = max3f(mb, s1[9], s1[10]); mb = max3f(mb, s1[11], s1[12]); mb = max3f(mb, s1[13], s1[14]); mb = max3f(mb, s1[15], ma);
    const float mx = swapmax(mb);
    if (__any(mx > mref + 8.f)) {
        const float mn = fmaxf(mref, mx), alpha = fexp2(mref - mn); mref = mn; lsum *= alpha;
#pragma unroll
        for (int r = 0; r < 16; ++r) { o0[r] *= alpha; o1[r] *= alpha; }
    }
    ASB();
    LDK(3, ka1, kc1);
    if (more) MMA(n0, ka0, qf[2]);
    s0 = s0 - mref; EXP4(s0, 0);
    ASB();
    if (more) MMA(n1, kc0, qf[2]);
    EXP4(s0, 4);
    pw0 = (u32x4){pk2(s0[0], s0[1]), pk2(s0[2], s0[3]), pk2(s0[4], s0[5]), pk2(s0[6], s0[7])};
    ASB();
    LDK(4, ka0, kc0);
    if (more) MMA(n0, ka1, qf[3]);
    EXP4(s0, 8);
    ASB();
    if (more) MMA(n1, kc1, qf[3]);
    EXP4(s0, 12);
    pw1 = (u32x4){pk2(s0[8], s0[9]), pk2(s0[10], s0[11]), pk2(s0[12], s0[13]), pk2(s0[14], s0[15])};
    ASB();
    LDK(5, ka1, kc1);
    if (more) MMA(n0, ka0, qf[4]);
    s1 = s1 - mref; EXP4(s1, 0);
    ASB();
    if (more) MMA(n1, kc0, qf[4]);
    EXP4(s1, 4);
    pw2 = (u32x4){pk2(s1[0], s1[1]), pk2(s1[2], s1[3]), pk2(s1[4], s1[5]), pk2(s1[6], s1[7])};
    ASB();
    LDV(0, va0, vc0);
    if (more) MMA(n0, ka1, qf[5]);
    EXP4(s1, 8);
    ASB();
    if (more) MMA(n1, kc1, qf[5]);
    EXP4(s1, 12);
    pw3 = (u32x4){pk2(s1[8], s1[9]), pk2(s1[10], s1[11]), pk2(s1[12], s1[13]), pk2(s1[14], s1[15])};
    ASB();
    LDV(1, va1, vc1);
    MMA(o0, va0, __builtin_bit_cast(bf16x8, pw0)); MMA(o1, vc0, __builtin_bit_cast(bf16x8, pw0));
    { const f32x16 sv = s0 + s1; lsum += ((sv[0] + sv[1]) + (sv[2] + sv[3])) + ((sv[4] + sv[5]) + (sv[6] + sv[7])) + ((sv[8] + sv[9]) + (sv[10] + sv[11])) + ((sv[12] + sv[13]) + (sv[14] + sv[15])); }
    ASB();
    LDV(2, va0, vc0);
    MMA(o0, va1, __builtin_bit_cast(bf16x8, pw1)); MMA(o1, vc1, __builtin_bit_cast(bf16x8, pw1));
    ASB();
    LDV(3, va1, vc1);
    MMA(o0, va0, __builtin_bit_cast(bf16x8, pw2)); MMA(o1, vc0, __builtin_bit_cast(bf16x8, pw2));
    ASB();
    MMA(o0, va1, __builtin_bit_cast(bf16x8, pw3)); MMA(o1, vc1, __builtin_bit_cast(bf16x8, pw3));
    ASB();
    if (t + 1 < 36) { const int vn = (vcur == 0) ? 2 : vcur - 1; att_store(c, (t + 1) & 1, vn, S); }
    asm volatile("s_waitcnt lgkmcnt(0)" ::: "memory"); __builtin_amdgcn_s_barrier(); asm volatile("" ::: "memory");
    s0 = n0; s1 = n1; vcur = (vcur == 2) ? 0 : vcur + 1;
}
__device__ __forceinline__ void attn_phase(const Params& p, unsigned char* lds) {
    unsigned char* ws = p.ws;
    const bf16_t* Q = (const bf16_t*)(ws + WS_QRAW); bf16_t* MIX = (bf16_t*)(ws + WS_MIX);
    const int tid = threadIdx.x, lane = tid & 63, wave = tid >> 6, r32 = lane & 31, hi = lane >> 5;
    AttCtx c; c.KF = (const bf16_t*)(ws + WS_KF); c.VT = (const bf16_t*)(ws + WS_VT); c.Ks = lds; c.Vs = lds + 2 * KBUF; c.tid = tid;
    const int bx = blockIdx.x, G = gridDim.x;
    const int vcu = (G % 8 == 0) ? (bx % 8) * (G / 8) + bx / 8 : bx;
    c.kkey0 = tid / 12; c.kpart0 = tid % 12; c.kkey1 = (tid + 512) / 12; c.kpart1 = (tid + 512) % 12;
    c.vd = tid >> 3; c.vpart = tid & 7;
    c.vdst = c.vd * VSTR + (c.vpart >> 1) * 32 + (c.vpart & 1) * 8;
    c.koff = r32 * KSTR + hi * 16; c.voff = r32 * VSTR + hi * 16;
    for (int unit = vcu; unit < NB * NH * 8; unit += G) {
        const int qb = unit & 7, h = (unit >> 3) & 7, b = unit >> 6;
        c.b = b; c.h = h;
        const size_t qrow = (size_t)b * SEQ + qb * 256 + wave * 32 + r32;
        bf16x8 qf[6];
        {
            float qv[6][8]; float ss = 0.f;
#pragma unroll
            for (int s = 0; s < 6; ++s) { unpack8(qv[s], *(const u32x4*)(Q + qrow * 768 + h * 96 + 16 * s + 8 * hi));
#pragma unroll
                for (int i = 0; i < 8; ++i) ss += qv[s][i] * qv[s][i]; }
            ss += __shfl_xor(ss, 32);
            const float rs = rsqrtf(ss * (1.f / 96.f) + EPS) * QSCALE;
#pragma unroll
            for (int s = 0; s < 6; ++s)
#pragma unroll
                for (int i = 0; i < 8; ++i) qv[s][i] *= rs * p.qn[16 * s + 8 * hi + i];
            const int pos = (int)(qrow & (SEQ - 1));
#pragma unroll
            for (int s = 4; s < 6; ++s) { const float fpos = (float)(s == 4 ? (pos >> 6) : (pos & 63));
#pragma unroll
                for (int f = 0; f < 8; ++f) { const float partner = __shfl_xor(qv[s][f], 32);
                    const float rev = (fpos * rope_inv(f)) * 0.15915494309189535f; const float sn = __builtin_amdgcn_sinf(rev), cs = __builtin_amdgcn_cosf(rev);
                    qv[s][f] = qv[s][f] * cs + (hi ? partner : -partner) * sn; } }
#pragma unroll
            for (int s = 0; s < 6; ++s) qf[s] = __builtin_bit_cast(bf16x8, pack8(qv[s]));
        }
        float mref = -1e30f, lsum = 0.f; f32x16 o0 = {}, o1 = {};
        AttStage A, B; A.k1 = (u32x4){0u, 0u, 0u, 0u}; B.k1 = A.k1;
        att_load(c, 0, A); att_store(c, 0, 0, A);
        asm volatile("s_waitcnt lgkmcnt(0)" ::: "memory"); __builtin_amdgcn_s_barrier(); asm volatile("" ::: "memory");
        att_load(c, 1, A); att_load(c, 2, B);
        f32x16 s0 = {}, s1 = {};
        { const unsigned char* kb = c.Ks + c.koff; bf16x8 ka, kc;
#pragma unroll
          for (int s = 0; s < 6; ++s) { LDK(s, ka, kc); MMA(s0, ka, qf[s]); MMA(s1, kc, qf[s]); } }
        att_store(c, 1, 1, A);
        asm volatile("s_waitcnt lgkmcnt(0)" ::: "memory"); __builtin_amdgcn_s_barrier(); asm volatile("" ::: "memory");
        int vcur = 0;
        for (int t = 1; t <= 35; t += 2) {
            att_iter(c, t, vcur, qf, s0, s1, o0, o1, mref, lsum, A, B);
            att_iter(c, t + 1, vcur, qf, s0, s1, o0, o1, mref, lsum, B, A);
        }
        lsum = swapadd(lsum);
        const float il = 1.f / lsum;
        bf16_t* orow = MIX + qrow * DM + h * 64 + 4 * hi;
#pragma unroll
        for (int q = 0; q < 4; ++q) {
            u32x2 a; a.x = pk2(o0[4 * q] * il, o0[4 * q + 1] * il); a.y = pk2(o0[4 * q + 2] * il, o0[4 * q + 3] * il); *(u32x2*)(orow + 8 * q) = a;
            u32x2 cc; cc.x = pk2(o1[4 * q] * il, o1[4 * q + 1] * il); cc.y = pk2(o1[4 * q + 2] * il, o1[4 * q + 3] * il); *(u32x2*)(orow + 32 + 8 * q) = cc;
        }
    }
}
#undef LDK
#undef LDV
#undef MMA
#undef EXP4
#undef ASB

constexpr int NPHASE = 12;
__global__ void __launch_bounds__(512, 2) mega_fwd(Params p) {
    extern __shared__ __attribute__((aligned(16))) unsigned char lds[];
    LAS unsigned char* ldsl = (LAS unsigned char*)lds;
    unsigned char* ws = p.ws;
    const int G = gridDim.x, bx = blockIdx.x;
    float* MOD = (float*)(ws + WS_MOD);
    bf16_t* H = (bf16_t*)(ws + WS_H); bf16_t* ACT = (bf16_t*)(ws + WS_ACT); bf16_t* PROJ = (bf16_t*)(ws + WS_PROJ);
    float* X1C = (float*)(ws + WS_X1C); float* RSQ = (float*)(ws + WS_RSQ); float* RSKV = (float*)(ws + WS_RSKV);
    const int lo = p.ph_lo, hi = p.ph_hi;
#define IN(k) (lo <= (k) && (k) < hi)
#define SEAM(k) do { if (IN(k) && IN((k) + 1)) { cg::this_grid().sync(); } } while (0)
    using pg8::Gemm; using pg8::StaticOrder;

    if (IN(0)) { phase0(p, (float*)lds); } SEAM(0);
    if (IN(1)) { norm_mod_phase(p.x, p.ctx, MT, p.norm1, MOD, 0, H); } SEAM(1);
    if (IN(2)) { Gemm g{H, (const bf16_t*)(ws + WS_W13A), MT, 2 * DFF, DM, DM, DM}; StaticOrder S; S.init(MT, 2 * DFF, G, bx);
        pg8::EpiSwigluT<false> E{ACT, DFF, nullptr, nullptr}; pg8::gemm_phase(ldsl, g, S, E);
        { const int fi = S.nwg % G, np = fi ? G - fi : G, wi = fi ? bx - fi : bx; const int wave = threadIdx.x >> 6, lane = threadIdx.x & 63;
          if (wi >= 0) { tr_set(p, 1, wi * 8 + wave, np * 8, (float*)lds + wave * 4096, lane); } __syncthreads(); } } SEAM(2);
    if (IN(3)) { Gemm g{ACT, (const bf16_t*)(ws + WS_W2A), MT, DM, DFF, DFF, DFF}; StaticOrder S; S.init(MT, DM, G, bx);
        pg8::EpiRes<MX / 256, 1, true> E{p.x, p.ctx, p.out, X1C, MOD + 2 * DM, p.norm2, MOD + 4 * DM, H, (float*)(ws + WS_SS2)}; pg8::gemm_phase<pg8::EpiRes<MX / 256, 1, true>, StaticOrder, true>(ldsl, g, S, E);
        { const int fi = S.nwg % G, np = fi ? G - fi : G, wi = fi ? bx - fi : bx; const int tid = threadIdx.x, wave = tid >> 6, lane = tid & 63;
          if (wi >= 0) {
            for (int it = wi; it < 111; it += np) {
                if (it < 23) rowmat_item<false>(MOD + 3 * DM, NMOD, MOD + (size_t)32 * NMOD + 3 * DM, p.w_in, 1440, it, nullptr, (float*)(ws + WS_SWIN), NPROJ, 1, (float*)lds, tid);
                else if (it < 67) rowmat_item<false>(MOD + 6 * DM, NMOD, MOD + (size_t)32 * NMOD + 6 * DM, p.f2w1, DFF, it - 23, nullptr, (float*)(ws + WS_SW13), 2 * DFF, 2, (float*)lds, tid);
                else rowmat_item<false>(MOD + 6 * DM, NMOD, MOD + (size_t)32 * NMOD + 6 * DM, p.f2w3, DFF, it - 67, nullptr, (float*)(ws + WS_SW13), 2 * DFF, 3, (float*)lds, tid);
            }
            tr_set(p, 2, wi * 8 + wave, np * 8, (float*)lds + wave * 4096, lane); } __syncthreads(); } } SEAM(3);
    if (IN(4)) {
        { Gemm g{H, (const bf16_t*)(ws + WS_WIN), MX, NPROJ, DM, DM, DM}; StaticOrder S; S.init(MX, NPROJ, G, bx);
          pg8::EpiBf16S E{PROJ, NPROJ, nullptr, nullptr, (const float*)(ws + WS_SS2), (const float*)(ws + WS_SWIN), NPROJ, -1}; pg8::gemm_phase(ldsl, g, S, E); }
        { Gemm g{H + (size_t)MX * DM, (const bf16_t*)(ws + WS_WIN) + (size_t)256 * DM, MC, 256, DM, DM, DM}; StaticOrder S; S.init(MC, 256, G, bx);
          pg8::EpiBf16S E{PROJ + (size_t)MX * NPROJ + 256, NPROJ, nullptr, nullptr, (const float*)(ws + WS_SS2) + MX, (const float*)(ws + WS_SWIN) + 256, NPROJ, 32}; pg8::gemm_phase(ldsl, g, S, E); }
    } SEAM(4);
    if (IN(5)) { rstd_phase(PROJ, RSQ, RSKV); } SEAM(5);
    if (IN(6)) {
        { Gemm g{PROJ, (const bf16_t*)(ws + WS_WUQ), MX, 768, 256, NPROJ, 256}; StaticOrder S; S.init(MX, 768, G, bx);
          pg8::EpiBf16S E{(bf16_t*)(ws + WS_QRAW), 768, RSQ, nullptr, nullptr, nullptr, 0, 0}; pg8::gemm_phase(ldsl, g, S, E); }
        { Gemm g{PROJ + 256, (const bf16_t*)(ws + WS_WK), MT, 512, 256, NPROJ, 256}; StaticOrder S; S.init(MT, 512, G, bx);
          pg8::EpiBf16S E{(bf16_t*)(ws + WS_KNOPE), 512, RSKV, nullptr, nullptr, nullptr, 0, 0}; pg8::gemm_phase(ldsl, g, S, E); }
        { Gemm g{(const bf16_t*)(ws + WS_WV), PROJ + 256, 512, MT, 256, 256, NPROJ}; StaticOrder S; S.init(512, MT, G, bx);
          pg8::EpiBf16S E{(bf16_t*)(ws + WS_VT), MT, nullptr, RSKV, nullptr, nullptr, 0, 0}; pg8::gemm_phase(ldsl, g, S, E); }
        gmlp_phase(p, lds);
    } SEAM(6);
    if (IN(7)) { kprep_phase(p); } SEAM(7);
    if (IN(8)) { attn_phase(p, lds); } SEAM(8);
    if (IN(9)) { Gemm g{(const bf16_t*)(ws + WS_MIX), (const bf16_t*)(ws + WS_WOUT), MX, DM, DM, DM, DM}; StaticOrder S; S.init(MX, DM, G, bx);
        pg8::EpiRes<(1 << 30), 2, true> E{p.out, nullptr, p.out, nullptr, MOD + 5 * DM, p.norm3, MOD + 7 * DM, (bf16_t*)(ws + WS_H3), (float*)(ws + WS_SS3)}; pg8::gemm_phase(ldsl, g, S, E); } SEAM(9);
    if (IN(10)) { Gemm g{(const bf16_t*)(ws + WS_H3), (const bf16_t*)(ws + WS_W13B), MX, 2 * DFF, DM, DM, DM}; StaticOrder S; S.init(MX, 2 * DFF, G, bx);
        pg8::EpiSwigluT<true> E{ACT, DFF, (const float*)(ws + WS_SS3), (const float*)(ws + WS_SW13)}; pg8::gemm_phase(ldsl, g, S, E); } SEAM(10);
    if (IN(11)) { Gemm g{ACT, (const bf16_t*)(ws + WS_W2B), MX, DM, DFF, DFF, DFF}; StaticOrder S; S.init(MX, DM, G, bx);
        pg8::EpiRes<(1 << 30), 1, false> E{p.out, nullptr, p.out, nullptr, MOD + 8 * DM, nullptr, nullptr, nullptr, nullptr}; pg8::gemm_phase<pg8::EpiRes<(1 << 30), 1, false>, StaticOrder, true>(ldsl, g, S, E); }
#undef IN
#undef SEAM
}

extern "C" void kernel_launch(void* const* d_in, const int* in_sizes, int n_in, void* d_out, int out_size, void* d_ws, size_t ws_size, hipStream_t stream) {
    static int grid = 0;
    if (grid == 0) {
        if (n_in != 26 || in_sizes[0] != MX * DM || out_size != MX * DM || ws_size < WS_END) { fprintf(stderr, "kernel_launch: unexpected shapes (n_in %d, in0 %d, out %d, ws %zu)\n", n_in, n_in > 0 ? in_sizes[0] : -1, out_size, ws_size); grid = -1; return; }
        int dev = 0, cus = 0, per_cu = 0;
        if (hipGetDevice(&dev) != hipSuccess || hipDeviceGetAttribute(&cus, hipDeviceAttributeMultiprocessorCount, dev) != hipSuccess) { grid = -1; return; }
        if (hipFuncSetAttribute((const void*)mega_fwd, hipFuncAttributeMaxDynamicSharedMemorySize, LDS_BYTES) != hipSuccess) { fprintf(stderr, "kernel_launch: hipFuncSetAttribute failed\n"); grid = -1; return; }
        if (hipOccupancyMaxActiveBlocksPerMultiprocessor(&per_cu, (const void*)mega_fwd, 512, LDS_BYTES) != hipSuccess || per_cu < 1) { fprintf(stderr, "kernel_launch: occupancy query says %d\n", per_cu); per_cu = 1; }
        (void)hipGetLastError();
        grid = cus;
    }
    if (grid < 0) return;
    Params p{};
    const float** pp = (const float**)&p;
    for (int i = 0; i < 26; ++i) pp[i] = (const float*)d_in[i];
    p.out = (float*)d_out; p.ws = (unsigned char*)d_ws;
#if MK_ONE_LAUNCH
    p.ph_lo = 0; p.ph_hi = NPHASE;
    void* args[] = {&p};
    hipError_t e = hipLaunchCooperativeKernel((const void*)mega_fwd, dim3(grid), dim3(512), args, LDS_BYTES, stream);
    if (e != hipSuccess) fprintf(stderr, "cooperative launch failed: %s (grid %d)\n", hipGetErrorString(e), grid);
#else
    for (int ph = 0; ph < NPHASE; ++ph) {
        p.ph_lo = ph; p.ph_hi = ph + 1;
        hipLaunchKernelGGL(mega_fwd, dim3(grid), dim3(512), LDS_BYTES, stream, p);
    }
#endif
}
```

```cpp
#include <hip/hip_runtime.h>
#include <hip/hip_cooperative_groups.h>
#include <cstdio>
#include <cstdint>
namespace cg = cooperative_groups;

#ifndef MK_ONE_LAUNCH
#define MK_ONE_LAUNCH 1
#endif

#define LAS __attribute__((address_space(3)))
typedef unsigned short bf16_t;
typedef short bf16x8 __attribute__((ext_vector_type(8)));
typedef float f32x4 __attribute__((ext_vector_type(4)));
typedef float f32x16 __attribute__((ext_vector_type(16)));
typedef unsigned u32x4 __attribute__((ext_vector_type(4)));
typedef unsigned u32x2 __attribute__((ext_vector_type(2)));

constexpr int DM = 1024, NB = 32, SEQ = 2048, CTXL = 256, DFF = 2816;
constexpr int MX = NB * SEQ;
constexpr int MC = NB * CTXL;
constexpr int MT = MX + MC;
constexpr int NMOD = 9 * DM;
constexpr int NPROJ = 1536;
constexpr int NH = 8, DQK = 96, DV = 64;
constexpr float EPS = 1e-6f;
constexpr float QSCALE = 0.10206207261596577f * 1.4426950408889634f;

constexpr size_t MiB = 1u << 20;
constexpr size_t WS_MOD = 1 * MiB, WS_RSQ = 3 * MiB, WS_RSKV = 3 * MiB + 512 * 1024;
constexpr size_t WS_W13A = 4 * MiB, WS_W2A = 15 * MiB, WS_W13B = 21 * MiB, WS_W2B = 32 * MiB, WS_WIN = 38 * MiB;
constexpr size_t WS_WUQ = 41 * MiB, WS_WK = 41 * MiB + 512 * 1024, WS_WV = 41 * MiB + 768 * 1024, WS_WOUT = 42 * MiB, WS_WS = 44 * MiB;
constexpr size_t WS_X1C = 46 * MiB, WS_H = 80 * MiB, WS_ACT = 224 * MiB;
constexpr size_t WS_PROJ = 224 * MiB, WS_QRAW = 440 * MiB, WS_KNOPE = 536 * MiB;
constexpr size_t WS_KF = 620 * MiB, WS_VT = 728 * MiB, WS_END = 800 * MiB;
constexpr size_t WS_MIX = WS_H;
constexpr size_t WS_SWIN = 44 * MiB + 512 * 1024, WS_SW13 = 45 * MiB, WS_SS2 = 78 * MiB, WS_SS3 = 78 * MiB + 512 * 1024;
constexpr size_t WS_H3 = WS_KF;

constexpr int LDS_BYTES = 147456;

__device__ __forceinline__ unsigned pk2(float lo, float hi) {
    typedef float f2 __attribute__((ext_vector_type(2))); typedef __bf16 b2 __attribute__((ext_vector_type(2)));
    f2 v = {lo, hi}; b2 b = __builtin_convertvector(v, b2); return __builtin_bit_cast(unsigned, b);
}
__device__ __forceinline__ float bflo(unsigned w) { return __uint_as_float(w << 16); }
__device__ __forceinline__ float bfhi(unsigned w) { return __uint_as_float(w & 0xffff0000u); }
__device__ __forceinline__ float fexp2(float x) { return __builtin_amdgcn_exp2f(x); }
__device__ __forceinline__ float frcp(float x) { return __builtin_amdgcn_rcpf(x); }
__device__ __forceinline__ float silu_f(float a) { return a * frcp(1.f + fexp2(-1.4426950408889634f * a)); }
__device__ __forceinline__ float gelu_f(float x) { const float y = 0.7978845608028654f * (x + 0.044715f * x * x * x); return x * frcp(1.f + fexp2(-2.8853900817779268f * y)); }
__device__ __forceinline__ float wave_sum(float v) {
#pragma unroll
    for (int o = 1; o < 64; o <<= 1) v += __shfl_xor(v, o);
    return v;
}
#define LDS_WAIT() asm volatile("s_waitcnt lgkmcnt(0)" ::: "memory")

namespace pg8 {
constexpr int BM = 256, BK = 64, HALF = 128, HTB = HALF * BK * 2, STAGE_BYTES = 8 * HTB, NXCD = 8, WGM = 4;
__host__ __device__ __forceinline__ int lds_byte(int r, int c) { const int st = (r >> 4) * 2 + (c >> 5), rr = r & 15, cc = c & 31, ob = rr * 64 + cc * 2; return st * 1024 + (ob ^ (((ob >> 9) & 1) << 5)); }
__host__ __device__ __forceinline__ void stage_rc(int b, int& R, int& C) { const int st = b / 1024, sb = b % 1024, swz = sb ^ (((sb >> 9) & 1) << 5); R = (st >> 1) * 16 + swz / 64; C = (st & 1) * 32 + (swz % 64) / 2; }
__host__ __device__ __forceinline__ int perm32(int rho) { const int n = rho >> 4, i = rho & 15; return 8 * (i >> 2) + 4 * n + (i & 3); }

struct Unit { int pm, pn; };
struct Gemm { const bf16_t* A; const bf16_t* Bt; int M, N, K, lda, ldb; };

struct StaticOrder {
    int nM, nN, nwg, G, c;
    __device__ void init(int M, int N, int G_, int c_) { nM = M / BM; nN = N / BM; nwg = nM * nN; G = G_; c = c_; }
    __device__ bool next(int i, Unit& u) const {
        const long L = (long)i * G + c; if (L >= nwg) return false;
        int wgid = (int)L; { const int q = nwg / NXCD, r = nwg % NXCD, xcd = wgid % NXCD, off = wgid / NXCD; wgid = (xcd < r ? xcd * (q + 1) : r * (q + 1) + (xcd - r) * q) + off; }
        const int nig = WGM * nN, gid = wgid / nig, fm = gid * WGM, gsz = (nM - fm) < WGM ? (nM - fm) : WGM;
        u.pm = fm + ((wgid % nig) % gsz); u.pn = (wgid % nig) / gsz; return true;
    }
};

template <bool NORM, bool TILED = true> struct EpiSwigluT {
    static constexpr bool PERM = true;
    bf16_t* O; int ldc; const float* SSn; const float* cb;
    __device__ __forceinline__ void operator()(const f32x4 (&acc)[2][2][4][2], const Unit& u, int wr, int wc, int fr, int fq) const {
        const int row0 = u.pm * BM + wr * 64 + fr, col0 = u.pn * HALF + wc * 32 + 8 * fq;
        f32x4 cv[2][2];
        if (NORM) {
            const float* cbp = cb + (size_t)(u.pm >> 3) * (2 * DFF) + u.pn * BM + wc * 32 + 8 * fq;
#pragma unroll
            for (int bj = 0; bj < 2; ++bj)
#pragma unroll
                for (int n = 0; n < 2; ++n) cv[bj][n] = *(const f32x4*)(cbp + bj * HALF + 4 * n);
        }
#pragma unroll
        for (int ai = 0; ai < 2; ++ai)
#pragma unroll
            for (int m = 0; m < 4; ++m) {
                const int row = row0 + ai * HALF + m * 16;
                bf16_t* rowp = TILED ? O + ((size_t)((row >> 4) * (ldc >> 5) + (col0 >> 5)) * 512 + (row & 15) * 32 + (col0 & 31)) : O + (size_t)row * ldc + col0;
                f32x4 a0 = acc[ai][0][m][0], a1 = acc[ai][0][m][1], b0 = acc[ai][1][m][0], b1 = acc[ai][1][m][1];
                if (NORM) { const float r = rsqrtf(SSn[row] * (1.f / DM) + EPS); a0 = a0 * r + cv[0][0]; a1 = a1 * r + cv[0][1]; b0 = b0 * r + cv[1][0]; b1 = b1 * r + cv[1][1]; }
                u32x4 w;
                w.x = pk2(silu_f(a0[0]) * b0[0], silu_f(a0[1]) * b0[1]); w.y = pk2(silu_f(a0[2]) * b0[2], silu_f(a0[3]) * b0[3]);
                w.z = pk2(silu_f(a1[0]) * b1[0], silu_f(a1[1]) * b1[1]); w.w = pk2(silu_f(a1[2]) * b1[2], silu_f(a1[3]) * b1[3]);
                *(u32x4*)rowp = w;
            }
    }
};
template <int ctx_tile0, int COEF2, bool NORM> struct EpiRes {
    static constexpr bool PERM = true;
    const float* bx; const float* bc; float* ox; float* oc; const float* gate;
    const float* nw; const float* nscale; bf16_t* Hn; float* SS;
    __device__ __forceinline__ void operator()(const f32x4 (&acc)[2][2][4][2], const Unit& u, int wr, int wc, int fr, int fq) const {
        asm volatile("" : "+v"(fr), "+v"(fq));
        const bool isc = u.pm >= ctx_tile0;
        const int mrow = isc ? 32 : (u.pm >> 3);
        const int prow = isc ? (u.pm - ctx_tile0) : u.pm;
        const float* base = isc ? bc : bx; float* out = isc ? oc : ox;
        const int col0 = u.pn * BM + wc * 32 + 8 * fq;
        f32x4 gv[2][2], G[2][2]; float ssv[2][4];
#pragma unroll
        for (int bj = 0; bj < 2; ++bj)
#pragma unroll
            for (int n = 0; n < 2; ++n) { const int c = col0 + bj * HALF + 4 * n; gv[bj][n] = *(const f32x4*)(gate + (size_t)mrow * NMOD + c) * (0.5f * COEF2);
                if (NORM) G[bj][n] = *(const f32x4*)(nw + c) * (*(const f32x4*)(nscale + (size_t)mrow * NMOD + c) + 1.f); }
#pragma unroll
        for (int ai = 0; ai < 2; ++ai)
#pragma unroll
            for (int m = 0; m < 4; ++m) {
                const int rl = ai * HALF + wr * 64 + m * 16 + fr;
                const size_t off = (size_t)(prow * BM + rl) * DM + col0;
                const size_t hrow = (size_t)u.pm * BM + rl;
                float ss = 0.f;
#pragma unroll
                for (int bj = 0; bj < 2; ++bj) {
                    const f32x4 o0 = *(const f32x4*)(base + off + bj * HALF) + gv[bj][0] * acc[ai][bj][m][0];
                    const f32x4 o1 = *(const f32x4*)(base + off + bj * HALF + 4) + gv[bj][1] * acc[ai][bj][m][1];
                    if (!isc) { *(f32x4*)(out + off + bj * HALF) = o0; *(f32x4*)(out + off + bj * HALF + 4) = o1; }
                    if (NORM) {
                        ss += (o0[0] * o0[0] + o0[1] * o0[1]) + (o0[2] * o0[2] + o0[3] * o0[3]) + (o1[0] * o1[0] + o1[1] * o1[1]) + (o1[2] * o1[2] + o1[3] * o1[3]);
                        const f32x4 h0 = o0 * G[bj][0], h1 = o1 * G[bj][1];
                        u32x4 w; w.x = pk2(h0[0], h0[1]); w.y = pk2(h0[2], h0[3]); w.z = pk2(h1[0], h1[1]); w.w = pk2(h1[2], h1[3]);
                        *(u32x4*)(Hn + hrow * DM + col0 + bj * HALF) = w;
                    }
                }
                if (NORM) { ss += __shfl_xor(ss, 16); ss += __shfl_xor(ss, 32); ssv[ai][m] = ss; }
            }
        if (NORM) {
            asm volatile("" ::: "memory");
#pragma unroll
            for (int ai = 0; ai < 2; ++ai)
#pragma unroll
                for (int m = 0; m < 4; ++m)
                    if (fq == 0) __hip_atomic_fetch_add(SS + (size_t)u.pm * BM + ai * HALF + wr * 64 + m * 16 + fr, ssv[ai][m], __ATOMIC_RELAXED, __HIP_MEMORY_SCOPE_AGENT);
        }
    }
};
struct EpiBf16S {
    static constexpr bool PERM = true;
    bf16_t* O; int ldc; const float* rs; const float* cs; const float* SSn; const float* cb; int ldcb; int mrow_fixed;
    __device__ __forceinline__ void operator()(const f32x4 (&acc)[2][2][4][2], const Unit& u, int wr, int wc, int fr, int fq) const {
        const int row0 = u.pm * BM + wr * 64 + fr, col0 = u.pn * BM + wc * 32 + 8 * fq;
        const int mrow = mrow_fixed >= 0 ? mrow_fixed : (u.pm >> 3);
        f32x4 cv[2][2], bv[2][2];
#pragma unroll
        for (int bj = 0; bj < 2; ++bj)
#pragma unroll
            for (int n = 0; n < 2; ++n) { cv[bj][n] = cs ? *(const f32x4*)(cs + col0 + bj * HALF + 4 * n) : (f32x4){1.f, 1.f, 1.f, 1.f};
                bv[bj][n] = cb ? *(const f32x4*)(cb + (size_t)mrow * ldcb + col0 + bj * HALF + 4 * n) : (f32x4){0.f, 0.f, 0.f, 0.f}; }
#pragma unroll
        for (int ai = 0; ai < 2; ++ai)
#pragma unroll
            for (int m = 0; m < 4; ++m) {
                const int row = row0 + ai * HALF + m * 16;
                const float r = SSn ? rsqrtf(SSn[row] * (1.f / DM) + EPS) : (rs ? rs[row] : 1.f);
                bf16_t* rowp = O + (size_t)row * ldc + col0;
#pragma unroll
                for (int bj = 0; bj < 2; ++bj) {
                    const f32x4 v0 = acc[ai][bj][m][0] * cv[bj][0] * r + bv[bj][0], v1 = acc[ai][bj][m][1] * cv[bj][1] * r + bv[bj][1];
                    u32x4 w; w.x = pk2(v0[0], v0[1]); w.y = pk2(v0[2], v0[3]); w.z = pk2(v1[0], v1[1]); w.w = pk2(v1[2], v1[3]);
                    *(u32x4*)(rowp + bj * HALF) = w;
                }
            }
    }
};

template <class Epi, class Sched, bool TILEDA = false>
__device__ __forceinline__ void gemm_phase(LAS unsigned char* lds, const Gemm g, const Sched& S, const Epi& E) {
    const int tid = threadIdx.x, wid = __builtin_amdgcn_readfirstlane(tid >> 6), lane = tid & 63, wr = wid >> 2, wc = wid & 3, fr = lane & 15, fq = lane >> 4;
    const int K = g.K, nt = K / BK;
    unsigned voffA[2], voffB[2];
#pragma unroll
    for (int i = 0; i < 2; ++i) { int R, C; stage_rc(tid * 16 + i * 8192, R, C); const int Rb = Epi::PERM ? ((R & ~31) + perm32(R & 31)) : R;
        voffA[i] = TILEDA ? (unsigned)(((R >> 4) * (g.lda >> 5) + (C >> 5)) * 1024 + (R & 15) * 64 + (C & 31) * 2) : (unsigned)(R * g.lda + C) * 2u;
        voffB[i] = (unsigned)(Rb * g.ldb + C) * 2u; }
    const size_t kstep = (size_t)(BK * 2), kstepA = TILEDA ? (size_t)2048 : kstep;
    const size_t hA = TILEDA ? (size_t)(HALF / 16) * (g.lda >> 5) * 1024 : (size_t)HALF * g.lda * 2, hB = (size_t)HALF * g.ldb * 2;
    const size_t tA = 2 * hA, tB = 2 * hB;
    const unsigned ldsw = (unsigned)wid * 1024u;
    const int aoff = lds_byte(wr * 64 + fr, fq * 8), boff = lds_byte(wc * 32 + fr, fq * 8);
#define PG8_SA(b, h) (((b) * 2 + (h)) * HTB)
#define PG8_SB(b, h) ((4 + (b) * 2 + (h)) * HTB)
#define PG8_STAGE(bufoff, gbase, voff) do { _Pragma("unroll") for (int _i = 0; _i < 2; ++_i) \
        __builtin_amdgcn_global_load_lds((const unsigned*)((const char*)(gbase) + (voff)[_i]), (LAS unsigned*)(lds + (bufoff) + ldsw + _i * 8192), 16, 0, 0); } while (0)
#define PG8_LDA(dst, b, h) do { _Pragma("unroll") for (int m = 0; m < 4; ++m) _Pragma("unroll") for (int k = 0; k < 2; ++k) dst[m][k] = *(const LAS bf16x8*)(lds + PG8_SA(b, h) + aoff + m * 2048 + k * 1024); } while (0)
#define PG8_LDB(dst, b, h) do { _Pragma("unroll") for (int n = 0; n < 2; ++n) _Pragma("unroll") for (int k = 0; k < 2; ++k) dst[n][k] = *(const LAS bf16x8*)(lds + PG8_SB(b, h) + boff + n * 2048 + k * 1024); } while (0)
#define PG8_MMA(ai, bj, At, Bt) do { __builtin_amdgcn_s_setprio(1); _Pragma("unroll") for (int m = 0; m < 4; ++m) _Pragma("unroll") for (int n = 0; n < 2; ++n) _Pragma("unroll") for (int k = 0; k < 2; ++k) \
        acc[ai][bj][m][n] = __builtin_amdgcn_mfma_f32_16x16x32_bf16(Bt[n][k], At[m][k], acc[ai][bj][m][n], 0, 0, 0); __builtin_amdgcn_s_setprio(0); } while (0)
#define PG8_WAIT_V(n) asm volatile("s_waitcnt vmcnt(" #n ")" ::: "memory")
#define PG8_WAIT_L(n) asm volatile("s_waitcnt lgkmcnt(" #n ")" ::: "memory")
#define PG8_BAR __builtin_amdgcn_s_barrier()
#define PG8_SCHED __builtin_amdgcn_sched_barrier(0)
    Unit cur, nxt; int ui = 0;
    if (!S.next(0, cur)) return;
    f32x4 acc[2][2][4][2];
#pragma unroll
    for (int a = 0; a < 2; ++a)
#pragma unroll
        for (int b = 0; b < 2; ++b)
#pragma unroll
            for (int m = 0; m < 4; ++m)
#pragma unroll
                for (int n = 0; n < 2; ++n) acc[a][b][m][n] = (f32x4){0.f, 0.f, 0.f, 0.f};
    bf16x8 At[4][2], B0[2][2], B1[2][2];
    const char* cA = (const char*)g.A + (size_t)cur.pm * tA; const char* cB = (const char*)g.Bt + (size_t)cur.pn * tB;
    PG8_STAGE(PG8_SB(0, 0), cB, voffB); PG8_STAGE(PG8_SB(0, 1), cB + hB, voffB); PG8_STAGE(PG8_SA(0, 0), cA, voffA); PG8_STAGE(PG8_SA(0, 1), cA + hA, voffA);
    if (wr == 1) PG8_BAR;
    PG8_WAIT_V(2); PG8_BAR;
    PG8_STAGE(PG8_SB(1, 0), cB + kstep, voffB); PG8_STAGE(PG8_SA(1, 0), cA + kstepA, voffA); PG8_STAGE(PG8_SB(1, 1), cB + hB + kstep, voffB);
    PG8_WAIT_V(6); PG8_BAR;
    for (;;) {
        const bool has_next = S.next(ui + 1, nxt);
        const char* nA = has_next ? (const char*)g.A + (size_t)nxt.pm * tA : cA; const char* nB = has_next ? (const char*)g.Bt + (size_t)nxt.pn * tB : cB;
        for (int t = 0; t < nt; t += 2) {
            const bool last = (t == nt - 2);
            const char* a1 = cA + (size_t)(t + 1) * kstepA;
            const char* a2 = last ? nA : cA + (size_t)(t + 2) * kstepA; const char* b2 = last ? nB : cB + (size_t)(t + 2) * kstep;
            const char* a3 = a2 + kstepA; const char* b3 = b2 + kstep;
            PG8_LDB(B0, 0, 0); PG8_LDB(B1, 0, 1); PG8_SCHED; PG8_LDA(At, 0, 0); PG8_STAGE(PG8_SA(1, 1), a1 + hA, voffA);
            PG8_WAIT_V(8); PG8_WAIT_L(0); PG8_BAR; PG8_MMA(0, 0, At, B0); PG8_MMA(0, 1, At, B1); PG8_BAR; PG8_SCHED;
            PG8_LDA(At, 0, 1); PG8_STAGE(PG8_SB(0, 0), b2, voffB); PG8_STAGE(PG8_SB(0, 1), b2 + hB, voffB); PG8_STAGE(PG8_SA(0, 0), a2, voffA);
            PG8_WAIT_V(8); PG8_WAIT_L(0); PG8_BAR; PG8_MMA(1, 0, At, B0); PG8_MMA(1, 1, At, B1); PG8_BAR; PG8_SCHED;
            PG8_LDB(B0, 1, 0); PG8_LDB(B1, 1, 1); PG8_SCHED; PG8_LDA(At, 1, 0); PG8_STAGE(PG8_SA(0, 1), a2 + hA, voffA);
            PG8_WAIT_V(8); PG8_WAIT_L(0); PG8_BAR; PG8_MMA(0, 0, At, B0); PG8_MMA(0, 1, At, B1); PG8_BAR; PG8_SCHED;
            PG8_LDA(At, 1, 1); PG8_STAGE(PG8_SB(1, 0), b3, voffB); PG8_STAGE(PG8_SB(1, 1), b3 + hB, voffB); PG8_STAGE(PG8_SA(1, 0), a3, voffA);
            PG8_WAIT_V(8); PG8_WAIT_L(0); PG8_BAR; PG8_MMA(1, 0, At, B0); PG8_MMA(1, 1, At, B1); PG8_BAR; PG8_SCHED;
        }
        if (wr == 0) PG8_BAR;
        E(acc, cur, wr, wc, fr, fq);
        if (!has_next) break;
#pragma unroll
        for (int a = 0; a < 2; ++a)
#pragma unroll
            for (int b = 0; b < 2; ++b)
#pragma unroll
                for (int m = 0; m < 4; ++m)
#pragma unroll
                    for (int n = 0; n < 2; ++n) acc[a][b][m][n] = (f32x4){0.f, 0.f, 0.f, 0.f};
        cur = nxt; cA = nA; cB = nB; ++ui;
        if (wr == 1) PG8_BAR;
    }
    PG8_WAIT_V(0);
    PG8_BAR;
#undef PG8_SA
#undef PG8_SB
#undef PG8_STAGE
#undef PG8_LDA
#undef PG8_LDB
#undef PG8_MMA
#undef PG8_WAIT_V
#undef PG8_WAIT_L
#undef PG8_BAR
#undef PG8_SCHED
}
}

struct Params {
    const float *x, *c, *ctx, *cctx, *w_ada, *b_ada, *norm1, *f1w1, *f1w3, *f1w2, *norm2, *w_in, *qan, *w_uq, *kvan, *w_ukv, *qn, *kn, *vn, *w_s, *b_s, *w_out, *norm3, *f2w1, *f2w3, *f2w2;
    float* out; unsigned char* ws; int ph_lo, ph_hi;
};

__device__ __forceinline__ void tr_item(const float* W, int N, int k0, int n0, bf16_t* dst, int ldd, const float* kscale, float* scr, int lane) {
#pragma unroll 8
    for (int i = 0; i < 32; ++i) { const int kk = 2 * i + (lane >> 5); float v = W[(size_t)(k0 + kk) * N + n0 + (lane & 31)]; if (kscale) v *= kscale[k0 + kk]; scr[kk * 33 + (lane & 31)] = v; }
    LDS_WAIT();
    const int c = lane & 7;
#pragma unroll
    for (int j = 0; j < 4; ++j) { const int n = (lane >> 3) + 8 * j; const float* s = scr + (8 * c) * 33 + n;
        u32x4 o; o.x = pk2(s[0 * 33], s[1 * 33]); o.y = pk2(s[2 * 33], s[3 * 33]); o.z = pk2(s[4 * 33], s[5 * 33]); o.w = pk2(s[6 * 33], s[7 * 33]);
        *(u32x4*)(dst + (size_t)n * ldd + 8 * c) = o; }
    LDS_WAIT();
}
__device__ __forceinline__ int win_row(int n) {
    if (n < 128) return 256 + n;
    if (n < 160) return 384 + (n - 128);
    if (n < 416) return n - 160;
    if (n < 928) return 512 + (n - 416);
    return 1024 + (n - 928);
}
template <bool SILU>
__device__ __forceinline__ void rowmat_item(const float* in, int istr, const float* in32, const float* W, int N, int j, const float* bias, float* out, int ldo, int cmap, float* lds, int tid) {
    const int wave = tid >> 6, lane = tid & 63, col = 64 * j + lane; const bool cok = col < N; const int colc = cok ? col : N - 1;
    float acc[33];
#pragma unroll
    for (int r = 0; r < 33; ++r) acc[r] = 0.f;
    for (int pass = 0; pass < 2; ++pass) {
        __syncthreads();
        {
            float cvv[33];
#pragma unroll
            for (int r = 0; r < 33; ++r) cvv[r] = (r < 32) ? in[(size_t)r * istr + 512 * pass + tid] : in32[512 * pass + tid];
#pragma unroll
            for (int r = 0; r < 33; ++r) lds[r * 512 + tid] = SILU ? cvv[r] / (1.f + __expf(-cvv[r])) : cvv[r];
        }
        __syncthreads();
        const int kb = 512 * pass + 64 * wave;
        const float* Wc = W + (size_t)kb * N + colc;
        float w0 = Wc[0], w1 = Wc[(size_t)N], w2 = Wc[(size_t)2 * N], w3 = Wc[(size_t)3 * N];
        float x0 = Wc[(size_t)4 * N], x1 = Wc[(size_t)5 * N], x2 = Wc[(size_t)6 * N], x3 = Wc[(size_t)7 * N];
        for (int k4 = 0; k4 < 16; ++k4) {
            const int kn = (k4 + 2 < 16) ? 4 * (k4 + 2) : 0;
            const float y0 = Wc[(size_t)(kn + 0) * N], y1 = Wc[(size_t)(kn + 1) * N], y2 = Wc[(size_t)(kn + 2) * N], y3 = Wc[(size_t)(kn + 3) * N];
#pragma unroll
            for (int r = 0; r < 33; ++r) { const f32x4 s = *(const f32x4*)(lds + r * 512 + 64 * wave + 4 * k4); acc[r] += s[0] * w0 + s[1] * w1 + s[2] * w2 + s[3] * w3; }
            w0 = x0; w1 = x1; w2 = x2; w3 = x3; x0 = y0; x1 = y1; x2 = y2; x3 = y3;
        }
    }
    __syncthreads();
#pragma unroll
    for (int r = 0; r < 33; ++r) lds[(wave * 33 + r) * 64 + lane] = acc[r];
    __syncthreads();
    for (int idx = tid; idx < 33 * 64; idx += 512) { const int r = idx >> 6, l = idx & 63, c = 64 * j + l; float s = 0.f;
#pragma unroll
        for (int w = 0; w < 8; ++w) s += lds[(w * 33 + r) * 64 + l];
        if (c < N) { const int oc = cmap == 0 ? c : cmap == 1 ? win_row(c) : (256 * (c >> 7) + (c & 127) + (cmap == 3 ? 128 : 0));
            out[(size_t)r * ldo + oc] = s + (bias ? bias[c] : 0.f); } }
    __syncthreads();
}
constexpr int I_UP = 16 * 88, I_DN = 44 * 32, I_IN = 16 * 45, I_UQ = 4 * 24, I_UKV = 2 * 32, I_OUT = 16 * 32;
constexpr int NITEMS = 4 * I_UP + 2 * I_DN + I_IN + I_UQ + I_UKV + I_OUT;
__device__ __forceinline__ void tr_dispatch(const Params& p, int it, float* scr, int lane) {
    unsigned char* ws = p.ws;
    int r = it;
    if (r < 4 * I_UP) { const int which = r / I_UP; r -= which * I_UP; const int kb = r / 88, nb = r % 88, k0 = 64 * kb, n0 = 32 * nb;
        const float* W = which == 0 ? p.f1w1 : which == 1 ? p.f1w3 : which == 2 ? p.f2w1 : p.f2w3;
        bf16_t* D = (bf16_t*)(ws + (which < 2 ? WS_W13A : WS_W13B));
        const int row = 256 * (n0 >> 7) + (n0 & 127) + ((which & 1) ? 128 : 0);
        tr_item(W, DFF, k0, n0, D + (size_t)row * DM + k0, DM, nullptr, scr, lane); return; }
    r -= 4 * I_UP;
    if (r < 2 * I_DN) { const int which = r / I_DN; r -= which * I_DN; const int kb = r / 32, nb = r % 32, k0 = 64 * kb, n0 = 32 * nb;
        tr_item(which ? p.f2w2 : p.f1w2, DM, k0, n0, (bf16_t*)(ws + (which ? WS_W2B : WS_W2A)) + (size_t)n0 * DFF + k0, DFF, nullptr, scr, lane); return; }
    r -= 2 * I_DN;
    if (r < I_IN) { const int kb = r / 45, nb = r % 45, k0 = 64 * kb, n0 = 32 * nb;
        tr_item(p.w_in, 1440, k0, n0, (bf16_t*)(ws + WS_WIN) + (size_t)win_row(n0) * DM + k0, DM, nullptr, scr, lane); return; }
    r -= I_IN;
    if (r < I_UQ) { const int kb = r / 24, nb = r % 24, k0 = 64 * kb, n0 = 32 * nb;
        tr_item(p.w_uq, 768, k0, n0, (bf16_t*)(ws + WS_WUQ) + (size_t)n0 * 256 + k0, 256, p.qan, scr, lane); return; }
    r -= I_UQ;
    if (r < I_UKV) { const int kb = r / 32, nb = r % 32, k0 = 64 * kb, n0 = 32 * nb; const int h = n0 >> 7, j = n0 & 127;
        bf16_t* D = (j < 64) ? (bf16_t*)(ws + WS_WK) + (size_t)(h * 64 + j) * 256 : (bf16_t*)(ws + WS_WV) + (size_t)(h * 64 + j - 64) * 256;
        tr_item(p.w_ukv, 1024, k0, n0, D + k0, 256, p.kvan, scr, lane); return; }
    r -= I_UKV;
    { const int kb = r / 32, nb = r % 32, k0 = 64 * kb, n0 = 32 * nb;
        tr_item(p.w_out, DM, k0, n0, (bf16_t*)(ws + WS_WOUT) + (size_t)n0 * DM + k0, DM, nullptr, scr, lane); }
}
__device__ __forceinline__ void tr_set(const Params& p, int set, int widx, int nw, float* scr, int lane, int j0 = 0, int j1 = 1 << 30) {
    const int nall = set == 1 ? (I_IN + I_UQ + I_UKV + I_OUT) : (2 * I_UP + I_DN); const int n = j1 < nall ? j1 : nall;
    for (int j = j0 + widx; j < n; j += nw) {
        const int it = set == 0 ? (j < 2 * I_UP ? j : 4 * I_UP + (j - 2 * I_UP))
                     : set == 1 ? (4 * I_UP + 2 * I_DN + j)
                     : (j < 2 * I_UP ? 2 * I_UP + j : 4 * I_UP + I_DN + (j - 2 * I_UP));
        tr_dispatch(p, it, scr, lane);
    }
}
__device__ __forceinline__ void phase0(const Params& p, float* lds) {
    unsigned char* ws = p.ws;
    const int tid = threadIdx.x, lane = tid & 63, wave = tid >> 6, G = gridDim.x;
    float* MOD = (float*)(ws + WS_MOD);
    if ((int)blockIdx.x < 144) rowmat_item<true>(p.c, DM, p.cctx, p.w_ada, NMOD, blockIdx.x, p.b_ada, MOD, NMOD, 0, lds, tid);
    {
        const int gt = blockIdx.x * 512 + tid, NT = G * 512;
        { f32x4* zs = (f32x4*)(ws + WS_SWIN); for (int i = gt; i < 33 * NPROJ / 4; i += NT) zs[i] = (f32x4){0.f, 0.f, 0.f, 0.f}; }
        { f32x4* zs = (f32x4*)(ws + WS_SS2); for (int i = gt; i < MT / 4; i += NT) zs[i] = (f32x4){0.f, 0.f, 0.f, 0.f}; }
        { f32x4* zs = (f32x4*)(ws + WS_SS3); for (int i = gt; i < MX / 4; i += NT) zs[i] = (f32x4){0.f, 0.f, 0.f, 0.f}; }
        u32x4* z0 = (u32x4*)((bf16_t*)(ws + WS_WIN) + (size_t)416 * 1024);
        for (int i = gt; i < 96 * 1024 / 8; i += NT) z0[i] = (u32x4){0u, 0u, 0u, 0u};
        for (int i = gt; i < 512 * 16; i += NT) { const int r = i >> 4, cpart = i & 15;
            *(u32x4*)((bf16_t*)(ws + WS_WK) + (size_t)r * 256 + 128 + cpart * 8) = (u32x4){0u, 0u, 0u, 0u};
            *(u32x4*)((bf16_t*)(ws + WS_WV) + (size_t)r * 256 + 128 + cpart * 8) = (u32x4){0u, 0u, 0u, 0u}; }
        for (int i = gt; i < 8 * 128 * 128 / 8; i += NT) { const f32x4 a = *(const f32x4*)(p.w_s + (size_t)i * 8), b = *(const f32x4*)(p.w_s + (size_t)i * 8 + 4);
            u32x4 o; o.x = pk2(a[0], a[1]); o.y = pk2(a[2], a[3]); o.z = pk2(b[0], b[1]); o.w = pk2(b[2], b[3]); *(u32x4*)((bf16_t*)(ws + WS_WS) + (size_t)i * 8) = o; }
    }
    if (G > 144) { if ((int)blockIdx.x >= 144) tr_set(p, 0, ((int)blockIdx.x - 144) * 8 + wave, (G - 144) * 8, lds + wave * 4096, lane, 1152);
                   else tr_set(p, 0, (int)blockIdx.x * 8 + wave, 1152, lds + wave * 4096, lane, 0, 1152); }
    else tr_set(p, 0, blockIdx.x * 8 + wave, G * 8, lds + wave * 4096, lane);
    __syncthreads();
}

__device__ __forceinline__ void norm_mod_phase(const float* srcx, const float* srcc, int nrows, const float* w, const float* MOD, int ishift, bf16_t* H) {
    const int tid = threadIdx.x, lane = tid & 63, wave = tid >> 6;
    const int gw = blockIdx.x * 8 + wave, NGW = gridDim.x * 8, nch = nrows / 8;
    for (int ch = gw; ch < nch; ch += NGW) {
        const int row0 = ch * 8; const bool isc = row0 >= MX; const int mrow = isc ? 32 : (row0 >> 11);
        const float* src = isc ? srcc + (size_t)(row0 - MX) * DM : srcx + (size_t)row0 * DM;
        const float* sh = MOD + (size_t)mrow * NMOD + ishift * DM; const float* sc = sh + DM;
        f32x4 g[4], s[4];
#pragma unroll
        for (int j = 0; j < 4; ++j) { const int c = 4 * lane + 256 * j; const f32x4 wv = *(const f32x4*)(w + c), scv = *(const f32x4*)(sc + c); g[j] = wv * (scv + 1.f); s[j] = *(const f32x4*)(sh + c); }
        f32x4 nx[4];
#pragma unroll
        for (int j = 0; j < 4; ++j) nx[j] = ((const f32x4*)src + lane)[64 * j];
        for (int rr = 0; rr < 8; ++rr) {
            f32x4 v[4]; float ss = 0.f;
#pragma unroll
            for (int j = 0; j < 4; ++j) v[j] = nx[j];
            if (rr < 7) { const f32x4* xr = (const f32x4*)(src + (size_t)(rr + 1) * DM) + lane;
#pragma unroll
                for (int j = 0; j < 4; ++j) nx[j] = xr[64 * j]; }
#pragma unroll
            for (int j = 0; j < 4; ++j) ss += (v[j][0] * v[j][0] + v[j][1] * v[j][1]) + (v[j][2] * v[j][2] + v[j][3] * v[j][3]);
            const float rstd = rsqrtf(wave_sum(ss) * (1.f / DM) + EPS);
            u32x2* o = (u32x2*)(H + (size_t)(row0 + rr) * DM) + lane;
#pragma unroll
            for (int j = 0; j < 4; ++j) { const f32x4 y = v[j] * rstd * g[j] + s[j]; u32x2 ov; ov.x = pk2(y[0], y[1]); ov.y = pk2(y[2], y[3]); o[64 * j] = ov; }
        }
    }
}

__device__ __forceinline__ void rstd_phase(const bf16_t* PROJ, float* RSQ, float* RSKV) {
    const int tid = threadIdx.x, lane = tid & 63, wave = tid >> 6;
    const int gw = blockIdx.x * 8 + wave, NGW = gridDim.x * 8;
    for (int r4 = gw; r4 < MT / 4; r4 += NGW) {
        unsigned kv[4]; u32x2 q[4];
#pragma unroll
        for (int i = 0; i < 4; ++i) { const int row = 4 * r4 + i; const bf16_t* pr = PROJ + (size_t)row * NPROJ;
            kv[i] = *((const unsigned*)(pr + 256) + lane); q[i] = (row < MX) ? *((const u32x2*)pr + lane) : (u32x2){0u, 0u}; }
#pragma unroll
        for (int i = 0; i < 4; ++i) { const int row = 4 * r4 + i;
            float s2 = bflo(kv[i]) * bflo(kv[i]) + bfhi(kv[i]) * bfhi(kv[i]);
            float s1 = (bflo(q[i].x) * bflo(q[i].x) + bfhi(q[i].x) * bfhi(q[i].x)) + (bflo(q[i].y) * bflo(q[i].y) + bfhi(q[i].y) * bfhi(q[i].y));
            s2 = wave_sum(s2); s1 = wave_sum(s1);
            if (lane == 0) { RSKV[row] = rsqrtf(s2 * (1.f / 128.f) + EPS); if (row < MX) RSQ[row] = rsqrtf(s1 * (1.f / 256.f) + EPS); } }
    }
}

__device__ __forceinline__ void gmlp_phase(const Params& p, unsigned char* lds) {
    unsigned char* ws = p.ws;
    const bf16_t* PROJ = (const bf16_t*)(ws + WS_PROJ); const bf16_t* WSb = (const bf16_t*)(ws + WS_WS); bf16_t* MIX = (bf16_t*)(ws + WS_MIX);
    const int tid = threadIdx.x, lane = tid & 63, wave = tid >> 6, r32 = lane & 31, hi = lane >> 5;
    bf16_t* Vt = (bf16_t*)lds;
    float* vnl = (float*)(lds + 32768); float* bsl = vnl + 512;
    { vnl[tid] = p.vn[tid]; bsl[tid] = p.b_s[tid]; bsl[tid + 512] = p.b_s[tid + 512]; }
    __syncthreads();
    const int pp = tid >> 2, cp = tid & 3;
    const int c0 = 32 * (wave >> 2), p0 = 32 * (wave & 3), pos = p0 + r32;
    u32x4 va, vb2;
    constexpr int NU = NB * 16 * 8;
    const bool bal = gridDim.x == 256;
    const int ubase = bal ? ((int)blockIdx.x < 64 ? (int)blockIdx.x * 13 : 832 + ((int)blockIdx.x - 64) * 17) : (int)blockIdx.x;
    const int ustep = bal ? 1 : (int)gridDim.x;
    const int uend = bal ? ubase + ((int)blockIdx.x < 64 ? 13 : 17) : NU;
    { const int unit = ubase; if (unit < uend) { const int g = unit & 7, n = (unit >> 3) & 15, b = unit >> 7;
        const bf16_t* src0 = PROJ + ((size_t)b * SEQ + n * 128 + pp) * NPROJ + 1024 + 64 * g + 16 * cp; va = *(const u32x4*)src0; vb2 = *(const u32x4*)(src0 + 8); } }
    for (int unit = ubase; unit < uend; unit += ustep) {
        const int g = unit & 7, n = (unit >> 3) & 15, b = unit >> 7;
        const size_t r0 = (size_t)b * SEQ + n * 128;
        bf16x8 wf[8];
        const bf16_t* wrow = WSb + ((size_t)g * 128 + pos) * 128 + 8 * hi;
#pragma unroll
        for (int s = 0; s < 8; ++s) wf[s] = *(const bf16x8*)(wrow + 16 * s);
        const bf16_t* urow = PROJ + (r0 + pos) * NPROJ + 512 + 64 * g + c0 + 4 * hi;
        u32x2 uu[4];
#pragma unroll
        for (int q = 0; q < 4; ++q) uu[q] = *(const u32x2*)(urow + 8 * q);
        const float bias = bsl[g * 128 + pos];
        f32x4 vw[4];
#pragma unroll
        for (int i = 0; i < 4; ++i) vw[i] = *(const f32x4*)(vnl + 64 * g + 16 * cp + 4 * i);
        {
            float v[16];
            v[0] = bflo(va.x); v[1] = bfhi(va.x); v[2] = bflo(va.y); v[3] = bfhi(va.y); v[4] = bflo(va.z); v[5] = bfhi(va.z); v[6] = bflo(va.w); v[7] = bfhi(va.w);
            v[8] = bflo(vb2.x); v[9] = bfhi(vb2.x); v[10] = bflo(vb2.y); v[11] = bfhi(vb2.y); v[12] = bflo(vb2.z); v[13] = bfhi(vb2.z); v[14] = bflo(vb2.w); v[15] = bfhi(vb2.w);
            float ss = 0.f;
#pragma unroll
            for (int i = 0; i < 16; ++i) { v[i] = gelu_f(v[i]); ss += v[i] * v[i]; }
            ss += __shfl_xor(ss, 1); ss += __shfl_xor(ss, 2);
            const float rstd = rsqrtf(ss * (1.f / 64.f) + EPS);
#pragma unroll
            for (int i = 0; i < 16; ++i) { const int c = 16 * cp + i; const float y = v[i] * rstd * vw[i >> 2][i & 3]; Vt[c * 136 + pp] = (bf16_t)(pk2(y, 0.f) & 0xffffu); }
        }
        {
            const int un = unit + ustep; if (un < uend) { const int g2 = un & 7, n2 = (un >> 3) & 15, b2 = un >> 7;
                const bf16_t* src0 = PROJ + ((size_t)b2 * SEQ + n2 * 128 + pp) * NPROJ + 1024 + 64 * g2 + 16 * cp; va = *(const u32x4*)src0; vb2 = *(const u32x4*)(src0 + 8); } }
        __syncthreads();
        {
            f32x16 acc = {};
            const bf16_t* vrow = Vt + (c0 + r32) * 136 + 8 * hi;
#pragma unroll
            for (int s = 0; s < 8; ++s) { const bf16x8 av = *(const bf16x8*)(vrow + 16 * s);
                acc = __builtin_amdgcn_mfma_f32_32x32x16_bf16(av, wf[s], acc, 0, 0, 0); }
            bf16_t* orow = MIX + (r0 + pos) * DM + 512 + 64 * g + c0 + 4 * hi;
#pragma unroll
            for (int q = 0; q < 4; ++q) {
                const float o0 = gelu_f(bflo(uu[q].x)) * (acc[4 * q + 0] + bias), o1 = gelu_f(bfhi(uu[q].x)) * (acc[4 * q + 1] + bias);
                const float o2 = gelu_f(bflo(uu[q].y)) * (acc[4 * q + 2] + bias), o3 = gelu_f(bfhi(uu[q].y)) * (acc[4 * q + 3] + bias);
                u32x2 ov; ov.x = pk2(o0, o1); ov.y = pk2(o2, o3); *(u32x2*)(orow + 8 * q) = ov; }
        }
        __syncthreads();
    }
}

__device__ __forceinline__ void unpack8(float* v, const u32x4 a) { v[0] = bflo(a.x); v[1] = bfhi(a.x); v[2] = bflo(a.y); v[3] = bfhi(a.y); v[4] = bflo(a.z); v[5] = bfhi(a.z); v[6] = bflo(a.w); v[7] = bfhi(a.w); }
__device__ __forceinline__ u32x4 pack8(const float* v) { u32x4 o; o.x = pk2(v[0], v[1]); o.y = pk2(v[2], v[3]); o.z = pk2(v[4], v[5]); o.w = pk2(v[6], v[7]); return o; }
__device__ __forceinline__ float rope_inv(int f) { return f == 0 ? 1.0f : f == 1 ? 0.316227766f : f == 2 ? 0.1f : f == 3 ? 0.0316227766f : f == 4 ? 0.01f : f == 5 ? 0.00316227766f : f == 6 ? 0.001f : 0.000316227766f; }
__device__ __forceinline__ void kprep_phase(const Params& p) {
    unsigned char* ws = p.ws;
    const bf16_t* KN = (const bf16_t*)(ws + WS_KNOPE); const bf16_t* PROJ = (const bf16_t*)(ws + WS_PROJ); bf16_t* KF = (bf16_t*)(ws + WS_KF);
    const int tid = threadIdx.x, lane = tid & 63, wave = tid >> 6, h = lane >> 3, j = lane & 7;
    const int gw = blockIdx.x * 8 + wave, NGW = gridDim.x * 8;
    float wn[8], wp[8];
#pragma unroll
    for (int i = 0; i < 8; ++i) { wn[i] = p.kn[8 * j + i]; wp[i] = p.kn[64 + 8 * (j & 3) + i]; }
    u32x4 na = {}, ne = {};
    if (gw < MT) { na = *(const u32x4*)(KN + (size_t)gw * 512 + h * 64 + 8 * j); ne = *(const u32x4*)(PROJ + (size_t)gw * NPROJ + 384 + 8 * (j & 3)); }
    for (int row = gw; row < MT; row += NGW) {
        float a[8], e[8];
        unpack8(a, na); unpack8(e, ne);
        { const int rn = row + NGW; if (rn < MT) { na = *(const u32x4*)(KN + (size_t)rn * 512 + h * 64 + 8 * j); ne = *(const u32x4*)(PROJ + (size_t)rn * NPROJ + 384 + 8 * (j & 3)); } }
        float ss = 0.f;
#pragma unroll
        for (int i = 0; i < 8; ++i) ss += a[i] * a[i];
        if (j < 4) {
#pragma unroll
            for (int i = 0; i < 8; ++i) ss += e[i] * e[i];
        }
        ss += __shfl_xor(ss, 1); ss += __shfl_xor(ss, 2); ss += __shfl_xor(ss, 4);
        const float rs = rsqrtf(ss * (1.f / 96.f) + EPS);
#pragma unroll
        for (int i = 0; i < 8; ++i) { a[i] *= rs * wn[i]; e[i] *= rs * wp[i]; }
        bf16_t* ko = KF + (size_t)row * 768 + h * 96;
        *(u32x4*)(ko + 8 * j) = pack8(a);
        const bool lat = row < MX; const int pos = row & (SEQ - 1);
        const float fpos = (float)(((j >> 1) & 1) ? (pos & 63) : (pos >> 6));
#pragma unroll
        for (int f = 0; f < 8; ++f) {
            const float partner = __shfl_xor(e[f], 1);
            float sn = 0.f, cs = 1.f;
            if (lat) { const float rev = (fpos * rope_inv(f)) * 0.15915494309189535f; sn = __builtin_amdgcn_sinf(rev); cs = __builtin_amdgcn_cosf(rev); }
            e[f] = e[f] * cs + ((j & 1) ? partner : -partner) * sn;
        }
        if (j < 4) *(u32x4*)(ko + 64 + 8 * j) = pack8(e);
    }
}

constexpr int KSTR = 208, VSTR = 144, KBUF = 64 * KSTR, VBUF = 64 * VSTR;
__device__ __forceinline__ float max3f(float a, float b, float c) { float r; asm("v_max3_f32 %0, %1, %2, %3" : "=v"(r) : "v"(a), "v"(b), "v"(c)); return r; }
__device__ __forceinline__ float swapmax(float m) { auto rr = __builtin_amdgcn_permlane32_swap(__float_as_uint(m), __float_as_uint(m), false, false); return fmaxf(__uint_as_float(rr[0]), __uint_as_float(rr[1])); }
__device__ __forceinline__ float swapadd(float m) { auto rr = __builtin_amdgcn_permlane32_swap(__float_as_uint(m), __float_as_uint(m), false, false); return __uint_as_float(rr[0]) + __uint_as_float(rr[1]); }
#define ASB() __builtin_amdgcn_sched_barrier(0)
struct AttStage { u32x4 k0, k1, v; };
struct AttCtx {
    const bf16_t* KF; const bf16_t* VT; unsigned char* Ks; unsigned char* Vs;
    int tid, b, h, kkey0, kpart0, kkey1, kpart1, vd, vpart, vdst, koff, voff;
};
__device__ __forceinline__ void att_load(const AttCtx& c, int t, AttStage& s) {
    const size_t kr = (t < 32) ? (size_t)c.b * SEQ + t * 64 : (size_t)MX + (size_t)c.b * CTXL + (t - 32) * 64;
    s.k0 = *(const u32x4*)(c.KF + (kr + c.kkey0) * 768 + c.h * 96 + 8 * c.kpart0);
    if (c.tid < 256) s.k1 = *(const u32x4*)(c.KF + (kr + c.kkey1) * 768 + c.h * 96 + 8 * c.kpart1);
    s.v = *(const u32x4*)(c.VT + (size_t)(c.h * 64 + c.vd) * MT + kr + 8 * c.vpart);
}
__device__ __forceinline__ void att_store(const AttCtx& c, int kbuf, int vbuf, const AttStage& s) {
    *(u32x4*)(c.Ks + kbuf * KBUF + c.kkey0 * KSTR + c.kpart0 * 16) = s.k0;
    if (c.tid < 256) *(u32x4*)(c.Ks + kbuf * KBUF + c.kkey1 * KSTR + c.kpart1 * 16) = s.k1;
    *(u32x2*)(c.Vs + vbuf * VBUF + c.vdst) = (u32x2){s.v.x, s.v.y}; *(u32x2*)(c.Vs + vbuf * VBUF + c.vdst + 16) = (u32x2){s.v.z, s.v.w};
}
#define LDK(s_, A, C) do { A = *(const bf16x8*)(kb + (s_) * 32); C = *(const bf16x8*)(kb + 32 * KSTR + (s_) * 32); } while (0)
#define LDV(s_, A, C) do { A = *(const bf16x8*)(vb + (s_) * 32); C = *(const bf16x8*)(vb + 32 * VSTR + (s_) * 32); } while (0)
#define MMA(Acc, A, B) Acc = __builtin_amdgcn_mfma_f32_32x32x16_bf16(A, B, Acc, 0, 0, 0)
#define EXP4(V, i) do { V[i] = fexp2(V[i]); V[i + 1] = fexp2(V[i + 1]); V[i + 2] = fexp2(V[i + 2]); V[i + 3] = fexp2(V[i + 3]); } while (0)
__device__ __forceinline__ void att_iter(const AttCtx& c, int t, int& vcur, const bf16x8 (&qf)[6], f32x16& s0, f32x16& s1, f32x16& o0, f32x16& o1, float& mref, float& lsum, AttStage& L, const AttStage& S) {
    const bool more = t < 36;
    if (t + 2 < 36) att_load(c, t + 2, L);
    const unsigned char* kb = c.Ks + (t & 1) * KBUF + c.koff;
    const unsigned char* vb = c.Vs + vcur * VBUF + c.voff;
    f32x16 n0 = {}, n1 = {};
    u32x4 pw0, pw1, pw2, pw3;
    bf16x8 ka0, kc0, ka1, kc1, va0, vc0, va1, vc1;
    LDK(0, ka0, kc0);
    ASB();
    LDK(1, ka1, kc1);
    if (more) MMA(n0, ka0, qf[0]);
    float ma = max3f(s0[0], s0[1], s0[2]); ma = max3f(ma, s0[3], s0[4]); ma = max3f(ma, s0[5], s0[6]); ma = max3f(ma, s0[7], s0[8]);
    ASB();
    if (more) MMA(n1, kc0, qf[0]);
    ma = max3f(ma, s0[9], s0[10]); ma = max3f(ma, s0[11], s0[12]); ma = max3f(ma, s0[13], s0[14]); ma = fmaxf(ma, s0[15]);
    ASB();
    LDK(2, ka0, kc0);
    if (more) MMA(n0, ka1, qf[1]);
    float mb = max3f(s1[0], s1[1], s1[2]); mb = max3f(mb, s1[3], s1[4]); mb = max3f(mb, s1[5], s1[6]); mb = max3f(mb, s1[7], s1[8]);
    ASB();
    if (more) MMA(n1, kc1, qf[1]);
    mb = max3f(mb, s1[9], s1[10]); mb = max3f(mb, s1[11], s1[12]); mb = max3f(mb, s1[13], s1[14]); mb = max3f(mb, s1[15], ma);
    const float mx = swapmax(mb);
    if (__any(mx > mref + 8.f)) {
        const float mn = fmaxf(mref, mx), alpha = fexp2(mref - mn); mref = mn; lsum *= alpha;
#pragma unroll
        for (int r = 0; r < 16; ++r) { o0[r] *= alpha; o1[r] *= alpha; }
    }
    ASB();
    LDK(3, ka1, kc1);
    if (more) MMA(n0, ka0, qf[2]);
    s0 = s0 - mref; EXP4(s0, 0);
    ASB();
    if (more) MMA(n1, kc0, qf[2]);
    EXP4(s0, 4);
    pw0 = (u32x4){pk2(s0[0], s0[1]), pk2(s0[2], s0[3]), pk2(s0[4], s0[5]), pk2(s0[6], s0[7])};
    ASB();
    LDK(4, ka0, kc0);
    if (more) MMA(n0, ka1, qf[3]);
    EXP4(s0, 8);
    ASB();
    if (more) MMA(n1, kc1, qf[3]);
    EXP4(s0, 12);
    pw1 = (u32x4){pk2(s0[8], s0[9]), pk2(s0[10], s0[11]), pk2(s0[12], s0[13]), pk2(s0[14], s0[15])};
    ASB();
    LDK(5, ka1, kc1);
    if (more) MMA(n0, ka0, qf[4]);
    s1 = s1 - mref; EXP4(s1, 0);
    ASB();
    if (more) MMA(n1, kc0, qf[4]);
    EXP4(s1, 4);
    pw2 = (u32x4){pk2(s1[0], s1[1]), pk2(s1[2], s1[3]), pk2(s1[4], s1[5]), pk2(s1[6], s1[7])};
    ASB();
    LDV(0, va0, vc0);
    if (more) MMA(n0, ka1, qf[5]);
    EXP4(s1, 8);
    ASB();
    if (more) MMA(n1, kc1, qf[5]);
    EXP4(s1, 12);
    pw3 = (u32x4){pk2(s1[8], s1[9]), pk2(s1[10], s1[11]), pk2(s1[12], s1[13]), pk2(s1[14], s1[15])};
    ASB();
    LDV(1, va1, vc1);
    MMA(o0, va0, __builtin_bit_cast(bf16x8, pw0)); MMA(o1, vc0, __builtin_bit_cast(bf16x8, pw0));
    { const f32x16 sv = s0 + s1; lsum += ((sv[0] + sv[1]) + (sv[2] + sv[3])) + ((sv[4] + sv[5]) + (sv[6] + sv[7])) + ((sv[8] + sv[9]) + (sv[10] + sv[11])) + ((sv[12] + sv[13]) + (sv[14] + sv[15])); }
    ASB();
    LDV(2, va0, vc0);
    MMA(o0, va1, __builtin_bit_cast(bf16x8, pw1)); MMA(o1, vc1, __builtin_bit_cast(bf16x8, pw1));
    ASB();
    LDV(3, va1, vc1);
    MMA(o0, va0, __builtin_bit_cast(bf16x8, pw2)); MMA(o1, vc0, __builtin_bit_cast(bf16x8, pw2));
    ASB();
    MMA(o0, va1, __builtin_bit_cast(bf16x8, pw3)); MMA(o1, vc1, __builtin_bit_cast(bf16x8, pw3));
    ASB();
    if (t + 1 < 36) { const int vn = (vcur == 0) ? 2 : vcur - 1; att_store(c, (t + 1) & 1, vn, S); }
    asm volatile("s_waitcnt lgkmcnt(0)" ::: "memory"); __builtin_amdgcn_s_barrier(); asm volatile("" ::: "memory");
    s0 = n0; s1 = n1; vcur = (vcur == 2) ? 0 : vcur + 1;
}
__device__ __forceinline__ void attn_phase(const Params& p, unsigned char* lds) {
    unsigned char* ws = p.ws;
    const bf16_t* Q = (const bf16_t*)(ws + WS_QRAW); bf16_t* MIX = (bf16_t*)(ws + WS_MIX);
    const int tid = threadIdx.x, lane = tid & 63, wave = tid >> 6, r32 = lane & 31, hi = lane >> 5;
    AttCtx c; c.KF = (const bf16_t*)(ws + WS_KF); c.VT = (const bf16_t*)(ws + WS_VT); c.Ks = lds; c.Vs = lds + 2 * KBUF; c.tid = tid;
    const int bx = blockIdx.x, G = gridDim.x;
    const int vcu = (G % 8 == 0) ? (bx % 8) * (G / 8) + bx / 8 : bx;
    c.kkey0 = tid / 12; c.kpart0 = tid % 12; c.kkey1 = (tid + 512) / 12; c.kpart1 = (tid + 512) % 12;
    c.vd = tid >> 3; c.vpart = tid & 7;
    c.vdst = c.vd * VSTR + (c.vpart >> 1) * 32 + (c.vpart & 1) * 8;
    c.koff = r32 * KSTR + hi * 16; c.voff = r32 * VSTR + hi * 16;
    for (int unit = vcu; unit < NB * NH * 8; unit += G) {
        const int qb = unit & 7, h = (unit >> 3) & 7, b = unit >> 6;
        c.b = b; c.h = h;
        const size_t qrow = (size_t)b * SEQ + qb * 256 + wave * 32 + r32;
        bf16x8 qf[6];
        {
            float qv[6][8]; float ss = 0.f;
#pragma unroll
            for (int s = 0; s < 6; ++s) { unpack8(qv[s], *(const u32x4*)(Q + qrow * 768 + h * 96 + 16 * s + 8 * hi));
#pragma unroll
                for (int i = 0; i < 8; ++i) ss += qv[s][i] * qv[s][i]; }
            ss += __shfl_xor(ss, 32);
            const float rs = rsqrtf(ss * (1.f / 96.f) + EPS) * QSCALE;
#pragma unroll
            for (int s = 0; s < 6; ++s)
#pragma unroll
                for (int i = 0; i < 8; ++i) qv[s][i] *= rs * p.qn[16 * s + 8 * hi + i];
            const int pos = (int)(qrow & (SEQ - 1));
#pragma unroll
            for (int s = 4; s < 6; ++s) { const float fpos = (float)(s == 4 ? (pos >> 6) : (pos & 63));
#pragma unroll
                for (int f = 0; f < 8; ++f) { const float partner = __shfl_xor(qv[s][f], 32);
                    const float rev = (fpos * rope_inv(f)) * 0.15915494309189535f; const float sn = __builtin_amdgcn_sinf(rev), cs = __builtin_amdgcn_cosf(rev);
                    qv[s][f] = qv[s][f] * cs + (hi ? partner : -partner) * sn; } }
#pragma unroll
            for (int s = 0; s < 6; ++s) qf[s] = __builtin_bit_cast(bf16x8, pack8(qv[s]));
        }
        float mref = -1e30f, lsum = 0.f; f32x16 o0 = {}, o1 = {};
        AttStage A, B; A.k1 = (u32x4){0u, 0u, 0u, 0u}; B.k1 = A.k1;
        att_load(c, 0, A); att_store(c, 0, 0, A);
        asm volatile("s_waitcnt lgkmcnt(0)" ::: "memory"); __builtin_amdgcn_s_barrier(); asm volatile("" ::: "memory");
        att_load(c, 1, A); att_load(c, 2, B);
        f32x16 s0 = {}, s1 = {};
        { const unsigned char* kb = c.Ks + c.koff; bf16x8 ka, kc;
#pragma unroll
          for (int s = 0; s < 6; ++s) { LDK(s, ka, kc); MMA(s0, ka, qf[s]); MMA(s1, kc, qf[s]); } }
        att_store(c, 1, 1, A);
        asm volatile("s_waitcnt lgkmcnt(0)" ::: "memory"); __builtin_amdgcn_s_barrier(); asm volatile("" ::: "memory");
        int vcur = 0;
        for (int t = 1; t <= 35; t += 2) {
            att_iter(c, t, vcur, qf, s0, s1, o0, o1, mref, lsum, A, B);
            att_iter(c, t + 1, vcur, qf, s0, s1, o0, o1, mref, lsum, B, A);
        }
        lsum = swapadd(lsum);
        const float il = 1.f / lsum;
        bf16_t* orow = MIX + qrow * DM + h * 64 + 4 * hi;
#pragma unroll
        for (int q = 0; q < 4; ++q) {
            u32x2 a; a.x = pk2(o0[4 * q] * il, o0[4 * q + 1] * il); a.y = pk2(o0[4 * q + 2] * il, o0[4 * q + 3] * il); *(u32x2*)(orow + 8 * q) = a;
            u32x2 cc; cc.x = pk2(o1[4 * q] * il, o1[4 * q + 1] * il); cc.y = pk2(o1[4 * q + 2] * il, o1[4 * q + 3] * il); *(u32x2*)(orow + 32 + 8 * q) = cc;
        }
    }
}
#undef LDK
#undef LDV
#undef MMA
#undef EXP4
#undef ASB

constexpr int NPHASE = 12;
__global__ void __launch_bounds__(512, 2) mega_fwd(Params p) {
    extern __shared__ __attribute__((aligned(16))) unsigned char lds[];
    LAS unsigned char* ldsl = (LAS unsigned char*)lds;
    unsigned char* ws = p.ws;
    const int G = gridDim.x, bx = blockIdx.x;
    float* MOD = (float*)(ws + WS_MOD);
    bf16_t* H = (bf16_t*)(ws + WS_H); bf16_t* ACT = (bf16_t*)(ws + WS_ACT); bf16_t* PROJ = (bf16_t*)(ws + WS_PROJ);
    float* X1C = (float*)(ws + WS_X1C); float* RSQ = (float*)(ws + WS_RSQ); float* RSKV = (float*)(ws + WS_RSKV);
    const int lo = p.ph_lo, hi = p.ph_hi;
#define IN(k) (lo <= (k) && (k) < hi)
#define SEAM(k) do { if (IN(k) && IN((k) + 1)) { cg::this_grid().sync(); } } while (0)
    using pg8::Gemm; using pg8::StaticOrder;

    if (IN(0)) { phase0(p, (float*)lds); } SEAM(0);
    if (IN(1)) { norm_mod_phase(p.x, p.ctx, MT, p.norm1, MOD, 0, H); } SEAM(1);
    if (IN(2)) { Gemm g{H, (const bf16_t*)(ws + WS_W13A), MT, 2 * DFF, DM, DM, DM}; StaticOrder S; S.init(MT, 2 * DFF, G, bx);
        pg8::EpiSwigluT<false> E{ACT, DFF, nullptr, nullptr}; pg8::gemm_phase(ldsl, g, S, E);
        { const int fi = S.nwg % G, np = fi ? G - fi : G, wi = fi ? bx - fi : bx; const int wave = threadIdx.x >> 6, lane = threadIdx.x & 63;
          if (wi >= 0) { tr_set(p, 1, wi * 8 + wave, np * 8, (float*)lds + wave * 4096, lane); } __syncthreads(); } } SEAM(2);
    if (IN(3)) { Gemm g{ACT, (const bf16_t*)(ws + WS_W2A), MT, DM, DFF, DFF, DFF}; StaticOrder S; S.init(MT, DM, G, bx);
        pg8::EpiRes<MX / 256, 1, true> E{p.x, p.ctx, p.out, X1C, MOD + 2 * DM, p.norm2, MOD + 4 * DM, H, (float*)(ws + WS_SS2)}; pg8::gemm_phase<pg8::EpiRes<MX / 256, 1, true>, StaticOrder, true>(ldsl, g, S, E);
        { const int fi = S.nwg % G, np = fi ? G - fi : G, wi = fi ? bx - fi : bx; const int tid = threadIdx.x, wave = tid >> 6, lane = tid & 63;
          if (wi >= 0) {
            for (int it = wi; it < 111; it += np) {
                if (it < 23) rowmat_item<false>(MOD + 3 * DM, NMOD, MOD + (size_t)32 * NMOD + 3 * DM, p.w_in, 1440, it, nullptr, (float*)(ws + WS_SWIN), NPROJ, 1, (float*)lds, tid);
                else if (it < 67) rowmat_item<false>(MOD + 6 * DM, NMOD, MOD + (size_t)32 * NMOD + 6 * DM, p.f2w1, DFF, it - 23, nullptr, (float*)(ws + WS_SW13), 2 * DFF, 2, (float*)lds, tid);
                else rowmat_item<false>(MOD + 6 * DM, NMOD, MOD + (size_t)32 * NMOD + 6 * DM, p.f2w3, DFF, it - 67, nullptr, (float*)(ws + WS_SW13), 2 * DFF, 3, (float*)lds, tid);
            }
            tr_set(p, 2, wi * 8 + wave, np * 8, (float*)lds + wave * 4096, lane); } __syncthreads(); } } SEAM(3);
    if (IN(4)) {
        { Gemm g{H, (const bf16_t*)(ws + WS_WIN), MX, NPROJ, DM, DM, DM}; StaticOrder S; S.init(MX, NPROJ, G, bx);
          pg8::EpiBf16S E{PROJ, NPROJ, nullptr, nullptr, (const float*)(ws + WS_SS2), (const float*)(ws + WS_SWIN), NPROJ, -1}; pg8::gemm_phase(ldsl, g, S, E); }
        { Gemm g{H + (size_t)MX * DM, (const bf16_t*)(ws + WS_WIN) + (size_t)256 * DM, MC, 256, DM, DM, DM}; StaticOrder S; S.init(MC, 256, G, bx);
          pg8::EpiBf16S E{PROJ + (size_t)MX * NPROJ + 256, NPROJ, nullptr, nullptr, (const float*)(ws + WS_SS2) + MX, (const float*)(ws + WS_SWIN) + 256, NPROJ, 32}; pg8::gemm_phase(ldsl, g, S, E); }
    } SEAM(4);
    if (IN(5)) { rstd_phase(PROJ, RSQ, RSKV); } SEAM(5);
    if (IN(6)) {
        { Gemm g{PROJ, (const bf16_t*)(ws + WS_WUQ), MX, 768, 256, NPROJ, 256}; StaticOrder S; S.init(MX, 768, G, bx);
          pg8::EpiBf16S E{(bf16_t*)(ws + WS_QRAW), 768, RSQ, nullptr, nullptr, nullptr, 0, 0}; pg8::gemm_phase(ldsl, g, S, E); }
        { int k128 = 128; asm volatile("" : "+s"(k128));     Gemm g{PROJ + 256, (const bf16_t*)(ws + WS_WK), MT, 512, k128, NPROJ, 256}; StaticOrder S; S.init(MT, 512, G, bx);
          pg8::EpiBf16S E{(bf16_t*)(ws + WS_KNOPE), 512, RSKV, nullptr, nullptr, nullptr, 0, 0}; pg8::gemm_phase(ldsl, g, S, E); }
        { int k128 = 128; asm volatile("" : "+s"(k128)); Gemm g{(const bf16_t*)(ws + WS_WV), PROJ + 256, 512, MT, k128, 256, NPROJ}; StaticOrder S; S.init(512, MT, G, bx);
          pg8::EpiBf16S E{(bf16_t*)(ws + WS_VT), MT, nullptr, RSKV, nullptr, nullptr, 0, 0}; pg8::gemm_phase(ldsl, g, S, E); }
        gmlp_phase(p, lds);
    } SEAM(6);
    if (IN(7)) { kprep_phase(p); } SEAM(7);
    if (IN(8)) { attn_phase(p, lds); } SEAM(8);
    if (IN(9)) { Gemm g{(const bf16_t*)(ws + WS_MIX), (const bf16_t*)(ws + WS_WOUT), MX, DM, DM, DM, DM}; StaticOrder S; S.init(MX, DM, G, bx);
        pg8::EpiRes<(1 << 30), 2, true> E{p.out, nullptr, p.out, nullptr, MOD + 5 * DM, p.norm3, MOD + 7 * DM, (bf16_t*)(ws + WS_H3), (float*)(ws + WS_SS3)}; pg8::gemm_phase(ldsl, g, S, E); } SEAM(9);
    if (IN(10)) { Gemm g{(const bf16_t*)(ws + WS_H3), (const bf16_t*)(ws + WS_W13B), MX, 2 * DFF, DM, DM, DM}; StaticOrder S; S.init(MX, 2 * DFF, G, bx);
        pg8::EpiSwigluT<true> E{ACT, DFF, (const float*)(ws + WS_SS3), (const float*)(ws + WS_SW13)}; pg8::gemm_phase(ldsl, g, S, E); } SEAM(10);
    if (IN(11)) { Gemm g{ACT, (const bf16_t*)(ws + WS_W2B), MX, DM, DFF, DFF, DFF}; StaticOrder S; S.init(MX, DM, G, bx);
        pg8::EpiRes<(1 << 30), 1, false> E{p.out, nullptr, p.out, nullptr, MOD + 8 * DM, nullptr, nullptr, nullptr, nullptr}; pg8::gemm_phase<pg8::EpiRes<(1 << 30), 1, false>, StaticOrder, true>(ldsl, g, S, E); }
#undef IN
#undef SEAM
}

extern "C" void kernel_launch(void* const* d_in, const int* in_sizes, int n_in, void* d_out, int out_size, void* d_ws, size_t ws_size, hipStream_t stream) {
    static int grid = 0;
    if (grid == 0) {
        if (n_in != 26 || in_sizes[0] != MX * DM || out_size != MX * DM || ws_size < WS_END) { fprintf(stderr, "kernel_launch: unexpected shapes (n_in %d, in0 %d, out %d, ws %zu)\n", n_in, n_in > 0 ? in_sizes[0] : -1, out_size, ws_size); grid = -1; return; }
        int dev = 0, cus = 0, per_cu = 0;
        if (hipGetDevice(&dev) != hipSuccess || hipDeviceGetAttribute(&cus, hipDeviceAttributeMultiprocessorCount, dev) != hipSuccess) { grid = -1; return; }
        if (hipFuncSetAttribute((const void*)mega_fwd, hipFuncAttributeMaxDynamicSharedMemorySize, LDS_BYTES) != hipSuccess) { fprintf(stderr, "kernel_launch: hipFuncSetAttribute failed\n"); grid = -1; return; }
        if (hipOccupancyMaxActiveBlocksPerMultiprocessor(&per_cu, (const void*)mega_fwd, 512, LDS_BYTES) != hipSuccess || per_cu < 1) { fprintf(stderr, "kernel_launch: occupancy query says %d\n", per_cu); per_cu = 1; }
        (void)hipGetLastError();
        grid = cus;
    }
    if (grid < 0) return;
    Params p{};
    const float** pp = (const float**)&p;
    for (int i = 0; i < 26; ++i) pp[i] = (const float*)d_in[i];
    p.out = (float*)d_out; p.ws = (unsigned char*)d_ws;
#if MK_ONE_LAUNCH
    p.ph_lo = 0; p.ph_hi = NPHASE;
    void* args[] = {&p};
    hipError_t e = hipLaunchCooperativeKernel((const void*)mega_fwd, dim3(grid), dim3(512), args, LDS_BYTES, stream);
    if (e != hipSuccess) fprintf(stderr, "cooperative launch failed: %s (grid %d)\n", hipGetErrorString(e), grid);
#else
    for (int ph = 0; ph < NPHASE; ++ph) {
        p.ph_lo = ph; p.ph_hi = ph + 1;
        hipLaunchKernelGGL(mega_fwd, dim3(grid), dim3(512), LDS_BYTES, stream, p);
    }
#endif
}
```

```cpp
#include <hip/hip_runtime.h>
#include <hip/hip_cooperative_groups.h>
#include <cstdio>
#include <cstdint>
namespace cg = cooperative_groups;

#ifndef MK_ONE_LAUNCH
#define MK_ONE_LAUNCH 1
#endif

#define LAS __attribute__((address_space(3)))
typedef unsigned short bf16_t;
typedef short bf16x8 __attribute__((ext_vector_type(8)));
typedef float f32x4 __attribute__((ext_vector_type(4)));
typedef float f32x16 __attribute__((ext_vector_type(16)));
typedef unsigned u32x4 __attribute__((ext_vector_type(4)));
typedef unsigned u32x2 __attribute__((ext_vector_type(2)));

constexpr int DM = 1024, NB = 32, SEQ = 2048, CTXL = 256, DFF = 2816;
constexpr int MX = NB * SEQ;
constexpr int MC = NB * CTXL;
constexpr int MT = MX + MC;
constexpr int NMOD = 9 * DM;
constexpr int NPROJ = 1536;
constexpr int NH = 8, DQK = 96, DV = 64;
constexpr float EPS = 1e-6f;
constexpr float QSCALE = 0.10206207261596577f * 1.4426950408889634f;

constexpr size_t MiB = 1u << 20;
constexpr size_t WS_MOD = 1 * MiB, WS_RSQ = 3 * MiB, WS_RSKV = 3 * MiB + 512 * 1024;
constexpr size_t WS_W13A = 4 * MiB, WS_W2A = 15 * MiB, WS_W13B = 21 * MiB, WS_W2B = 32 * MiB, WS_WIN = 38 * MiB;
constexpr size_t WS_WUQ = 41 * MiB, WS_WK = 41 * MiB + 512 * 1024, WS_WV = 41 * MiB + 768 * 1024, WS_WOUT = 42 * MiB, WS_WS = 44 * MiB;
constexpr size_t WS_X1C = 46 * MiB, WS_H = 80 * MiB, WS_ACT = 224 * MiB;
constexpr size_t WS_PROJ = 224 * MiB, WS_QRAW = 440 * MiB, WS_KNOPE = 536 * MiB;
constexpr size_t WS_KF = 620 * MiB, WS_VT = 728 * MiB, WS_END = 800 * MiB;
constexpr size_t WS_MIX = WS_H;
constexpr size_t WS_SWIN = 44 * MiB + 512 * 1024, WS_SW13 = 45 * MiB, WS_SS2 = 78 * MiB, WS_SS3 = 78 * MiB + 512 * 1024;
constexpr size_t WS_H3 = WS_KF;

constexpr int LDS_BYTES = 147456;

__device__ __forceinline__ unsigned pk2(float lo, float hi) {
    typedef float f2 __attribute__((ext_vector_type(2))); typedef __bf16 b2 __attribute__((ext_vector_type(2)));
    f2 v = {lo, hi}; b2 b = __builtin_convertvector(v, b2); return __builtin_bit_cast(unsigned, b);
}
__device__ __forceinline__ float bflo(unsigned w) { return __uint_as_float(w << 16); }
__device__ __forceinline__ float bfhi(unsigned w) { return __uint_as_float(w & 0xffff0000u); }
__device__ __forceinline__ float fexp2(float x) { return __builtin_amdgcn_exp2f(x); }
__device__ __forceinline__ float frcp(float x) { return __builtin_amdgcn_rcpf(x); }
__device__ __forceinline__ float silu_f(float a) { return a * frcp(1.f + fexp2(-1.4426950408889634f * a)); }
__device__ __forceinline__ float gelu_f(float x) { const float y = 0.7978845608028654f * (x + 0.044715f * x * x * x); return x * frcp(1.f + fexp2(-2.8853900817779268f * y)); }
__device__ __forceinline__ float wave_sum(float v) {
#pragma unroll
    for (int o = 1; o < 64; o <<= 1) v += __shfl_xor(v, o);
    return v;
}
#define LDS_WAIT() asm volatile("s_waitcnt lgkmcnt(0)" ::: "memory")

namespace pg8 {
constexpr int BM = 256, BK = 64, HALF = 128, HTB = HALF * BK * 2, STAGE_BYTES = 8 * HTB, NXCD = 8, WGM = 4;
__host__ __device__ __forceinline__ int lds_byte(int r, int c) { const int st = (r >> 4) * 2 + (c >> 5), rr = r & 15, cc = c & 31, ob = rr * 64 + cc * 2; return st * 1024 + (ob ^ (((ob >> 9) & 1) << 5)); }
__host__ __device__ __forceinline__ void stage_rc(int b, int& R, int& C) { const int st = b / 1024, sb = b % 1024, swz = sb ^ (((sb >> 9) & 1) << 5); R = (st >> 1) * 16 + swz / 64; C = (st & 1) * 32 + (swz % 64) / 2; }
__host__ __device__ __forceinline__ int perm32(int rho) { const int n = rho >> 4, i = rho & 15; return 8 * (i >> 2) + 4 * n + (i & 3); }

struct Unit { int pm, pn; };
struct Gemm { const bf16_t* A; const bf16_t* Bt; int M, N, K, lda, ldb; };

struct StaticOrder {
    int nM, nN, nwg, G, c;
    __device__ void init(int M, int N, int G_, int c_) { nM = M / BM; nN = N / BM; nwg = nM * nN; G = G_; c = c_; }
    __device__ bool next(int i, Unit& u) const {
        const long L = (long)i * G + c; if (L >= nwg) return false;
        int wgid = (int)L; { const int q = nwg / NXCD, r = nwg % NXCD, xcd = wgid % NXCD, off = wgid / NXCD; wgid = (xcd < r ? xcd * (q + 1) : r * (q + 1) + (xcd - r) * q) + off; }
        const int nig = WGM * nN, gid = wgid / nig, fm = gid * WGM, gsz = (nM - fm) < WGM ? (nM - fm) : WGM;
        u.pm = fm + ((wgid % nig) % gsz); u.pn = (wgid % nig) / gsz; return true;
    }
};

template <bool NORM, bool TILED = true> struct EpiSwigluT {
    static constexpr bool PERM = true;
    bf16_t* O; int ldc; const float* SSn; const float* cb;
    __device__ __forceinline__ void operator()(const f32x4 (&acc)[2][2][4][2], const Unit& u, int wr, int wc, int fr, int fq) const {
        const int row0 = u.pm * BM + wr * 64 + fr, col0 = u.pn * HALF + wc * 32 + 8 * fq;
        f32x4 cv[2][2];
        if (NORM) {
            const float* cbp = cb + (size_t)(u.pm >> 3) * (2 * DFF) + u.pn * BM + wc * 32 + 8 * fq;
#pragma unroll
            for (int bj = 0; bj < 2; ++bj)
#pragma unroll
                for (int n = 0; n < 2; ++n) cv[bj][n] = *(const f32x4*)(cbp + bj * HALF + 4 * n);
        }
#pragma unroll
        for (int ai = 0; ai < 2; ++ai)
#pragma unroll
            for (int m = 0; m < 4; ++m) {
                const int row = row0 + ai * HALF + m * 16;
                bf16_t* rowp = TILED ? O + ((size_t)((row >> 4) * (ldc >> 5) + (col0 >> 5)) * 512 + (row & 15) * 32 + (col0 & 31)) : O + (size_t)row * ldc + col0;
                f32x4 a0 = acc[ai][0][m][0], a1 = acc[ai][0][m][1], b0 = acc[ai][1][m][0], b1 = acc[ai][1][m][1];
                if (NORM) { const float r = rsqrtf(SSn[row] * (1.f / DM) + EPS); a0 = a0 * r + cv[0][0]; a1 = a1 * r + cv[0][1]; b0 = b0 * r + cv[1][0]; b1 = b1 * r + cv[1][1]; }
                u32x4 w;
                w.x = pk2(silu_f(a0[0]) * b0[0], silu_f(a0[1]) * b0[1]); w.y = pk2(silu_f(a0[2]) * b0[2], silu_f(a0[3]) * b0[3]);
                w.z = pk2(silu_f(a1[0]) * b1[0], silu_f(a1[1]) * b1[1]); w.w = pk2(silu_f(a1[2]) * b1[2], silu_f(a1[3]) * b1[3]);
                *(u32x4*)rowp = w;
            }
    }
};
template <int ctx_tile0, int COEF2, bool NORM> struct EpiRes {
    static constexpr bool PERM = true;
    const float* bx; const float* bc; float* ox; float* oc; const float* gate;
    const float* nw; const float* nscale; bf16_t* Hn; float* SS;
    __device__ __forceinline__ void operator()(const f32x4 (&acc)[2][2][4][2], const Unit& u, int wr, int wc, int fr, int fq) const {
        asm volatile("" : "+v"(fr), "+v"(fq));
        const bool isc = u.pm >= ctx_tile0;
        const int mrow = isc ? 32 : (u.pm >> 3);
        const int prow = isc ? (u.pm - ctx_tile0) : u.pm;
        const float* base = isc ? bc : bx; float* out = isc ? oc : ox;
        const int col0 = u.pn * BM + wc * 32 + 8 * fq;
        f32x4 gv[2][2], G[2][2]; float ssv[2][4];
#pragma unroll
        for (int bj = 0; bj < 2; ++bj)
#pragma unroll
            for (int n = 0; n < 2; ++n) { const int c = col0 + bj * HALF + 4 * n; gv[bj][n] = *(const f32x4*)(gate + (size_t)mrow * NMOD + c) * (0.5f * COEF2);
                if (NORM) G[bj][n] = *(const f32x4*)(nw + c) * (*(const f32x4*)(nscale + (size_t)mrow * NMOD + c) + 1.f); }
#pragma unroll
        for (int ai = 0; ai < 2; ++ai)
#pragma unroll
            for (int m = 0; m < 4; ++m) {
                const int rl = ai * HALF + wr * 64 + m * 16 + fr;
                const size_t off = (size_t)(prow * BM + rl) * DM + col0;
                const size_t hrow = (size_t)u.pm * BM + rl;
                float ss = 0.f;
#pragma unroll
                for (int bj = 0; bj < 2; ++bj) {
                    const f32x4 o0 = *(const f32x4*)(base + off + bj * HALF) + gv[bj][0] * acc[ai][bj][m][0];
                    const f32x4 o1 = *(const f32x4*)(base + off + bj * HALF + 4) + gv[bj][1] * acc[ai][bj][m][1];
                    if (!isc) { *(f32x4*)(out + off + bj * HALF) = o0; *(f32x4*)(out + off + bj * HALF + 4) = o1; }
                    if (NORM) {
                        ss += (o0[0] * o0[0] + o0[1] * o0[1]) + (o0[2] * o0[2] + o0[3] * o0[3]) + (o1[0] * o1[0] + o1[1] * o1[1]) + (o1[2] * o1[2] + o1[3] * o1[3]);
                        const f32x4 h0 = o0 * G[bj][0], h1 = o1 * G[bj][1];
                        u32x4 w; w.x = pk2(h0[0], h0[1]); w.y = pk2(h0[2], h0[3]); w.z = pk2(h1[0], h1[1]); w.w = pk2(h1[2], h1[3]);
                        *(u32x4*)(Hn + hrow * DM + col0 + bj * HALF) = w;
                    }
                }
                if (NORM) { ss += __shfl_xor(ss, 16); ss += __shfl_xor(ss, 32); ssv[ai][m] = ss; }
            }
        if (NORM) {
            asm volatile("" ::: "memory");
#pragma unroll
            for (int ai = 0; ai < 2; ++ai)
#pragma unroll
                for (int m = 0; m < 4; ++m)
                    if (fq == 0) __hip_atomic_fetch_add(SS + (size_t)u.pm * BM + ai * HALF + wr * 64 + m * 16 + fr, ssv[ai][m], __ATOMIC_RELAXED, __HIP_MEMORY_SCOPE_AGENT);
        }
    }
};
struct EpiBf16S {
    static constexpr bool PERM = true;
    bf16_t* O; int ldc; const float* rs; const float* cs; const float* SSn; const float* cb; int ldcb; int mrow_fixed;
    __device__ __forceinline__ void operator()(const f32x4 (&acc)[2][2][4][2], const Unit& u, int wr, int wc, int fr, int fq) const {
        const int row0 = u.pm * BM + wr * 64 + fr, col0 = u.pn * BM + wc * 32 + 8 * fq;
        const int mrow = mrow_fixed >= 0 ? mrow_fixed : (u.pm >> 3);
        f32x4 cv[2][2], bv[2][2];
#pragma unroll
        for (int bj = 0; bj < 2; ++bj)
#pragma unroll
            for (int n = 0; n < 2; ++n) { cv[bj][n] = cs ? *(const f32x4*)(cs + col0 + bj * HALF + 4 * n) : (f32x4){1.f, 1.f, 1.f, 1.f};
                bv[bj][n] = cb ? *(const f32x4*)(cb + (size_t)mrow * ldcb + col0 + bj * HALF + 4 * n) : (f32x4){0.f, 0.f, 0.f, 0.f}; }
#pragma unroll
        for (int ai = 0; ai < 2; ++ai)
#pragma unroll
            for (int m = 0; m < 4; ++m) {
                const int row = row0 + ai * HALF + m * 16;
                const float r = SSn ? rsqrtf(SSn[row] * (1.f / DM) + EPS) : (rs ? rs[row] : 1.f);
                bf16_t* rowp = O + (size_t)row * ldc + col0;
#pragma unroll
                for (int bj = 0; bj < 2; ++bj) {
                    const f32x4 v0 = acc[ai][bj][m][0] * cv[bj][0] * r + bv[bj][0], v1 = acc[ai][bj][m][1] * cv[bj][1] * r + bv[bj][1];
                    u32x4 w; w.x = pk2(v0[0], v0[1]); w.y = pk2(v0[2], v0[3]); w.z = pk2(v1[0], v1[1]); w.w = pk2(v1[2], v1[3]);
                    *(u32x4*)(rowp + bj * HALF) = w;
                }
            }
    }
};

template <class Epi, class Sched, bool TILEDA = false>
__device__ __forceinline__ void gemm_phase(LAS unsigned char* lds, const Gemm g, const Sched& S, const Epi& E) {
    const int tid = threadIdx.x, wid = __builtin_amdgcn_readfirstlane(tid >> 6), lane = tid & 63, wr = wid >> 2, wc = wid & 3, fr = lane & 15, fq = lane >> 4;
    const int K = g.K, nt = K / BK;
    unsigned voffA[2], voffB[2];
#pragma unroll
    for (int i = 0; i < 2; ++i) { int R, C; stage_rc(tid * 16 + i * 8192, R, C); const int Rb = Epi::PERM ? ((R & ~31) + perm32(R & 31)) : R;
        voffA[i] = TILEDA ? (unsigned)(((R >> 4) * (g.lda >> 5) + (C >> 5)) * 1024 + (R & 15) * 64 + (C & 31) * 2) : (unsigned)(R * g.lda + C) * 2u;
        voffB[i] = (unsigned)(Rb * g.ldb + C) * 2u; }
    const size_t kstep = (size_t)(BK * 2), kstepA = TILEDA ? (size_t)2048 : kstep;
    const size_t hA = TILEDA ? (size_t)(HALF / 16) * (g.lda >> 5) * 1024 : (size_t)HALF * g.lda * 2, hB = (size_t)HALF * g.ldb * 2;
    const size_t tA = 2 * hA, tB = 2 * hB;
    const unsigned ldsw = (unsigned)wid * 1024u;
    const int aoff = lds_byte(wr * 64 + fr, fq * 8), boff = lds_byte(wc * 32 + fr, fq * 8);
#define PG8_SA(b, h) (((b) * 2 + (h)) * HTB)
#define PG8_SB(b, h) ((4 + (b) * 2 + (h)) * HTB)
#define PG8_STAGE(bufoff, gbase, voff) do { _Pragma("unroll") for (int _i = 0; _i < 2; ++_i) \
        __builtin_amdgcn_global_load_lds((const unsigned*)((const char*)(gbase) + (voff)[_i]), (LAS unsigned*)(lds + (bufoff) + ldsw + _i * 8192), 16, 0, 0); } while (0)
#define PG8_LDA(dst, b, h) do { _Pragma("unroll") for (int m = 0; m < 4; ++m) _Pragma("unroll") for (int k = 0; k < 2; ++k) dst[m][k] = *(const LAS bf16x8*)(lds + PG8_SA(b, h) + aoff + m * 2048 + k * 1024); } while (0)
#define PG8_LDB(dst, b, h) do { _Pragma("unroll") for (int n = 0; n < 2; ++n) _Pragma("unroll") for (int k = 0; k < 2; ++k) dst[n][k] = *(const LAS bf16x8*)(lds + PG8_SB(b, h) + boff + n * 2048 + k * 1024); } while (0)
#define PG8_MMA(ai, bj, At, Bt) do { __builtin_amdgcn_s_setprio(1); _Pragma("unroll") for (int m = 0; m < 4; ++m) _Pragma("unroll") for (int n = 0; n < 2; ++n) _Pragma("unroll") for (int k = 0; k < 2; ++k) \
        acc[ai][bj][m][n] = __builtin_amdgcn_mfma_f32_16x16x32_bf16(Bt[n][k], At[m][k], acc[ai][bj][m][n], 0, 0, 0); __builtin_amdgcn_s_setprio(0); } while (0)
#define PG8_WAIT_V(n) asm volatile("s_waitcnt vmcnt(" #n ")" ::: "memory")
#define PG8_WAIT_L(n) asm volatile("s_waitcnt lgkmcnt(" #n ")" ::: "memory")
#define PG8_BAR __builtin_amdgcn_s_barrier()
#define PG8_SCHED __builtin_amdgcn_sched_barrier(0)
    Unit cur, nxt; int ui = 0;
    if (!S.next(0, cur)) return;
    f32x4 acc[2][2][4][2];
#pragma unroll
    for (int a = 0; a < 2; ++a)
#pragma unroll
        for (int b = 0; b < 2; ++b)
#pragma unroll
            for (int m = 0; m < 4; ++m)
#pragma unroll
                for (int n = 0; n < 2; ++n) acc[a][b][m][n] = (f32x4){0.f, 0.f, 0.f, 0.f};
    bf16x8 At[4][2], B0[2][2], B1[2][2];
    const char* cA = (const char*)g.A + (size_t)cur.pm * tA; const char* cB = (const char*)g.Bt + (size_t)cur.pn * tB;
    PG8_STAGE(PG8_SB(0, 0), cB, voffB); PG8_STAGE(PG8_SB(0, 1), cB + hB, voffB); PG8_STAGE(PG8_SA(0, 0), cA, voffA); PG8_STAGE(PG8_SA(0, 1), cA + hA, voffA);
    if (wr == 1) PG8_BAR;
    PG8_WAIT_V(2); PG8_BAR;
    PG8_STAGE(PG8_SB(1, 0), cB + kstep, voffB); PG8_STAGE(PG8_SA(1, 0), cA + kstepA, voffA); PG8_STAGE(PG8_SB(1, 1), cB + hB + kstep, voffB);
    PG8_WAIT_V(6); PG8_BAR;
    for (;;) {
        const bool has_next = S.next(ui + 1, nxt);
        const char* nA = has_next ? (const char*)g.A + (size_t)nxt.pm * tA : cA; const char* nB = has_next ? (const char*)g.Bt + (size_t)nxt.pn * tB : cB;
        for (int t = 0; t < nt; t += 2) {
            const bool last = (t == nt - 2);
            const char* a1 = cA + (size_t)(t + 1) * kstepA;
            const char* a2 = last ? nA : cA + (size_t)(t + 2) * kstepA; const char* b2 = last ? nB : cB + (size_t)(t + 2) * kstep;
            const char* a3 = a2 + kstepA; const char* b3 = b2 + kstep;
            PG8_LDB(B0, 0, 0); PG8_LDB(B1, 0, 1); PG8_SCHED; PG8_LDA(At, 0, 0); PG8_STAGE(PG8_SA(1, 1), a1 + hA, voffA);
            PG8_WAIT_V(8); PG8_WAIT_L(0); PG8_BAR; PG8_MMA(0, 0, At, B0); PG8_MMA(0, 1, At, B1); PG8_BAR; PG8_SCHED;
            PG8_LDA(At, 0, 1); PG8_STAGE(PG8_SB(0, 0), b2, voffB); PG8_STAGE(PG8_SB(0, 1), b2 + hB, voffB); PG8_STAGE(PG8_SA(0, 0), a2, voffA);
            PG8_WAIT_V(8); PG8_WAIT_L(0); PG8_BAR; PG8_MMA(1, 0, At, B0); PG8_MMA(1, 1, At, B1); PG8_BAR; PG8_SCHED;
            PG8_LDB(B0, 1, 0); PG8_LDB(B1, 1, 1); PG8_SCHED; PG8_LDA(At, 1, 0); PG8_STAGE(PG8_SA(0, 1), a2 + hA, voffA);
            PG8_WAIT_V(8); PG8_WAIT_L(0); PG8_BAR; PG8_MMA(0, 0, At, B0); PG8_MMA(0, 1, At, B1); PG8_BAR; PG8_SCHED;
            PG8_LDA(At, 1, 1); PG8_STAGE(PG8_SB(1, 0), b3, voffB); PG8_STAGE(PG8_SB(1, 1), b3 + hB, voffB); PG8_STAGE(PG8_SA(1, 0), a3, voffA);
            PG8_WAIT_V(8); PG8_WAIT_L(0); PG8_BAR; PG8_MMA(1, 0, At, B0); PG8_MMA(1, 1, At, B1); PG8_BAR; PG8_SCHED;
        }
        if (wr == 0) PG8_BAR;
        E(acc, cur, wr, wc, fr, fq);
        if (!has_next) break;
#pragma unroll
        for (int a = 0; a < 2; ++a)
#pragma unroll
            for (int b = 0; b < 2; ++b)
#pragma unroll
                for (int m = 0; m < 4; ++m)
#pragma unroll
                    for (int n = 0; n < 2; ++n) acc[a][b][m][n] = (f32x4){0.f, 0.f, 0.f, 0.f};
        cur = nxt; cA = nA; cB = nB; ++ui;
        if (wr == 1) PG8_BAR;
    }
    PG8_WAIT_V(0);
    PG8_BAR;
#undef PG8_SA
#undef PG8_SB
#undef PG8_STAGE
#undef PG8_LDA
#undef PG8_LDB
#undef PG8_MMA
#undef PG8_WAIT_V
#undef PG8_WAIT_L
#undef PG8_BAR
#undef PG8_SCHED
}
}

struct Params {
    const float *x, *c, *ctx, *cctx, *w_ada, *b_ada, *norm1, *f1w1, *f1w3, *f1w2, *norm2, *w_in, *qan, *w_uq, *kvan, *w_ukv, *qn, *kn, *vn, *w_s, *b_s, *w_out, *norm3, *f2w1, *f2w3, *f2w2;
    float* out; unsigned char* ws; int ph_lo, ph_hi;
};

__device__ __forceinline__ void tr_item(const float* W, int N, int k0, int n0, bf16_t* dst, int ldd, const float* kscale, float* scr, int lane) {
#pragma unroll 8
    for (int i = 0; i < 32; ++i) { const int kk = 2 * i + (lane >> 5); float v = W[(size_t)(k0 + kk) * N + n0 + (lane & 31)]; if (kscale) v *= kscale[k0 + kk]; scr[kk * 33 + (lane & 31)] = v; }
    LDS_WAIT();
    const int c = lane & 7;
#pragma unroll
    for (int j = 0; j < 4; ++j) { const int n = (lane >> 3) + 8 * j; const float* s = scr + (8 * c) * 33 + n;
        u32x4 o; o.x = pk2(s[0 * 33], s[1 * 33]); o.y = pk2(s[2 * 33], s[3 * 33]); o.z = pk2(s[4 * 33], s[5 * 33]); o.w = pk2(s[6 * 33], s[7 * 33]);
        *(u32x4*)(dst + (size_t)n * ldd + 8 * c) = o; }
    LDS_WAIT();
}
__device__ __forceinline__ int win_row(int n) {
    if (n < 128) return 256 + n;
    if (n < 160) return 384 + (n - 128);
    if (n < 416) return n - 160;
    if (n < 928) return 512 + (n - 416);
    return 1024 + (n - 928);
}
template <bool SILU>
__device__ __forceinline__ void rowmat_item(const float* in, int istr, const float* in32, const float* W, int N, int j, const float* bias, float* out, int ldo, int cmap, float* lds, int tid) {
    const int wave = tid >> 6, lane = tid & 63, col = 64 * j + lane; const bool cok = col < N; const int colc = cok ? col : N - 1;
    float acc[33];
#pragma unroll
    for (int r = 0; r < 33; ++r) acc[r] = 0.f;
    for (int pass = 0; pass < 2; ++pass) {
        __syncthreads();
        {
            float cvv[33];
#pragma unroll
            for (int r = 0; r < 33; ++r) cvv[r] = (r < 32) ? in[(size_t)r * istr + 512 * pass + tid] : in32[512 * pass + tid];
#pragma unroll
            for (int r = 0; r < 33; ++r) lds[r * 512 + tid] = SILU ? cvv[r] / (1.f + __expf(-cvv[r])) : cvv[r];
        }
        __syncthreads();
        const int kb = 512 * pass + 64 * wave;
        const float* Wc = W + (size_t)kb * N + colc;
        float w0 = Wc[0], w1 = Wc[(size_t)N], w2 = Wc[(size_t)2 * N], w3 = Wc[(size_t)3 * N];
        float x0 = Wc[(size_t)4 * N], x1 = Wc[(size_t)5 * N], x2 = Wc[(size_t)6 * N], x3 = Wc[(size_t)7 * N];
        for (int k4 = 0; k4 < 16; ++k4) {
            const int kn = (k4 + 2 < 16) ? 4 * (k4 + 2) : 0;
            const float y0 = Wc[(size_t)(kn + 0) * N], y1 = Wc[(size_t)(kn + 1) * N], y2 = Wc[(size_t)(kn + 2) * N], y3 = Wc[(size_t)(kn + 3) * N];
#pragma unroll
            for (int r = 0; r < 33; ++r) { const f32x4 s = *(const f32x4*)(lds + r * 512 + 64 * wave + 4 * k4); acc[r] += s[0] * w0 + s[1] * w1 + s[2] * w2 + s[3] * w3; }
            w0 = x0; w1 = x1; w2 = x2; w3 = x3; x0 = y0; x1 = y1; x2 = y2; x3 = y3;
        }
    }
    __syncthreads();
#pragma unroll
    for (int r = 0; r < 33; ++r) lds[(wave * 33 + r) * 64 + lane] = acc[r];
    __syncthreads();
    for (int idx = tid; idx < 33 * 64; idx += 512) { const int r = idx >> 6, l = idx & 63, c = 64 * j + l; float s = 0.f;
#pragma unroll
        for (int w = 0; w < 8; ++w) s += lds[(w * 33 + r) * 64 + l];
        if (c < N) { const int oc = cmap == 0 ? c : cmap == 1 ? win_row(c) : (256 * (c >> 7) + (c & 127) + (cmap == 3 ? 128 : 0));
            out[(size_t)r * ldo + oc] = s + (bias ? bias[c] : 0.f); } }
    __syncthreads();
}
constexpr int I_UP = 16 * 88, I_DN = 44 * 32, I_IN = 16 * 45, I_UQ = 4 * 24, I_UKV = 2 * 32, I_OUT = 16 * 32;
constexpr int NITEMS = 4 * I_UP + 2 * I_DN + I_IN + I_UQ + I_UKV + I_OUT;
__device__ __forceinline__ void tr_dispatch(const Params& p, int it, float* scr, int lane) {
    unsigned char* ws = p.ws;
    int r = it;
    if (r < 4 * I_UP) { const int which = r / I_UP; r -= which * I_UP; const int kb = r / 88, nb = r % 88, k0 = 64 * kb, n0 = 32 * nb;
        const float* W = which == 0 ? p.f1w1 : which == 1 ? p.f1w3 : which == 2 ? p.f2w1 : p.f2w3;
        bf16_t* D = (bf16_t*)(ws + (which < 2 ? WS_W13A : WS_W13B));
        const int row = 256 * (n0 >> 7) + (n0 & 127) + ((which & 1) ? 128 : 0);
        tr_item(W, DFF, k0, n0, D + (size_t)row * DM + k0, DM, nullptr, scr, lane); return; }
    r -= 4 * I_UP;
    if (r < 2 * I_DN) { const int which = r / I_DN; r -= which * I_DN; const int kb = r / 32, nb = r % 32, k0 = 64 * kb, n0 = 32 * nb;
        tr_item(which ? p.f2w2 : p.f1w2, DM, k0, n0, (bf16_t*)(ws + (which ? WS_W2B : WS_W2A)) + (size_t)n0 * DFF + k0, DFF, nullptr, scr, lane); return; }
    r -= 2 * I_DN;
    if (r < I_IN) { const int kb = r / 45, nb = r % 45, k0 = 64 * kb, n0 = 32 * nb;
        tr_item(p.w_in, 1440, k0, n0, (bf16_t*)(ws + WS_WIN) + (size_t)win_row(n0) * DM + k0, DM, nullptr, scr, lane); return; }
    r -= I_IN;
    if (r < I_UQ) { const int kb = r / 24, nb = r % 24, k0 = 64 * kb, n0 = 32 * nb;
        tr_item(p.w_uq, 768, k0, n0, (bf16_t*)(ws + WS_WUQ) + (size_t)n0 * 256 + k0, 256, p.qan, scr, lane); return; }
    r -= I_UQ;
    if (r < I_UKV) { const int kb = r / 32, nb = r % 32, k0 = 64 * kb, n0 = 32 * nb; const int h = n0 >> 7, j = n0 & 127;
        bf16_t* D = (j < 64) ? (bf16_t*)(ws + WS_WK) + (size_t)(h * 64 + j) * 256 : (bf16_t*)(ws + WS_WV) + (size_t)(h * 64 + j - 64) * 256;
        tr_item(p.w_ukv, 1024, k0, n0, D + k0, 256, p.kvan, scr, lane); return; }
    r -= I_UKV;
    { const int kb = r / 32, nb = r % 32, k0 = 64 * kb, n0 = 32 * nb;
        tr_item(p.w_out, DM, k0, n0, (bf16_t*)(ws + WS_WOUT) + (size_t)n0 * DM + k0, DM, nullptr, scr, lane); }
}
__device__ __forceinline__ void tr_set(const Params& p, int set, int widx, int nw, float* scr, int lane, int j0 = 0, int j1 = 1 << 30) {
    const int nall = set == 1 ? (I_IN + I_UQ + I_UKV + I_OUT) : (2 * I_UP + I_DN); const int n = j1 < nall ? j1 : nall;
    for (int j = j0 + widx; j < n; j += nw) {
        const int it = set == 0 ? (j < 2 * I_UP ? j : 4 * I_UP + (j - 2 * I_UP))
                     : set == 1 ? (4 * I_UP + 2 * I_DN + j)
                     : (j < 2 * I_UP ? 2 * I_UP + j : 4 * I_UP + I_DN + (j - 2 * I_UP));
        tr_dispatch(p, it, scr, lane);
    }
}
__device__ __forceinline__ void phase0(const Params& p, float* lds) {
    unsigned char* ws = p.ws;
    const int tid = threadIdx.x, lane = tid & 63, wave = tid >> 6, G = gridDim.x;
    float* MOD = (float*)(ws + WS_MOD);
    if ((int)blockIdx.x < 144) rowmat_item<true>(p.c, DM, p.cctx, p.w_ada, NMOD, blockIdx.x, p.b_ada, MOD, NMOD, 0, lds, tid);
    {
        const int gt = blockIdx.x * 512 + tid, NT = G * 512;
        { f32x4* zs = (f32x4*)(ws + WS_SWIN); for (int i = gt; i < 33 * NPROJ / 4; i += NT) zs[i] = (f32x4){0.f, 0.f, 0.f, 0.f}; }
        { f32x4* zs = (f32x4*)(ws + WS_SS2); for (int i = gt; i < MT / 4; i += NT) zs[i] = (f32x4){0.f, 0.f, 0.f, 0.f}; }
        { f32x4* zs = (f32x4*)(ws + WS_SS3); for (int i = gt; i < MX / 4; i += NT) zs[i] = (f32x4){0.f, 0.f, 0.f, 0.f}; }
        u32x4* z0 = (u32x4*)((bf16_t*)(ws + WS_WIN) + (size_t)416 * 1024);
        for (int i = gt; i < 96 * 1024 / 8; i += NT) z0[i] = (u32x4){0u, 0u, 0u, 0u};
        for (int i = gt; i < 8 * 128 * 128 / 8; i += NT) { const f32x4 a = *(const f32x4*)(p.w_s + (size_t)i * 8), b = *(const f32x4*)(p.w_s + (size_t)i * 8 + 4);
            u32x4 o; o.x = pk2(a[0], a[1]); o.y = pk2(a[2], a[3]); o.z = pk2(b[0], b[1]); o.w = pk2(b[2], b[3]); *(u32x4*)((bf16_t*)(ws + WS_WS) + (size_t)i * 8) = o; }
    }
    if (G > 144) { if ((int)blockIdx.x >= 144) tr_set(p, 0, ((int)blockIdx.x - 144) * 8 + wave, (G - 144) * 8, lds + wave * 4096, lane, 1152);
                   else tr_set(p, 0, (int)blockIdx.x * 8 + wave, 1152, lds + wave * 4096, lane, 0, 1152); }
    else tr_set(p, 0, blockIdx.x * 8 + wave, G * 8, lds + wave * 4096, lane);
    __syncthreads();
}

__device__ __forceinline__ void norm_mod_phase(const float* srcx, const float* srcc, int nrows, const float* w, const float* MOD, int ishift, bf16_t* H) {
    const int tid = threadIdx.x, lane = tid & 63, wave = tid >> 6;
    const int gw = blockIdx.x * 8 + wave, NGW = gridDim.x * 8, nch = nrows / 8;
    for (int ch = gw; ch < nch; ch += NGW) {
        const int row0 = ch * 8; const bool isc = row0 >= MX; const int mrow = isc ? 32 : (row0 >> 11);
        const float* src = isc ? srcc + (size_t)(row0 - MX) * DM : srcx + (size_t)row0 * DM;
        const float* sh = MOD + (size_t)mrow * NMOD + ishift * DM; const float* sc = sh + DM;
        f32x4 g[4], s[4];
#pragma unroll
        for (int j = 0; j < 4; ++j) { const int c = 4 * lane + 256 * j; const f32x4 wv = *(const f32x4*)(w + c), scv = *(const f32x4*)(sc + c); g[j] = wv * (scv + 1.f); s[j] = *(const f32x4*)(sh + c); }
        f32x4 nx[4];
#pragma unroll
        for (int j = 0; j < 4; ++j) nx[j] = ((const f32x4*)src + lane)[64 * j];
        for (int rr = 0; rr < 8; ++rr) {
            f32x4 v[4]; float ss = 0.f;
#pragma unroll
            for (int j = 0; j < 4; ++j) v[j] = nx[j];
            if (rr < 7) { const f32x4* xr = (const f32x4*)(src + (size_t)(rr + 1) * DM) + lane;
#pragma unroll
                for (int j = 0; j < 4; ++j) nx[j] = xr[64 * j]; }
#pragma unroll
            for (int j = 0; j < 4; ++j) ss += (v[j][0] * v[j][0] + v[j][1] * v[j][1]) + (v[j][2] * v[j][2] + v[j][3] * v[j][3]);
            const float rstd = rsqrtf(wave_sum(ss) * (1.f / DM) + EPS);
            u32x2* o = (u32x2*)(H + (size_t)(row0 + rr) * DM) + lane;
#pragma unroll
            for (int j = 0; j < 4; ++j) { const f32x4 y = v[j] * rstd * g[j] + s[j]; u32x2 ov; ov.x = pk2(y[0], y[1]); ov.y = pk2(y[2], y[3]); o[64 * j] = ov; }
        }
    }
}

__device__ __forceinline__ void rstd_phase(const bf16_t* PROJ, float* RSQ, float* RSKV) {
    const int tid = threadIdx.x, lane = tid & 63, wave = tid >> 6;
    const int gw = blockIdx.x * 8 + wave, NGW = gridDim.x * 8;
    for (int r4 = gw; r4 < MT / 4; r4 += NGW) {
        unsigned kv[4]; u32x2 q[4];
#pragma unroll
        for (int i = 0; i < 4; ++i) { const int row = 4 * r4 + i; const bf16_t* pr = PROJ + (size_t)row * NPROJ;
            kv[i] = *((const unsigned*)(pr + 256) + lane); q[i] = (row < MX) ? *((const u32x2*)pr + lane) : (u32x2){0u, 0u}; }
#pragma unroll
        for (int i = 0; i < 4; ++i) { const int row = 4 * r4 + i;
            float s2 = bflo(kv[i]) * bflo(kv[i]) + bfhi(kv[i]) * bfhi(kv[i]);
            float s1 = (bflo(q[i].x) * bflo(q[i].x) + bfhi(q[i].x) * bfhi(q[i].x)) + (bflo(q[i].y) * bflo(q[i].y) + bfhi(q[i].y) * bfhi(q[i].y));
            s2 = wave_sum(s2); s1 = wave_sum(s1);
            if (lane == 0) { RSKV[row] = rsqrtf(s2 * (1.f / 128.f) + EPS); if (row < MX) RSQ[row] = rsqrtf(s1 * (1.f / 256.f) + EPS); } }
    }
}

__device__ __forceinline__ void gmlp_phase(const Params& p, unsigned char* lds) {
    unsigned char* ws = p.ws;
    const bf16_t* PROJ = (const bf16_t*)(ws + WS_PROJ); const bf16_t* WSb = (const bf16_t*)(ws + WS_WS); bf16_t* MIX = (bf16_t*)(ws + WS_MIX);
    const int tid = threadIdx.x, lane = tid & 63, wave = tid >> 6, r32 = lane & 31, hi = lane >> 5;
    bf16_t* Vt = (bf16_t*)lds;
    float* vnl = (float*)(lds + 32768); float* bsl = vnl + 512;
    { vnl[tid] = p.vn[tid]; bsl[tid] = p.b_s[tid]; bsl[tid + 512] = p.b_s[tid + 512]; }
    __syncthreads();
    const int pp = tid >> 2, cp = tid & 3;
    const int c0 = 32 * (wave >> 2), p0 = 32 * (wave & 3), pos = p0 + r32;
    u32x4 va, vb2;
    constexpr int NU = NB * 16 * 8;
    const bool bal = gridDim.x == 256;
    const int ubase = bal ? ((int)blockIdx.x < 64 ? (int)blockIdx.x * 13 : 832 + ((int)blockIdx.x - 64) * 17) : (int)blockIdx.x;
    const int ustep = bal ? 1 : (int)gridDim.x;
    const int uend = bal ? ubase + ((int)blockIdx.x < 64 ? 13 : 17) : NU;
    { const int unit = ubase; if (unit < uend) { const int g = unit & 7, n = (unit >> 3) & 15, b = unit >> 7;
        const bf16_t* src0 = PROJ + ((size_t)b * SEQ + n * 128 + pp) * NPROJ + 1024 + 64 * g + 16 * cp; va = *(const u32x4*)src0; vb2 = *(const u32x4*)(src0 + 8); } }
    for (int unit = ubase; unit < uend; unit += ustep) {
        const int g = unit & 7, n = (unit >> 3) & 15, b = unit >> 7;
        const size_t r0 = (size_t)b * SEQ + n * 128;
        bf16x8 wf[8];
        const bf16_t* wrow = WSb + ((size_t)g * 128 + pos) * 128 + 8 * hi;
#pragma unroll
        for (int s = 0; s < 8; ++s) wf[s] = *(const bf16x8*)(wrow + 16 * s);
        const bf16_t* urow = PROJ + (r0 + pos) * NPROJ + 512 + 64 * g + c0 + 4 * hi;
        u32x2 uu[4];
#pragma unroll
        for (int q = 0; q < 4; ++q) uu[q] = *(const u32x2*)(urow + 8 * q);
        const float bias = bsl[g * 128 + pos];
        f32x4 vw[4];
#pragma unroll
        for (int i = 0; i < 4; ++i) vw[i] = *(const f32x4*)(vnl + 64 * g + 16 * cp + 4 * i);
        {
            float v[16];
            v[0] = bflo(va.x); v[1] = bfhi(va.x); v[2] = bflo(va.y); v[3] = bfhi(va.y); v[4] = bflo(va.z); v[5] = bfhi(va.z); v[6] = bflo(va.w); v[7] = bfhi(va.w);
            v[8] = bflo(vb2.x); v[9] = bfhi(vb2.x); v[10] = bflo(vb2.y); v[11] = bfhi(vb2.y); v[12] = bflo(vb2.z); v[13] = bfhi(vb2.z); v[14] = bflo(vb2.w); v[15] = bfhi(vb2.w);
            float ss = 0.f;
#pragma unroll
            for (int i = 0; i < 16; ++i) { v[i] = gelu_f(v[i]); ss += v[i] * v[i]; }
            ss += __shfl_xor(ss, 1); ss += __shfl_xor(ss, 2);
            const float rstd = rsqrtf(ss * (1.f / 64.f) + EPS);
#pragma unroll
            for (int i = 0; i < 16; ++i) { const int c = 16 * cp + i; const float y = v[i] * rstd * vw[i >> 2][i & 3]; Vt[c * 136 + pp] = (bf16_t)(pk2(y, 0.f) & 0xffffu); }
        }
        {
            const int un = unit + ustep; if (un < uend) { const int g2 = un & 7, n2 = (un >> 3) & 15, b2 = un >> 7;
                const bf16_t* src0 = PROJ + ((size_t)b2 * SEQ + n2 * 128 + pp) * NPROJ + 1024 + 64 * g2 + 16 * cp; va = *(const u32x4*)src0; vb2 = *(const u32x4*)(src0 + 8); } }
        __syncthreads();
        {
            f32x16 acc = {};
            const bf16_t* vrow = Vt + (c0 + r32) * 136 + 8 * hi;
#pragma unroll
            for (int s = 0; s < 8; ++s) { const bf16x8 av = *(const bf16x8*)(vrow + 16 * s);
                acc = __builtin_amdgcn_mfma_f32_32x32x16_bf16(av, wf[s], acc, 0, 0, 0); }
            bf16_t* orow = MIX + (r0 + pos) * DM + 512 + 64 * g + c0 + 4 * hi;
#pragma unroll
            for (int q = 0; q < 4; ++q) {
                const float o0 = gelu_f(bflo(uu[q].x)) * (acc[4 * q + 0] + bias), o1 = gelu_f(bfhi(uu[q].x)) * (acc[4 * q + 1] + bias);
                const float o2 = gelu_f(bflo(uu[q].y)) * (acc[4 * q + 2] + bias), o3 = gelu_f(bfhi(uu[q].y)) * (acc[4 * q + 3] + bias);
                u32x2 ov; ov.x = pk2(o0, o1); ov.y = pk2(o2, o3); *(u32x2*)(orow + 8 * q) = ov; }
        }
        __syncthreads();
    }
}

__device__ __forceinline__ void unpack8(float* v, const u32x4 a) { v[0] = bflo(a.x); v[1] = bfhi(a.x); v[2] = bflo(a.y); v[3] = bfhi(a.y); v[4] = bflo(a.z); v[5] = bfhi(a.z); v[6] = bflo(a.w); v[7] = bfhi(a.w); }
__device__ __forceinline__ u32x4 pack8(const float* v) { u32x4 o; o.x = pk2(v[0], v[1]); o.y = pk2(v[2], v[3]); o.z = pk2(v[4], v[5]); o.w = pk2(v[6], v[7]); return o; }
__device__ __forceinline__ float rope_inv(int f) { return f == 0 ? 1.0f : f == 1 ? 0.316227766f : f == 2 ? 0.1f : f == 3 ? 0.0316227766f : f == 4 ? 0.01f : f == 5 ? 0.00316227766f : f == 6 ? 0.001f : 0.000316227766f; }
__device__ __forceinline__ void kprep_phase(const Params& p) {
    unsigned char* ws = p.ws;
    const bf16_t* KN = (const bf16_t*)(ws + WS_KNOPE); const bf16_t* PROJ = (const bf16_t*)(ws + WS_PROJ); bf16_t* KF = (bf16_t*)(ws + WS_KF);
    const int tid = threadIdx.x, lane = tid & 63, wave = tid >> 6, h = lane >> 3, j = lane & 7;
    const int gw = blockIdx.x * 8 + wave, NGW = gridDim.x * 8;
    float wn[8], wp[8];
#pragma unroll
    for (int i = 0; i < 8; ++i) { wn[i] = p.kn[8 * j + i]; wp[i] = p.kn[64 + 8 * (j & 3) + i]; }
    u32x4 na = {}, ne = {};
    if (gw < MT) { na = *(const u32x4*)(KN + (size_t)gw * 512 + h * 64 + 8 * j); ne = *(const u32x4*)(PROJ + (size_t)gw * NPROJ + 384 + 8 * (j & 3)); }
    for (int row = gw; row < MT; row += NGW) {
        float a[8], e[8];
        unpack8(a, na); unpack8(e, ne);
        { const int rn = row + NGW; if (rn < MT) { na = *(const u32x4*)(KN + (size_t)rn * 512 + h * 64 + 8 * j); ne = *(const u32x4*)(PROJ + (size_t)rn * NPROJ + 384 + 8 * (j & 3)); } }
        float ss = 0.f;
#pragma unroll
        for (int i = 0; i < 8; ++i) ss += a[i] * a[i];
        if (j < 4) {
#pragma unroll
            for (int i = 0; i < 8; ++i) ss += e[i] * e[i];
        }
        ss += __shfl_xor(ss, 1); ss += __shfl_xor(ss, 2); ss += __shfl_xor(ss, 4);
        const float rs = rsqrtf(ss * (1.f / 96.f) + EPS);
#pragma unroll
        for (int i = 0; i < 8; ++i) { a[i] *= rs * wn[i]; e[i] *= rs * wp[i]; }
        bf16_t* ko = KF + (size_t)row * 768 + h * 96;
        *(u32x4*)(ko + 8 * j) = pack8(a);
        const bool lat = row < MX; const int pos = row & (SEQ - 1);
        const float fpos = (float)(((j >> 1) & 1) ? (pos & 63) : (pos >> 6));
#pragma unroll
        for (int f = 0; f < 8; ++f) {
            const float partner = __shfl_xor(e[f], 1);
            float sn = 0.f, cs = 1.f;
            if (lat) { const float rev = (fpos * rope_inv(f)) * 0.15915494309189535f; sn = __builtin_amdgcn_sinf(rev); cs = __builtin_amdgcn_cosf(rev); }
            e[f] = e[f] * cs + ((j & 1) ? partner : -partner) * sn;
        }
        if (j < 4) *(u32x4*)(ko + 64 + 8 * j) = pack8(e);
    }
}

constexpr int KSTR = 208, VSTR = 144, KBUF = 64 * KSTR, VBUF = 64 * VSTR;
__device__ __forceinline__ float max3f(float a, float b, float c) { float r; asm("v_max3_f32 %0, %1, %2, %3" : "=v"(r) : "v"(a), "v"(b), "v"(c)); return r; }
__device__ __forceinline__ float swapmax(float m) { auto rr = __builtin_amdgcn_permlane32_swap(__float_as_uint(m), __float_as_uint(m), false, false); return fmaxf(__uint_as_float(rr[0]), __uint_as_float(rr[1])); }
__device__ __forceinline__ float swapadd(float m) { auto rr = __builtin_amdgcn_permlane32_swap(__float_as_uint(m), __float_as_uint(m), false, false); return __uint_as_float(rr[0]) + __uint_as_float(rr[1]); }
#define ASB() __builtin_amdgcn_sched_barrier(0)
struct AttStage { u32x4 k0, k1, v; };
struct AttCtx {
    const bf16_t* KF; const bf16_t* VT; unsigned char* Ks; unsigned char* Vs;
    int tid, b, h, kkey0, kpart0, kkey1, kpart1, vd, vpart, vdst, koff, voff;
};
__device__ __forceinline__ void att_load(const AttCtx& c, int t, AttStage& s) {
    const size_t kr = (t < 32) ? (size_t)c.b * SEQ + t * 64 : (size_t)MX + (size_t)c.b * CTXL + (t - 32) * 64;
    s.k0 = *(const u32x4*)(c.KF + (kr + c.kkey0) * 768 + c.h * 96 + 8 * c.kpart0);
    if (c.tid < 256) s.k1 = *(const u32x4*)(c.KF + (kr + c.kkey1) * 768 + c.h * 96 + 8 * c.kpart1);
    s.v = *(const u32x4*)(c.VT + (size_t)(c.h * 64 + c.vd) * MT + kr + 8 * c.vpart);
}
__device__ __forceinline__ void att_store(const AttCtx& c, int kbuf, int vbuf, const AttStage& s) {
    *(u32x4*)(c.Ks + kbuf * KBUF + c.kkey0 * KSTR + c.kpart0 * 16) = s.k0;
    if (c.tid < 256) *(u32x4*)(c.Ks + kbuf * KBUF + c.kkey1 * KSTR + c.kpart1 * 16) = s.k1;
    *(u32x2*)(c.Vs + vbuf * VBUF + c.vdst) = (u32x2){s.v.x, s.v.y}; *(u32x2*)(c.Vs + vbuf * VBUF + c.vdst + 16) = (u32x2){s.v.z, s.v.w};
}
#define LDK(s_, A, C) do { A = *(const bf16x8*)(kb + (s_) * 32); C = *(const bf16x8*)(kb + 32 * KSTR + (s_) * 32); } while (0)
#define LDV(s_, A, C) do { A = *(const bf16x8*)(vb + (s_) * 32); C = *(const bf16x8*)(vb + 32 * VSTR + (s_) * 32); } while (0)
#define MMA(Acc, A, B) Acc = __builtin_amdgcn_mfma_f32_32x32x16_bf16(A, B, Acc, 0, 0, 0)
#define EXP4(V, i) do { V[i] = fexp2(V[i]); V[i + 1] = fexp2(V[i + 1]); V[i + 2] = fexp2(V[i + 2]); V[i + 3] = fexp2(V[i + 3]); } while (0)
__device__ __forceinline__ void att_iter(const AttCtx& c, int t, int& vcur, const bf16x8 (&qf)[6], f32x16& s0, f32x16& s1, f32x16& o0, f32x16& o1, float& mref, float& lsum, AttStage& L, const AttStage& S) {
    const bool more = t < 36;
    if (t + 2 < 36) att_load(c, t + 2, L);
    const unsigned char* kb = c.Ks + (t & 1) * KBUF + c.koff;
    const unsigned char* vb = c.Vs + vcur * VBUF + c.voff;
    f32x16 n0 = {}, n1 = {};
    u32x4 pw0, pw1, pw2, pw3;
    bf16x8 ka0, kc0, ka1, kc1, va0, vc0, va1, vc1;
    LDK(0, ka0, kc0);
    ASB();
    LDK(1, ka1, kc1);
    if (more) MMA(n0, ka0, qf[0]);
    float ma = max3f(s0[0], s0[1], s0[2]); ma = max3f(ma, s0[3], s0[4]); ma = max3f(ma, s0[5], s0[6]); ma = max3f(ma, s0[7], s0[8]);
    ASB();
    if (more) MMA(n1, kc0, qf[0]);
    ma = max3f(ma, s0[9], s0[10]); ma = max3f(ma, s0[11], s0[12]); ma = max3f(ma, s0[13], s0[14]); ma = fmaxf(ma, s0[15]);
    ASB();
    LDK(2, ka0, kc0);
    if (more) MMA(n0, ka1, qf[1]);
    float mb = max3f(s1[0], s1[1], s1[2]); mb = max3f(mb, s1[3], s1[4]); mb = max3f(mb, s1[5], s1[6]); mb = max3f(mb, s1[7], s1[8]);
    ASB();
    if (more) MMA(n1, kc1, qf[1]);
    mb = max3f(mb, s1[9], s1[10]); mb = max3f(mb, s1[11], s1[12]); mb = max3f(mb, s1[13], s1[14]); mb = max3f(mb, s1[15], ma);
    const float mx = swapmax(mb);
    if (__any(mx > mref + 8.f)) {
        const float mn = fmaxf(mref, mx), alpha = fexp2(mref - mn); mref = mn; lsum *= alpha;
#pragma unroll
        for (int r = 0; r < 16; ++r) { o0[r] *= alpha; o1[r] *= alpha; }
    }
    ASB();
    LDK(3, ka1, kc1);
    if (more) MMA(n0, ka0, qf[2]);
    s0 = s0 - mref; EXP4(s0, 0);
    ASB();
    if (more) MMA(n1, kc0, qf[2]);
    EXP4(s0, 4);
    pw0 = (u32x4){pk2(s0[0], s0[1]), pk2(s0[2], s0[3]), pk2(s0[4], s0[5]), pk2(s0[6], s0[7])};
    ASB();
    LDK(4, ka0, kc0);
    if (more) MMA(n0, ka1, qf[3]);
    EXP4(s0, 8);
    ASB();
    if (more) MMA(n1, kc1, qf[3]);
    EXP4(s0, 12);
    pw1 = (u32x4){pk2(s0[8], s0[9]), pk2(s0[10], s0[11]), pk2(s0[12], s0[13]), pk2(s0[14], s0[15])};
    ASB();
    LDK(5, ka1, kc1);
    if (more) MMA(n0, ka0, qf[4]);
    s1 = s1 - mref; EXP4(s1, 0);
    ASB();
    if (more) MMA(n1, kc0, qf[4]);
    EXP4(s1, 4);
    pw2 = (u32x4){pk2(s1[0], s1[1]), pk2(s1[2], s1[3]), pk2(s1[4], s1[5]), pk2(s1[6], s1[7])};
    ASB();
    LDV(0, va0, vc0);
    if (more) MMA(n0, ka1, qf[5]);
    EXP4(s1, 8);
    ASB();
    if (more) MMA(n1, kc1, qf[5]);
    EXP4(s1, 12);
    pw3 = (u32x4){pk2(s1[8], s1[9]), pk2(s1[10], s1[11]), pk2(s1[12], s1[13]), pk2(s1[14], s1[15])};
    ASB();
    LDV(1, va1, vc1);
    MMA(o0, va0, __builtin_bit_cast(bf16x8, pw0)); MMA(o1, vc0, __builtin_bit_cast(bf16x8, pw0));
    { const f32x16 sv = s0 + s1; lsum += ((sv[0] + sv[1]) + (sv[2] + sv[3])) + ((sv[4] + sv[5]) + (sv[6] + sv[7])) + ((sv[8] + sv[9]) + (sv[10] + sv[11])) + ((sv[12] + sv[13]) + (sv[14] + sv[15])); }
    ASB();
    LDV(2, va0, vc0);
    MMA(o0, va1, __builtin_bit_cast(bf16x8, pw1)); MMA(o1, vc1, __builtin_bit_cast(bf16x8, pw1));
    ASB();
    LDV(3, va1, vc1);
    MMA(o0, va0, __builtin_bit_cast(bf16x8, pw2)); MMA(o1, vc0, __builtin_bit_cast(bf16x8, pw2));
    ASB();
    MMA(o0, va1, __builtin_bit_cast(bf16x8, pw3)); MMA(o1, vc1, __builtin_bit_cast(bf16x8, pw3));
    ASB();
    if (t + 1 < 36) { const int vn = (vcur == 0) ? 2 : vcur - 1; att_store(c, (t + 1) & 1, vn, S); }
    asm volatile("s_waitcnt lgkmcnt(0)" ::: "memory"); __builtin_amdgcn_s_barrier(); asm volatile("" ::: "memory");
    s0 = n0; s1 = n1; vcur = (vcur == 2) ? 0 : vcur + 1;
}
__device__ __forceinline__ void attn_phase(const Params& p, unsigned char* lds) {
    unsigned char* ws = p.ws;
    const bf16_t* Q = (const bf16_t*)(ws + WS_QRAW); bf16_t* MIX = (bf16_t*)(ws + WS_MIX);
    const int tid = threadIdx.x, lane = tid & 63, wave = tid >> 6, r32 = lane & 31, hi = lane >> 5;
    AttCtx c; c.KF = (const bf16_t*)(ws + WS_KF); c.VT = (const bf16_t*)(ws + WS_VT); c.Ks = lds; c.Vs = lds + 2 * KBUF; c.tid = tid;
    const int bx = blockIdx.x, G = gridDim.x;
    const int vcu = (G % 8 == 0) ? (bx % 8) * (G / 8) + bx / 8 : bx;
    c.kkey0 = tid / 12; c.kpart0 = tid % 12; c.kkey1 = (tid + 512) / 12; c.kpart1 = (tid + 512) % 12;
    c.vd = tid >> 3; c.vpart = tid & 7;
    c.vdst = c.vd * VSTR + (c.vpart >> 1) * 32 + (c.vpart & 1) * 8;
    c.koff = r32 * KSTR + hi * 16; c.voff = r32 * VSTR + hi * 16;
    float* qnl = (float*)(lds + 65536);
    if (tid < 96) qnl[tid] = p.qn[tid];
    __syncthreads();
    for (int unit = vcu; unit < NB * NH * 8; unit += G) {
        const int qb = unit & 7, h = (unit >> 3) & 7, b = unit >> 6;
        c.b = b; c.h = h;
        const size_t qrow = (size_t)b * SEQ + qb * 256 + wave * 32 + r32;
        bf16x8 qf[6];
        {
            float qv[6][8]; float ss = 0.f;
#pragma unroll
            for (int s = 0; s < 6; ++s) { unpack8(qv[s], *(const u32x4*)(Q + qrow * 768 + h * 96 + 16 * s + 8 * hi));
#pragma unroll
                for (int i = 0; i < 8; ++i) ss += qv[s][i] * qv[s][i]; }
            ss += __shfl_xor(ss, 32);
            const float rs = rsqrtf(ss * (1.f / 96.f) + EPS) * QSCALE;
#pragma unroll
            for (int s = 0; s < 6; ++s)
#pragma unroll
                for (int i = 0; i < 8; ++i) qv[s][i] *= rs * qnl[16 * s + 8 * hi + i];
            const int pos = (int)(qrow & (SEQ - 1));
#pragma unroll
            for (int s = 4; s < 6; ++s) { const float fpos = (float)(s == 4 ? (pos >> 6) : (pos & 63));
#pragma unroll
                for (int f = 0; f < 8; ++f) { const float partner = __shfl_xor(qv[s][f], 32);
                    const float rev = (fpos * rope_inv(f)) * 0.15915494309189535f; const float sn = __builtin_amdgcn_sinf(rev), cs = __builtin_amdgcn_cosf(rev);
                    qv[s][f] = qv[s][f] * cs + (hi ? partner : -partner) * sn; } }
#pragma unroll
            for (int s = 0; s < 6; ++s) qf[s] = __builtin_bit_cast(bf16x8, pack8(qv[s]));
        }
        float mref = -1e30f, lsum = 0.f; f32x16 o0 = {}, o1 = {};
        AttStage A, B; A.k1 = (u32x4){0u, 0u, 0u, 0u}; B.k1 = A.k1;
        att_load(c, 0, A); att_store(c, 0, 0, A);
        asm volatile("s_waitcnt lgkmcnt(0)" ::: "memory"); __builtin_amdgcn_s_barrier(); asm volatile("" ::: "memory");
        att_load(c, 1, A); att_load(c, 2, B);
        f32x16 s0 = {}, s1 = {};
        { const unsigned char* kb = c.Ks + c.koff; bf16x8 ka, kc;
#pragma unroll
          for (int s = 0; s < 6; ++s) { LDK(s, ka, kc); MMA(s0, ka, qf[s]); MMA(s1, kc, qf[s]); } }
        att_store(c, 1, 1, A);
        asm volatile("s_waitcnt lgkmcnt(0)" ::: "memory"); __builtin_amdgcn_s_barrier(); asm volatile("" ::: "memory");
        int vcur = 0;
        for (int t = 1; t <= 35; t += 2) {
            att_iter(c, t, vcur, qf, s0, s1, o0, o1, mref, lsum, A, B);
            att_iter(c, t + 1, vcur, qf, s0, s1, o0, o1, mref, lsum, B, A);
        }
        lsum = swapadd(lsum);
        const float il = 1.f / lsum;
        bf16_t* orow = MIX + qrow * DM + h * 64 + 4 * hi;
#pragma unroll
        for (int q = 0; q < 4; ++q) {
            u32x2 a; a.x = pk2(o0[4 * q] * il, o0[4 * q + 1] * il); a.y = pk2(o0[4 * q + 2] * il, o0[4 * q + 3] * il); *(u32x2*)(orow + 8 * q) = a;
            u32x2 cc; cc.x = pk2(o1[4 * q] * il, o1[4 * q + 1] * il); cc.y = pk2(o1[4 * q + 2] * il, o1[4 * q + 3] * il); *(u32x2*)(orow + 32 + 8 * q) = cc;
        }
    }
}
#undef LDK
#undef LDV
#undef MMA
#undef EXP4
#undef ASB

constexpr int NPHASE = 12;
__global__ void __launch_bounds__(512, 2) mega_fwd(Params p) {
    extern __shared__ __attribute__((aligned(16))) unsigned char lds[];
    LAS unsigned char* ldsl = (LAS unsigned char*)lds;
    unsigned char* ws = p.ws;
    const int G = gridDim.x, bx = blockIdx.x;
    float* MOD = (float*)(ws + WS_MOD);
    bf16_t* H = (bf16_t*)(ws + WS_H); bf16_t* ACT = (bf16_t*)(ws + WS_ACT); bf16_t* PROJ = (bf16_t*)(ws + WS_PROJ);
    float* X1C = (float*)(ws + WS_X1C); float* RSQ = (float*)(ws + WS_RSQ); float* RSKV = (float*)(ws + WS_RSKV);
    const int lo = p.ph_lo, hi = p.ph_hi;
#define IN(k) (lo <= (k) && (k) < hi)
#define SEAM(k) do { if (IN(k) && IN((k) + 1)) { cg::this_grid().sync(); } } while (0)
    using pg8::Gemm; using pg8::StaticOrder;

    if (IN(0)) { phase0(p, (float*)lds); } SEAM(0);
    if (IN(1)) { norm_mod_phase(p.x, p.ctx, MT, p.norm1, MOD, 0, H); } SEAM(1);
    if (IN(2)) { Gemm g{H, (const bf16_t*)(ws + WS_W13A), MT, 2 * DFF, DM, DM, DM}; StaticOrder S; S.init(MT, 2 * DFF, G, bx);
        pg8::EpiSwigluT<false> E{ACT, DFF, nullptr, nullptr}; pg8::gemm_phase(ldsl, g, S, E);
        { const int fi = S.nwg % G, np = fi ? G - fi : G, wi = fi ? bx - fi : bx; const int wave = threadIdx.x >> 6, lane = threadIdx.x & 63;
          if (wi >= 0) { tr_set(p, 1, wi * 8 + wave, np * 8, (float*)lds + wave * 4096, lane); } __syncthreads(); } } SEAM(2);
    if (IN(3)) { Gemm g{ACT, (const bf16_t*)(ws + WS_W2A), MT, DM, DFF, DFF, DFF}; StaticOrder S; S.init(MT, DM, G, bx);
        pg8::EpiRes<MX / 256, 1, true> E{p.x, p.ctx, p.out, X1C, MOD + 2 * DM, p.norm2, MOD + 4 * DM, H, (float*)(ws + WS_SS2)}; pg8::gemm_phase<pg8::EpiRes<MX / 256, 1, true>, StaticOrder, true>(ldsl, g, S, E);
        { const int fi = S.nwg % G, np = fi ? G - fi : G, wi = fi ? bx - fi : bx; const int tid = threadIdx.x, wave = tid >> 6, lane = tid & 63;
          if (wi >= 0) {
            for (int it = wi; it < 111; it += np) {
                if (it < 23) rowmat_item<false>(MOD + 3 * DM, NMOD, MOD + (size_t)32 * NMOD + 3 * DM, p.w_in, 1440, it, nullptr, (float*)(ws + WS_SWIN), NPROJ, 1, (float*)lds, tid);
                else if (it < 67) rowmat_item<false>(MOD + 6 * DM, NMOD, MOD + (size_t)32 * NMOD + 6 * DM, p.f2w1, DFF, it - 23, nullptr, (float*)(ws + WS_SW13), 2 * DFF, 2, (float*)lds, tid);
                else rowmat_item<false>(MOD + 6 * DM, NMOD, MOD + (size_t)32 * NMOD + 6 * DM, p.f2w3, DFF, it - 67, nullptr, (float*)(ws + WS_SW13), 2 * DFF, 3, (float*)lds, tid);
            }
            tr_set(p, 2, wi * 8 + wave, np * 8, (float*)lds + wave * 4096, lane); } __syncthreads(); } } SEAM(3);
    if (IN(4)) {
        { Gemm g{H, (const bf16_t*)(ws + WS_WIN), MX, NPROJ, DM, DM, DM}; StaticOrder S; S.init(MX, NPROJ, G, bx);
          pg8::EpiBf16S E{PROJ, NPROJ, nullptr, nullptr, (const float*)(ws + WS_SS2), (const float*)(ws + WS_SWIN), NPROJ, -1}; pg8::gemm_phase(ldsl, g, S, E); }
        { Gemm g{H + (size_t)MX * DM, (const bf16_t*)(ws + WS_WIN) + (size_t)256 * DM, MC, 256, DM, DM, DM}; StaticOrder S; S.init(MC, 256, G, bx);
          pg8::EpiBf16S E{PROJ + (size_t)MX * NPROJ + 256, NPROJ, nullptr, nullptr, (const float*)(ws + WS_SS2) + MX, (const float*)(ws + WS_SWIN) + 256, NPROJ, 32}; pg8::gemm_phase(ldsl, g, S, E); }
    } SEAM(4);
    if (IN(5)) { rstd_phase(PROJ, RSQ, RSKV); } SEAM(5);
    if (IN(6)) {
        { Gemm g{PROJ, (const bf16_t*)(ws + WS_WUQ), MX, 768, 256, NPROJ, 256}; StaticOrder S; S.init(MX, 768, G, bx);
          pg8::EpiBf16S E{(bf16_t*)(ws + WS_QRAW), 768, RSQ, nullptr, nullptr, nullptr, 0, 0}; pg8::gemm_phase(ldsl, g, S, E); }
        { int k128 = 128; asm volatile("" : "+s"(k128));     Gemm g{PROJ + 256, (const bf16_t*)(ws + WS_WK), MT, 512, k128, NPROJ, 256}; StaticOrder S; S.init(MT, 512, G, bx);
          pg8::EpiBf16S E{(bf16_t*)(ws + WS_KNOPE), 512, RSKV, nullptr, nullptr, nullptr, 0, 0}; pg8::gemm_phase(ldsl, g, S, E); }
        { int k128 = 128; asm volatile("" : "+s"(k128)); Gemm g{(const bf16_t*)(ws + WS_WV), PROJ + 256, 512, MT, k128, 256, NPROJ}; StaticOrder S; S.init(512, MT, G, bx);
          pg8::EpiBf16S E{(bf16_t*)(ws + WS_VT), MT, nullptr, RSKV, nullptr, nullptr, 0, 0}; pg8::gemm_phase(ldsl, g, S, E); }
        gmlp_phase(p, lds);
    } SEAM(6);
    if (IN(7)) { kprep_phase(p); } SEAM(7);
    if (IN(8)) { attn_phase(p, lds); } SEAM(8);
    if (IN(9)) { Gemm g{(const bf16_t*)(ws + WS_MIX), (const bf16_t*)(ws + WS_WOUT), MX, DM, DM, DM, DM}; StaticOrder S; S.init(MX, DM, G, bx);
        pg8::EpiRes<(1 << 30), 2, true> E{p.out, nullptr, p.out, nullptr, MOD + 5 * DM, p.norm3, MOD + 7 * DM, (bf16_t*)(ws + WS_H3), (float*)(ws + WS_SS3)}; pg8::gemm_phase(ldsl, g, S, E); } SEAM(9);
    if (IN(10)) { Gemm g{(const bf16_t*)(ws + WS_H3), (const bf16_t*)(ws + WS_W13B), MX, 2 * DFF, DM, DM, DM}; StaticOrder S; S.init(MX, 2 * DFF, G, bx);
        pg8::EpiSwigluT<true> E{ACT, DFF, (const float*)(ws + WS_SS3), (const float*)(ws + WS_SW13)}; pg8::gemm_phase(ldsl, g, S, E); } SEAM(10);
    if (IN(11)) { Gemm g{ACT, (const bf16_t*)(ws + WS_W2B), MX, DM, DFF, DFF, DFF}; StaticOrder S; S.init(MX, DM, G, bx);
        pg8::EpiRes<(1 << 30), 1, false> E{p.out, nullptr, p.out, nullptr, MOD + 8 * DM, nullptr, nullptr, nullptr, nullptr}; pg8::gemm_phase<pg8::EpiRes<(1 << 30), 1, false>, StaticOrder, true>(ldsl, g, S, E); }
#undef IN
#undef SEAM
}

extern "C" void kernel_launch(void* const* d_in, const int* in_sizes, int n_in, void* d_out, int out_size, void* d_ws, size_t ws_size, hipStream_t stream) {
    static int grid = 0;
    if (grid == 0) {
        if (n_in != 26 || in_sizes[0] != MX * DM || out_size != MX * DM || ws_size < WS_END) { fprintf(stderr, "kernel_launch: unexpected shapes (n_in %d, in0 %d, out %d, ws %zu)\n", n_in, n_in > 0 ? in_sizes[0] : -1, out_size, ws_size); grid = -1; return; }
        int dev = 0, cus = 0, per_cu = 0;
        if (hipGetDevice(&dev) != hipSuccess || hipDeviceGetAttribute(&cus, hipDeviceAttributeMultiprocessorCount, dev) != hipSuccess) { grid = -1; return; }
        if (hipFuncSetAttribute((const void*)mega_fwd, hipFuncAttributeMaxDynamicSharedMemorySize, LDS_BYTES) != hipSuccess) { fprintf(stderr, "kernel_launch: hipFuncSetAttribute failed\n"); grid = -1; return; }
        if (hipOccupancyMaxActiveBlocksPerMultiprocessor(&per_cu, (const void*)mega_fwd, 512, LDS_BYTES) != hipSuccess || per_cu < 1) { fprintf(stderr, "kernel_launch: occupancy query says %d\n", per_cu); per_cu = 1; }
        (void)hipGetLastError();
        grid = cus;
    }
    if (grid < 0) return;
    Params p{};
    const float** pp = (const float**)&p;
    for (int i = 0; i < 26; ++i) pp[i] = (const float*)d_in[i];
    p.out = (float*)d_out; p.ws = (unsigned char*)d_ws;
#if MK_ONE_LAUNCH
    p.ph_lo = 0; p.ph_hi = NPHASE;
    void* args[] = {&p};
    hipError_t e = hipLaunchCooperativeKernel((const void*)mega_fwd, dim3(grid), dim3(512), args, LDS_BYTES, stream);
    if (e != hipSuccess) fprintf(stderr, "cooperative launch failed: %s (grid %d)\n", hipGetErrorString(e), grid);
#else
    for (int ph = 0; ph < NPHASE; ++ph) {
        p.ph_lo = ph; p.ph_hi = ph + 1;
        hipLaunchKernelGGL(mega_fwd, dim3(grid), dim3(512), LDS_BYTES, stream, p);
    }
#endif
}
```

```cpp
#include <hip/hip_runtime.h>
#include <hip/hip_cooperative_groups.h>
#include <cstdio>
#include <cstdint>
namespace cg = cooperative_groups;

#ifndef MK_ONE_LAUNCH
#define MK_ONE_LAUNCH 1
#endif

#define LAS __attribute__((address_space(3)))
typedef unsigned short bf16_t;
typedef short bf16x8 __attribute__((ext_vector_type(8)));
typedef float f32x4 __attribute__((ext_vector_type(4)));
typedef float f32x16 __attribute__((ext_vector_type(16)));
typedef unsigned u32x4 __attribute__((ext_vector_type(4)));
typedef unsigned u32x2 __attribute__((ext_vector_type(2)));

constexpr int DM = 1024, NB = 32, SEQ = 2048, CTXL = 256, DFF = 2816;
constexpr int MX = NB * SEQ;
constexpr int MC = NB * CTXL;
constexpr int MT = MX + MC;
constexpr int NMOD = 9 * DM;
constexpr int NPROJ = 1536;
constexpr int NH = 8, DQK = 96, DV = 64;
constexpr float EPS = 1e-6f;
constexpr float QSCALE = 0.10206207261596577f * 1.4426950408889634f;

constexpr size_t MiB = 1u << 20;
constexpr size_t WS_MOD = 1 * MiB, WS_RSQ = 3 * MiB, WS_RSKV = 3 * MiB + 512 * 1024;
constexpr size_t WS_W13A = 4 * MiB, WS_W2A = 15 * MiB, WS_W13B = 21 * MiB, WS_W2B = 32 * MiB, WS_WIN = 38 * MiB;
constexpr size_t WS_WUQ = 41 * MiB, WS_WK = 41 * MiB + 512 * 1024, WS_WV = 41 * MiB + 768 * 1024, WS_WOUT = 42 * MiB, WS_WS = 44 * MiB;
constexpr size_t WS_X1C = 46 * MiB, WS_H = 80 * MiB, WS_ACT = 224 * MiB;
constexpr size_t WS_PROJ = 224 * MiB, WS_QRAW = 440 * MiB, WS_KNOPE = 536 * MiB;
constexpr size_t WS_KF = 620 * MiB, WS_VT = 728 * MiB, WS_END = 800 * MiB;
constexpr size_t WS_MIX = WS_H;
constexpr size_t WS_SWIN = 44 * MiB + 512 * 1024, WS_SW13 = 45 * MiB, WS_SS2 = 78 * MiB, WS_SS3 = 78 * MiB + 512 * 1024;
constexpr size_t WS_H3 = WS_KF;

constexpr int LDS_BYTES = 147456;

__device__ __forceinline__ unsigned pk2(float lo, float hi) {
    typedef float f2 __attribute__((ext_vector_type(2))); typedef __bf16 b2 __attribute__((ext_vector_type(2)));
    f2 v = {lo, hi}; b2 b = __builtin_convertvector(v, b2); return __builtin_bit_cast(unsigned, b);
}
__device__ __forceinline__ float bflo(unsigned w) { return __uint_as_float(w << 16); }
__device__ __forceinline__ float bfhi(unsigned w) { return __uint_as_float(w & 0xffff0000u); }
__device__ __forceinline__ float fexp2(float x) { return __builtin_amdgcn_exp2f(x); }
__device__ __forceinline__ float frcp(float x) { return __builtin_amdgcn_rcpf(x); }
__device__ __forceinline__ float silu_f(float a) { return a * frcp(1.f + fexp2(-1.4426950408889634f * a)); }
__device__ __forceinline__ float gelu_f(float x) { const float y = 0.7978845608028654f * (x + 0.044715f * x * x * x); return x * frcp(1.f + fexp2(-2.8853900817779268f * y)); }
__device__ __forceinline__ float wave_sum(float v) {
#pragma unroll
    for (int o = 1; o < 64; o <<= 1) v += __shfl_xor(v, o);
    return v;
}
#define LDS_WAIT() asm volatile("s_waitcnt lgkmcnt(0)" ::: "memory")

namespace pg8 {
constexpr int BM = 256, BK = 64, HALF = 128, HTB = HALF * BK * 2, STAGE_BYTES = 8 * HTB, NXCD = 8, WGM = 4;
__host__ __device__ __forceinline__ int lds_byte(int r, int c) { const int st = (r >> 4) * 2 + (c >> 5), rr = r & 15, cc = c & 31, ob = rr * 64 + cc * 2; return st * 1024 + (ob ^ (((ob >> 9) & 1) << 5)); }
__host__ __device__ __forceinline__ void stage_rc(int b, int& R, int& C) { const int st = b / 1024, sb = b % 1024, swz = sb ^ (((sb >> 9) & 1) << 5); R = (st >> 1) * 16 + swz / 64; C = (st & 1) * 32 + (swz % 64) / 2; }
__host__ __device__ __forceinline__ int perm32(int rho) { const int n = rho >> 4, i = rho & 15; return 8 * (i >> 2) + 4 * n + (i & 3); }

struct Unit { int pm, pn; };
struct Gemm { const bf16_t* A; const bf16_t* Bt; int M, N, K, lda, ldb; };

struct StaticOrder {
    int nM, nN, nwg, G, c;
    __device__ void init(int M, int N, int G_, int c_) { nM = M / BM; nN = N / BM; nwg = nM * nN; G = G_; c = c_; }
    __device__ bool next(int i, Unit& u) const {
        const long L = (long)i * G + c; if (L >= nwg) return false;
        int wgid = (int)L; { const int q = nwg / NXCD, r = nwg % NXCD, xcd = wgid % NXCD, off = wgid / NXCD; wgid = (xcd < r ? xcd * (q + 1) : r * (q + 1) + (xcd - r) * q) + off; }
        const int nig = WGM * nN, gid = wgid / nig, fm = gid * WGM, gsz = (nM - fm) < WGM ? (nM - fm) : WGM;
        u.pm = fm + ((wgid % nig) % gsz); u.pn = (wgid % nig) / gsz; return true;
    }
};

template <bool NORM, bool TILED = true> struct EpiSwigluT {
    static constexpr bool PERM = true;
    bf16_t* O; int ldc; const float* SSn; const float* cb;
    __device__ __forceinline__ void operator()(const f32x4 (&acc)[2][2][4][2], const Unit& u, int wr, int wc, int fr, int fq) const {
        const int row0 = u.pm * BM + wr * 64 + fr, col0 = u.pn * HALF + wc * 32 + 8 * fq;
        f32x4 cv[2][2];
        if (NORM) {
            const float* cbp = cb + (size_t)(u.pm >> 3) * (2 * DFF) + u.pn * BM + wc * 32 + 8 * fq;
#pragma unroll
            for (int bj = 0; bj < 2; ++bj)
#pragma unroll
                for (int n = 0; n < 2; ++n) cv[bj][n] = *(const f32x4*)(cbp + bj * HALF + 4 * n);
        }
#pragma unroll
        for (int ai = 0; ai < 2; ++ai)
#pragma unroll
            for (int m = 0; m < 4; ++m) {
                const int row = row0 + ai * HALF + m * 16;
                bf16_t* rowp = TILED ? O + ((size_t)((row >> 4) * (ldc >> 5) + (col0 >> 5)) * 512 + (row & 15) * 32 + (col0 & 31)) : O + (size_t)row * ldc + col0;
                f32x4 a0 = acc[ai][0][m][0], a1 = acc[ai][0][m][1], b0 = acc[ai][1][m][0], b1 = acc[ai][1][m][1];
                if (NORM) { const float r = rsqrtf(SSn[row] * (1.f / DM) + EPS); a0 = a0 * r + cv[0][0]; a1 = a1 * r + cv[0][1]; b0 = b0 * r + cv[1][0]; b1 = b1 * r + cv[1][1]; }
                u32x4 w;
                w.x = pk2(silu_f(a0[0]) * b0[0], silu_f(a0[1]) * b0[1]); w.y = pk2(silu_f(a0[2]) * b0[2], silu_f(a0[3]) * b0[3]);
                w.z = pk2(silu_f(a1[0]) * b1[0], silu_f(a1[1]) * b1[1]); w.w = pk2(silu_f(a1[2]) * b1[2], silu_f(a1[3]) * b1[3]);
                *(u32x4*)rowp = w;
            }
    }
};
template <int ctx_tile0, int COEF2, bool NORM> struct EpiRes {
    static constexpr bool PERM = true;
    const float* bx; const float* bc; float* ox; float* oc; const float* gate;
    const float* nw; const float* nscale; bf16_t* Hn; float* SS;
    __device__ __forceinline__ void operator()(const f32x4 (&acc)[2][2][4][2], const Unit& u, int wr, int wc, int fr, int fq) const {
        asm volatile("" : "+v"(fr), "+v"(fq));
        const bool isc = u.pm >= ctx_tile0;
        const int mrow = isc ? 32 : (u.pm >> 3);
        const int prow = isc ? (u.pm - ctx_tile0) : u.pm;
        const float* base = isc ? bc : bx; float* out = isc ? oc : ox;
        const int col0 = u.pn * BM + wc * 32 + 8 * fq;
        f32x4 gv[2][2], G[2][2]; float ssv[2][4];
#pragma unroll
        for (int bj = 0; bj < 2; ++bj)
#pragma unroll
            for (int n = 0; n < 2; ++n) { const int c = col0 + bj * HALF + 4 * n; gv[bj][n] = *(const f32x4*)(gate + (size_t)mrow * NMOD + c) * (0.5f * COEF2);
                if (NORM) G[bj][n] = *(const f32x4*)(nw + c) * (*(const f32x4*)(nscale + (size_t)mrow * NMOD + c) + 1.f); }
#pragma unroll
        for (int ai = 0; ai < 2; ++ai)
#pragma unroll
            for (int m = 0; m < 4; ++m) {
                const int rl = ai * HALF + wr * 64 + m * 16 + fr;
                const size_t off = (size_t)(prow * BM + rl) * DM + col0;
                const size_t hrow = (size_t)u.pm * BM + rl;
                float ss = 0.f;
#pragma unroll
                for (int bj = 0; bj < 2; ++bj) {
                    const f32x4 o0 = *(const f32x4*)(base + off + bj * HALF) + gv[bj][0] * acc[ai][bj][m][0];
                    const f32x4 o1 = *(const f32x4*)(base + off + bj * HALF + 4) + gv[bj][1] * acc[ai][bj][m][1];
                    if (!isc) { *(f32x4*)(out + off + bj * HALF) = o0; *(f32x4*)(out + off + bj * HALF + 4) = o1; }
                    if (NORM) {
                        ss += (o0[0] * o0[0] + o0[1] * o0[1]) + (o0[2] * o0[2] + o0[3] * o0[3]) + (o1[0] * o1[0] + o1[1] * o1[1]) + (o1[2] * o1[2] + o1[3] * o1[3]);
                        const f32x4 h0 = o0 * G[bj][0], h1 = o1 * G[bj][1];
                        u32x4 w; w.x = pk2(h0[0], h0[1]); w.y = pk2(h0[2], h0[3]); w.z = pk2(h1[0], h1[1]); w.w = pk2(h1[2], h1[3]);
                        *(u32x4*)(Hn + hrow * DM + col0 + bj * HALF) = w;
                    }
                }
                if (NORM) { ss += __shfl_xor(ss, 16); ss += __shfl_xor(ss, 32); ssv[ai][m] = ss; }
            }
        if (NORM) {
            asm volatile("" ::: "memory");
#pragma unroll
            for (int ai = 0; ai < 2; ++ai)
#pragma unroll
                for (int m = 0; m < 4; ++m)
                    if (fq == 0) __hip_atomic_fetch_add(SS + (size_t)u.pm * BM + ai * HALF + wr * 64 + m * 16 + fr, ssv[ai][m], __ATOMIC_RELAXED, __HIP_MEMORY_SCOPE_AGENT);
        }
    }
};
struct EpiBf16S {
    static constexpr bool PERM = true;
    bf16_t* O; int ldc; const float* SSr; float inv_r; const float* SSc; float inv_c; const float* cb; int ldcb; int mrow_fixed; float* st0; float* st1; int pn_off;
    __device__ __forceinline__ void operator()(const f32x4 (&acc)[2][2][4][2], const Unit& u, int wr, int wc, int fr, int fq) const {
        const int row0 = u.pm * BM + wr * 64 + fr, col0 = u.pn * BM + wc * 32 + 8 * fq;
        const int mrow = mrow_fixed >= 0 ? mrow_fixed : (u.pm >> 3);
        const int gp = u.pn + pn_off;
        float* sp = (gp == 0) ? st0 : ((gp == 1) ? st1 : nullptr);
        f32x4 cv[2][2], bv[2][2];
#pragma unroll
        for (int bj = 0; bj < 2; ++bj)
#pragma unroll
            for (int n = 0; n < 2; ++n) {
                if (SSc) { const f32x4 s = *(const f32x4*)(SSc + col0 + bj * HALF + 4 * n); cv[bj][n] = (f32x4){rsqrtf(s[0] * inv_c + EPS), rsqrtf(s[1] * inv_c + EPS), rsqrtf(s[2] * inv_c + EPS), rsqrtf(s[3] * inv_c + EPS)}; }
                else cv[bj][n] = (f32x4){1.f, 1.f, 1.f, 1.f};
                bv[bj][n] = cb ? *(const f32x4*)(cb + (size_t)mrow * ldcb + col0 + bj * HALF + 4 * n) : (f32x4){0.f, 0.f, 0.f, 0.f}; }
#pragma unroll
        for (int ai = 0; ai < 2; ++ai)
#pragma unroll
            for (int m = 0; m < 4; ++m) {
                const int row = row0 + ai * HALF + m * 16;
                const float r = SSr ? rsqrtf(SSr[row] * inv_r + EPS) : 1.f;
                bf16_t* rowp = O + (size_t)row * ldc + col0;
                float ss = 0.f;
#pragma unroll
                for (int bj = 0; bj < 2; ++bj) {
                    const f32x4 v0 = acc[ai][bj][m][0] * cv[bj][0] * r + bv[bj][0], v1 = acc[ai][bj][m][1] * cv[bj][1] * r + bv[bj][1];
                    u32x4 w; w.x = pk2(v0[0], v0[1]); w.y = pk2(v0[2], v0[3]); w.z = pk2(v1[0], v1[1]); w.w = pk2(v1[2], v1[3]);
                    *(u32x4*)(rowp + bj * HALF) = w;
                    if (st0 && (bj == 0 || gp == 0)) ss += (v0[0] * v0[0] + v0[1] * v0[1]) + (v0[2] * v0[2] + v0[3] * v0[3]) + (v1[0] * v1[0] + v1[1] * v1[1]) + (v1[2] * v1[2] + v1[3] * v1[3]);
                }
                if (sp) { ss += __shfl_xor(ss, 16); ss += __shfl_xor(ss, 32);
                    if (fq == 0) __hip_atomic_fetch_add(sp + row, ss, __ATOMIC_RELAXED, __HIP_MEMORY_SCOPE_AGENT); }
            }
    }
};

template <class Epi, class Sched, bool TILEDA = false>
__device__ __forceinline__ void gemm_phase(LAS unsigned char* lds, const Gemm g, const Sched& S, const Epi& E) {
    const int tid = threadIdx.x, wid = __builtin_amdgcn_readfirstlane(tid >> 6), lane = tid & 63, wr = wid >> 2, wc = wid & 3, fr = lane & 15, fq = lane >> 4;
    const int K = g.K, nt = K / BK;
    unsigned voffA[2], voffB[2];
#pragma unroll
    for (int i = 0; i < 2; ++i) { int R, C; stage_rc(tid * 16 + i * 8192, R, C); const int Rb = Epi::PERM ? ((R & ~31) + perm32(R & 31)) : R;
        voffA[i] = TILEDA ? (unsigned)(((R >> 4) * (g.lda >> 5) + (C >> 5)) * 1024 + (R & 15) * 64 + (C & 31) * 2) : (unsigned)(R * g.lda + C) * 2u;
        voffB[i] = (unsigned)(Rb * g.ldb + C) * 2u; }
    const size_t kstep = (size_t)(BK * 2), kstepA = TILEDA ? (size_t)2048 : kstep;
    const size_t hA = TILEDA ? (size_t)(HALF / 16) * (g.lda >> 5) * 1024 : (size_t)HALF * g.lda * 2, hB = (size_t)HALF * g.ldb * 2;
    const size_t tA = 2 * hA, tB = 2 * hB;
    const unsigned ldsw = (unsigned)wid * 1024u;
    const int aoff = lds_byte(wr * 64 + fr, fq * 8), boff = lds_byte(wc * 32 + fr, fq * 8);
#define PG8_SA(b, h) (((b) * 2 + (h)) * HTB)
#define PG8_SB(b, h) ((4 + (b) * 2 + (h)) * HTB)
#define PG8_STAGE(bufoff, gbase, voff) do { _Pragma("unroll") for (int _i = 0; _i < 2; ++_i) \
        __builtin_amdgcn_global_load_lds((const unsigned*)((const char*)(gbase) + (voff)[_i]), (LAS unsigned*)(lds + (bufoff) + ldsw + _i * 8192), 16, 0, 0); } while (0)
#define PG8_LDA(dst, b, h) do { _Pragma("unroll") for (int m = 0; m < 4; ++m) _Pragma("unroll") for (int k = 0; k < 2; ++k) dst[m][k] = *(const LAS bf16x8*)(lds + PG8_SA(b, h) + aoff + m * 2048 + k * 1024); } while (0)
#define PG8_LDB(dst, b, h) do { _Pragma("unroll") for (int n = 0; n < 2; ++n) _Pragma("unroll") for (int k = 0; k < 2; ++k) dst[n][k] = *(const LAS bf16x8*)(lds + PG8_SB(b, h) + boff + n * 2048 + k * 1024); } while (0)
#define PG8_MMA(ai, bj, At, Bt) do { __builtin_amdgcn_s_setprio(1); _Pragma("unroll") for (int m = 0; m < 4; ++m) _Pragma("unroll") for (int n = 0; n < 2; ++n) _Pragma("unroll") for (int k = 0; k < 2; ++k) \
        acc[ai][bj][m][n] = __builtin_amdgcn_mfma_f32_16x16x32_bf16(Bt[n][k], At[m][k], acc[ai][bj][m][n], 0, 0, 0); __builtin_amdgcn_s_setprio(0); } while (0)
#define PG8_WAIT_V(n) asm volatile("s_waitcnt vmcnt(" #n ")" ::: "memory")
#define PG8_WAIT_L(n) asm volatile("s_waitcnt lgkmcnt(" #n ")" ::: "memory")
#define PG8_BAR __builtin_amdgcn_s_barrier()
#define PG8_SCHED __builtin_amdgcn_sched_barrier(0)
    Unit cur, nxt; int ui = 0;
    if (!S.next(0, cur)) return;
    f32x4 acc[2][2][4][2];
#pragma unroll
    for (int a = 0; a < 2; ++a)
#pragma unroll
        for (int b = 0; b < 2; ++b)
#pragma unroll
            for (int m = 0; m < 4; ++m)
#pragma unroll
                for (int n = 0; n < 2; ++n) acc[a][b][m][n] = (f32x4){0.f, 0.f, 0.f, 0.f};
    bf16x8 At[4][2], B0[2][2], B1[2][2];
    const char* cA = (const char*)g.A + (size_t)cur.pm * tA; const char* cB = (const char*)g.Bt + (size_t)cur.pn * tB;
    PG8_STAGE(PG8_SB(0, 0), cB, voffB); PG8_STAGE(PG8_SB(0, 1), cB + hB, voffB); PG8_STAGE(PG8_SA(0, 0), cA, voffA); PG8_STAGE(PG8_SA(0, 1), cA + hA, voffA);
    if (wr == 1) PG8_BAR;
    PG8_WAIT_V(2); PG8_BAR;
    PG8_STAGE(PG8_SB(1, 0), cB + kstep, voffB); PG8_STAGE(PG8_SA(1, 0), cA + kstepA, voffA); PG8_STAGE(PG8_SB(1, 1), cB + hB + kstep, voffB);
    PG8_WAIT_V(6); PG8_BAR;
    for (;;) {
        const bool has_next = S.next(ui + 1, nxt);
        const char* nA = has_next ? (const char*)g.A + (size_t)nxt.pm * tA : cA; const char* nB = has_next ? (const char*)g.Bt + (size_t)nxt.pn * tB : cB;
        for (int t = 0; t < nt; t += 2) {
            const bool last = (t == nt - 2);
            const char* a1 = cA + (size_t)(t + 1) * kstepA;
            const char* a2 = last ? nA : cA + (size_t)(t + 2) * kstepA; const char* b2 = last ? nB : cB + (size_t)(t + 2) * kstep;
            const char* a3 = a2 + kstepA; const char* b3 = b2 + kstep;
            PG8_LDB(B0, 0, 0); PG8_LDB(B1, 0, 1); PG8_SCHED; PG8_LDA(At, 0, 0); PG8_STAGE(PG8_SA(1, 1), a1 + hA, voffA);
            PG8_WAIT_V(8); PG8_WAIT_L(0); PG8_BAR; PG8_MMA(0, 0, At, B0); PG8_MMA(0, 1, At, B1); PG8_BAR; PG8_SCHED;
            PG8_LDA(At, 0, 1); PG8_STAGE(PG8_SB(0, 0), b2, voffB); PG8_STAGE(PG8_SB(0, 1), b2 + hB, voffB); PG8_STAGE(PG8_SA(0, 0), a2, voffA);
            PG8_WAIT_V(8); PG8_WAIT_L(0); PG8_BAR; PG8_MMA(1, 0, At, B0); PG8_MMA(1, 1, At, B1); PG8_BAR; PG8_SCHED;
            PG8_LDB(B0, 1, 0); PG8_LDB(B1, 1, 1); PG8_SCHED; PG8_LDA(At, 1, 0); PG8_STAGE(PG8_SA(0, 1), a2 + hA, voffA);
            PG8_WAIT_V(8); PG8_WAIT_L(0); PG8_BAR; PG8_MMA(0, 0, At, B0); PG8_MMA(0, 1, At, B1); PG8_BAR; PG8_SCHED;
            PG8_LDA(At, 1, 1); PG8_STAGE(PG8_SB(1, 0), b3, voffB); PG8_STAGE(PG8_SB(1, 1), b3 + hB, voffB); PG8_STAGE(PG8_SA(1, 0), a3, voffA);
            PG8_WAIT_V(8); PG8_WAIT_L(0); PG8_BAR; PG8_MMA(1, 0, At, B0); PG8_MMA(1, 1, At, B1); PG8_BAR; PG8_SCHED;
        }
        if (wr == 0) PG8_BAR;
        E(acc, cur, wr, wc, fr, fq);
        if (!has_next) break;
#pragma unroll
        for (int a = 0; a < 2; ++a)
#pragma unroll
            for (int b = 0; b < 2; ++b)
#pragma unroll
                for (int m = 0; m < 4; ++m)
#pragma unroll
                    for (int n = 0; n < 2; ++n) acc[a][b][m][n] = (f32x4){0.f, 0.f, 0.f, 0.f};
        cur = nxt; cA = nA; cB = nB; ++ui;
        if (wr == 1) PG8_BAR;
    }
    PG8_WAIT_V(0);
    PG8_BAR;
#undef PG8_SA
#undef PG8_SB
#undef PG8_STAGE
#undef PG8_LDA
#undef PG8_LDB
#undef PG8_MMA
#undef PG8_WAIT_V
#undef PG8_WAIT_L
#undef PG8_BAR
#undef PG8_SCHED
}
}

struct Params {
    const float *x, *c, *ctx, *cctx, *w_ada, *b_ada, *norm1, *f1w1, *f1w3, *f1w2, *norm2, *w_in, *qan, *w_uq, *kvan, *w_ukv, *qn, *kn, *vn, *w_s, *b_s, *w_out, *norm3, *f2w1, *f2w3, *f2w2;
    float* out; unsigned char* ws; int ph_lo, ph_hi;
};

__device__ __forceinline__ void tr_item(const float* W, int N, int k0, int n0, bf16_t* dst, int ldd, const float* kscale, float* scr, int lane) {
#pragma unroll 8
    for (int i = 0; i < 32; ++i) { const int kk = 2 * i + (lane >> 5); float v = W[(size_t)(k0 + kk) * N + n0 + (lane & 31)]; if (kscale) v *= kscale[k0 + kk]; scr[kk * 33 + (lane & 31)] = v; }
    LDS_WAIT();
    const int c = lane & 7;
#pragma unroll
    for (int j = 0; j < 4; ++j) { const int n = (lane >> 3) + 8 * j; const float* s = scr + (8 * c) * 33 + n;
        u32x4 o; o.x = pk2(s[0 * 33], s[1 * 33]); o.y = pk2(s[2 * 33], s[3 * 33]); o.z = pk2(s[4 * 33], s[5 * 33]); o.w = pk2(s[6 * 33], s[7 * 33]);
        *(u32x4*)(dst + (size_t)n * ldd + 8 * c) = o; }
    LDS_WAIT();
}
__device__ __forceinline__ int win_row(int n) {
    if (n < 128) return 256 + n;
    if (n < 160) return 384 + (n - 128);
    if (n < 416) return n - 160;
    if (n < 928) return 512 + (n - 416);
    return 1024 + (n - 928);
}
template <bool SILU>
__device__ __forceinline__ void rowmat_item(const float* in, int istr, const float* in32, const float* W, int N, int j, const float* bias, float* out, int ldo, int cmap, float* lds, int tid) {
    const int wave = tid >> 6, lane = tid & 63, col = 64 * j + lane; const bool cok = col < N; const int colc = cok ? col : N - 1;
    float acc[33];
#pragma unroll
    for (int r = 0; r < 33; ++r) acc[r] = 0.f;
    for (int pass = 0; pass < 2; ++pass) {
        __syncthreads();
        {
            float cvv[33];
#pragma unroll
            for (int r = 0; r < 33; ++r) cvv[r] = (r < 32) ? in[(size_t)r * istr + 512 * pass + tid] : in32[512 * pass + tid];
#pragma unroll
            for (int r = 0; r < 33; ++r) lds[r * 512 + tid] = SILU ? cvv[r] / (1.f + __expf(-cvv[r])) : cvv[r];
        }
        __syncthreads();
        const int kb = 512 * pass + 64 * wave;
        const float* Wc = W + (size_t)kb * N + colc;
        float w0 = Wc[0], w1 = Wc[(size_t)N], w2 = Wc[(size_t)2 * N], w3 = Wc[(size_t)3 * N];
        float x0 = Wc[(size_t)4 * N], x1 = Wc[(size_t)5 * N], x2 = Wc[(size_t)6 * N], x3 = Wc[(size_t)7 * N];
        for (int k4 = 0; k4 < 16; ++k4) {
            const int kn = (k4 + 2 < 16) ? 4 * (k4 + 2) : 0;
            const float y0 = Wc[(size_t)(kn + 0) * N], y1 = Wc[(size_t)(kn + 1) * N], y2 = Wc[(size_t)(kn + 2) * N], y3 = Wc[(size_t)(kn + 3) * N];
#pragma unroll
            for (int r = 0; r < 33; ++r) { const f32x4 s = *(const f32x4*)(lds + r * 512 + 64 * wave + 4 * k4); acc[r] += s[0] * w0 + s[1] * w1 + s[2] * w2 + s[3] * w3; }
            w0 = x0; w1 = x1; w2 = x2; w3 = x3; x0 = y0; x1 = y1; x2 = y2; x3 = y3;
        }
    }
    __syncthreads();
#pragma unroll
    for (int r = 0; r < 33; ++r) lds[(wave * 33 + r) * 64 + lane] = acc[r];
    __syncthreads();
    for (int idx = tid; idx < 33 * 64; idx += 512) { const int r = idx >> 6, l = idx & 63, c = 64 * j + l; float s = 0.f;
#pragma unroll
        for (int w = 0; w < 8; ++w) s += lds[(w * 33 + r) * 64 + l];
        if (c < N) { const int oc = cmap == 0 ? c : cmap == 1 ? win_row(c) : (256 * (c >> 7) + (c & 127) + (cmap == 3 ? 128 : 0));
            out[(size_t)r * ldo + oc] = s + (bias ? bias[c] : 0.f); } }
    __syncthreads();
}
constexpr int I_UP = 16 * 88, I_DN = 44 * 32, I_IN = 16 * 45, I_UQ = 4 * 24, I_UKV = 2 * 32, I_OUT = 16 * 32;
constexpr int NITEMS = 4 * I_UP + 2 * I_DN + I_IN + I_UQ + I_UKV + I_OUT;
__device__ __forceinline__ void tr_dispatch(const Params& p, int it, float* scr, int lane) {
    unsigned char* ws = p.ws;
    int r = it;
    if (r < 4 * I_UP) { const int which = r / I_UP; r -= which * I_UP; const int kb = r / 88, nb = r % 88, k0 = 64 * kb, n0 = 32 * nb;
        const float* W = which == 0 ? p.f1w1 : which == 1 ? p.f1w3 : which == 2 ? p.f2w1 : p.f2w3;
        bf16_t* D = (bf16_t*)(ws + (which < 2 ? WS_W13A : WS_W13B));
        const int row = 256 * (n0 >> 7) + (n0 & 127) + ((which & 1) ? 128 : 0);
        tr_item(W, DFF, k0, n0, D + (size_t)row * DM + k0, DM, nullptr, scr, lane); return; }
    r -= 4 * I_UP;
    if (r < 2 * I_DN) { const int which = r / I_DN; r -= which * I_DN; const int kb = r / 32, nb = r % 32, k0 = 64 * kb, n0 = 32 * nb;
        tr_item(which ? p.f2w2 : p.f1w2, DM, k0, n0, (bf16_t*)(ws + (which ? WS_W2B : WS_W2A)) + (size_t)n0 * DFF + k0, DFF, nullptr, scr, lane); return; }
    r -= 2 * I_DN;
    if (r < I_IN) { const int kb = r / 45, nb = r % 45, k0 = 64 * kb, n0 = 32 * nb;
        tr_item(p.w_in, 1440, k0, n0, (bf16_t*)(ws + WS_WIN) + (size_t)win_row(n0) * DM + k0, DM, nullptr, scr, lane); return; }
    r -= I_IN;
    if (r < I_UQ) { const int kb = r / 24, nb = r % 24, k0 = 64 * kb, n0 = 32 * nb;
        tr_item(p.w_uq, 768, k0, n0, (bf16_t*)(ws + WS_WUQ) + (size_t)n0 * 256 + k0, 256, p.qan, scr, lane); return; }
    r -= I_UQ;
    if (r < I_UKV) { const int kb = r / 32, nb = r % 32, k0 = 64 * kb, n0 = 32 * nb; const int h = n0 >> 7, j = n0 & 127;
        bf16_t* D = (j < 64) ? (bf16_t*)(ws + WS_WK) + (size_t)(h * 64 + j) * 256 : (bf16_t*)(ws + WS_WV) + (size_t)(h * 64 + j - 64) * 256;
        tr_item(p.w_ukv, 1024, k0, n0, D + k0, 256, p.kvan, scr, lane); return; }
    r -= I_UKV;
    { const int kb = r / 32, nb = r % 32, k0 = 64 * kb, n0 = 32 * nb;
        tr_item(p.w_out, DM, k0, n0, (bf16_t*)(ws + WS_WOUT) + (size_t)n0 * DM + k0, DM, nullptr, scr, lane); }
}
__device__ __forceinline__ void tr_set(const Params& p, int set, int widx, int nw, float* scr, int lane, int j0 = 0, int j1 = 1 << 30) {
    const int nall = set == 1 ? (I_IN + I_UQ + I_UKV + I_OUT) : (2 * I_UP + I_DN); const int n = j1 < nall ? j1 : nall;
    for (int j = j0 + widx; j < n; j += nw) {
        const int it = set == 0 ? (j < 2 * I_UP ? j : 4 * I_UP + (j - 2 * I_UP))
                     : set == 1 ? (4 * I_UP + 2 * I_DN + j)
                     : (j < 2 * I_UP ? 2 * I_UP + j : 4 * I_UP + I_DN + (j - 2 * I_UP));
        tr_dispatch(p, it, scr, lane);
    }
}
__device__ __forceinline__ void phase0(const Params& p, float* lds) {
    unsigned char* ws = p.ws;
    const int tid = threadIdx.x, lane = tid & 63, wave = tid >> 6, G = gridDim.x;
    float* MOD = (float*)(ws + WS_MOD);
    if ((int)blockIdx.x < 144) rowmat_item<true>(p.c, DM, p.cctx, p.w_ada, NMOD, blockIdx.x, p.b_ada, MOD, NMOD, 0, lds, tid);
    {
        const int gt = blockIdx.x * 512 + tid, NT = G * 512;
        { f32x4* zs = (f32x4*)(ws + WS_SWIN); for (int i = gt; i < 33 * NPROJ / 4; i += NT) zs[i] = (f32x4){0.f, 0.f, 0.f, 0.f}; }
        { f32x4* zs = (f32x4*)(ws + WS_SS2); for (int i = gt; i < MT / 4; i += NT) zs[i] = (f32x4){0.f, 0.f, 0.f, 0.f}; }
        { f32x4* zs = (f32x4*)(ws + WS_RSQ); for (int i = gt; i < MX / 4; i += NT) zs[i] = (f32x4){0.f, 0.f, 0.f, 0.f}; }
        { f32x4* zs = (f32x4*)(ws + WS_RSKV); for (int i = gt; i < MT / 4; i += NT) zs[i] = (f32x4){0.f, 0.f, 0.f, 0.f}; }
        { f32x4* zs = (f32x4*)(ws + WS_SS3); for (int i = gt; i < MX / 4; i += NT) zs[i] = (f32x4){0.f, 0.f, 0.f, 0.f}; }
        u32x4* z0 = (u32x4*)((bf16_t*)(ws + WS_WIN) + (size_t)416 * 1024);
        for (int i = gt; i < 96 * 1024 / 8; i += NT) z0[i] = (u32x4){0u, 0u, 0u, 0u};
        for (int i = gt; i < 8 * 128 * 128 / 8; i += NT) { const f32x4 a = *(const f32x4*)(p.w_s + (size_t)i * 8), b = *(const f32x4*)(p.w_s + (size_t)i * 8 + 4);
            u32x4 o; o.x = pk2(a[0], a[1]); o.y = pk2(a[2], a[3]); o.z = pk2(b[0], b[1]); o.w = pk2(b[2], b[3]); *(u32x4*)((bf16_t*)(ws + WS_WS) + (size_t)i * 8) = o; }
    }
    if (G > 144) { if ((int)blockIdx.x >= 144) tr_set(p, 0, ((int)blockIdx.x - 144) * 8 + wave, (G - 144) * 8, lds + wave * 4096, lane, 1152);
                   else tr_set(p, 0, (int)blockIdx.x * 8 + wave, 1152, lds + wave * 4096, lane, 0, 1152); }
    else tr_set(p, 0, blockIdx.x * 8 + wave, G * 8, lds + wave * 4096, lane);
    __syncthreads();
}

__device__ __forceinline__ void norm_mod_phase(const float* srcx, const float* srcc, int nrows, const float* w, const float* MOD, int ishift, bf16_t* H) {
    const int tid = threadIdx.x, lane = tid & 63, wave = tid >> 6;
    const int gw = blockIdx.x * 8 + wave, NGW = gridDim.x * 8, nch = nrows / 8;
    for (int ch = gw; ch < nch; ch += NGW) {
        const int row0 = ch * 8; const bool isc = row0 >= MX; const int mrow = isc ? 32 : (row0 >> 11);
        const float* src = isc ? srcc + (size_t)(row0 - MX) * DM : srcx + (size_t)row0 * DM;
        const float* sh = MOD + (size_t)mrow * NMOD + ishift * DM; const float* sc = sh + DM;
        f32x4 g[4], s[4];
#pragma unroll
        for (int j = 0; j < 4; ++j) { const int c = 4 * lane + 256 * j; const f32x4 wv = *(const f32x4*)(w + c), scv = *(const f32x4*)(sc + c); g[j] = wv * (scv + 1.f); s[j] = *(const f32x4*)(sh + c); }
        f32x4 nx[4];
#pragma unroll
        for (int j = 0; j < 4; ++j) nx[j] = ((const f32x4*)src + lane)[64 * j];
        for (int rr = 0; rr < 8; ++rr) {
            f32x4 v[4]; float ss = 0.f;
#pragma unroll
            for (int j = 0; j < 4; ++j) v[j] = nx[j];
            if (rr < 7) { const f32x4* xr = (const f32x4*)(src + (size_t)(rr + 1) * DM) + lane;
#pragma unroll
                for (int j = 0; j < 4; ++j) nx[j] = xr[64 * j]; }
#pragma unroll
            for (int j = 0; j < 4; ++j) ss += (v[j][0] * v[j][0] + v[j][1] * v[j][1]) + (v[j][2] * v[j][2] + v[j][3] * v[j][3]);
            const float rstd = rsqrtf(wave_sum(ss) * (1.f / DM) + EPS);
            u32x2* o = (u32x2*)(H + (size_t)(row0 + rr) * DM) + lane;
#pragma unroll
            for (int j = 0; j < 4; ++j) { const f32x4 y = v[j] * rstd * g[j] + s[j]; u32x2 ov; ov.x = pk2(y[0], y[1]); ov.y = pk2(y[2], y[3]); o[64 * j] = ov; }
        }
    }
}

__device__ __forceinline__ void rstd_phase(const bf16_t* PROJ, float* RSQ, float* RSKV) {
    const int tid = threadIdx.x, lane = tid & 63, wave = tid >> 6;
    const int gw = blockIdx.x * 8 + wave, NGW = gridDim.x * 8;
    for (int r4 = gw; r4 < MT / 4; r4 += NGW) {
        unsigned kv[4]; u32x2 q[4];
#pragma unroll
        for (int i = 0; i < 4; ++i) { const int row = 4 * r4 + i; const bf16_t* pr = PROJ + (size_t)row * NPROJ;
            kv[i] = *((const unsigned*)(pr + 256) + lane); q[i] = (row < MX) ? *((const u32x2*)pr + lane) : (u32x2){0u, 0u}; }
#pragma unroll
        for (int i = 0; i < 4; ++i) { const int row = 4 * r4 + i;
            float s2 = bflo(kv[i]) * bflo(kv[i]) + bfhi(kv[i]) * bfhi(kv[i]);
            float s1 = (bflo(q[i].x) * bflo(q[i].x) + bfhi(q[i].x) * bfhi(q[i].x)) + (bflo(q[i].y) * bflo(q[i].y) + bfhi(q[i].y) * bfhi(q[i].y));
            s2 = wave_sum(s2); s1 = wave_sum(s1);
            if (lane == 0) { RSKV[row] = rsqrtf(s2 * (1.f / 128.f) + EPS); if (row < MX) RSQ[row] = rsqrtf(s1 * (1.f / 256.f) + EPS); } }
    }
}

__device__ __forceinline__ void gmlp_phase(const Params& p, unsigned char* lds) {
    unsigned char* ws = p.ws;
    const bf16_t* PROJ = (const bf16_t*)(ws + WS_PROJ); const bf16_t* WSb = (const bf16_t*)(ws + WS_WS); bf16_t* MIX = (bf16_t*)(ws + WS_MIX);
    const int tid = threadIdx.x, lane = tid & 63, wave = tid >> 6, r32 = lane & 31, hi = lane >> 5;
    bf16_t* Vt = (bf16_t*)lds;
    float* vnl = (float*)(lds + 32768); float* bsl = vnl + 512;
    { vnl[tid] = p.vn[tid]; bsl[tid] = p.b_s[tid]; bsl[tid + 512] = p.b_s[tid + 512]; }
    __syncthreads();
    const int pp = tid >> 2, cp = tid & 3;
    const int c0 = 32 * (wave >> 2), p0 = 32 * (wave & 3), pos = p0 + r32;
    u32x4 va, vb2;
    constexpr int NU = NB * 16 * 8;
    const bool bal = gridDim.x == 256;
    const int ubase = bal ? ((int)blockIdx.x < 64 ? (int)blockIdx.x * 13 : 832 + ((int)blockIdx.x - 64) * 17) : (int)blockIdx.x;
    const int ustep = bal ? 1 : (int)gridDim.x;
    const int uend = bal ? ubase + ((int)blockIdx.x < 64 ? 13 : 17) : NU;
    { const int unit = ubase; if (unit < uend) { const int g = unit & 7, n = (unit >> 3) & 15, b = unit >> 7;
        const bf16_t* src0 = PROJ + ((size_t)b * SEQ + n * 128 + pp) * NPROJ + 1024 + 64 * g + 16 * cp; va = *(const u32x4*)src0; vb2 = *(const u32x4*)(src0 + 8); } }
    for (int unit = ubase; unit < uend; unit += ustep) {
        const int g = unit & 7, n = (unit >> 3) & 15, b = unit >> 7;
        const size_t r0 = (size_t)b * SEQ + n * 128;
        bf16x8 wf[8];
        const bf16_t* wrow = WSb + ((size_t)g * 128 + pos) * 128 + 8 * hi;
#pragma unroll
        for (int s = 0; s < 8; ++s) wf[s] = *(const bf16x8*)(wrow + 16 * s);
        const bf16_t* urow = PROJ + (r0 + pos) * NPROJ + 512 + 64 * g + c0 + 4 * hi;
        u32x2 uu[4];
#pragma unroll
        for (int q = 0; q < 4; ++q) uu[q] = *(const u32x2*)(urow + 8 * q);
        const float bias = bsl[g * 128 + pos];
        f32x4 vw[4];
#pragma unroll
        for (int i = 0; i < 4; ++i) vw[i] = *(const f32x4*)(vnl + 64 * g + 16 * cp + 4 * i);
        {
            float v[16];
            v[0] = bflo(va.x); v[1] = bfhi(va.x); v[2] = bflo(va.y); v[3] = bfhi(va.y); v[4] = bflo(va.z); v[5] = bfhi(va.z); v[6] = bflo(va.w); v[7] = bfhi(va.w);
            v[8] = bflo(vb2.x); v[9] = bfhi(vb2.x); v[10] = bflo(vb2.y); v[11] = bfhi(vb2.y); v[12] = bflo(vb2.z); v[13] = bfhi(vb2.z); v[14] = bflo(vb2.w); v[15] = bfhi(vb2.w);
            float ss = 0.f;
#pragma unroll
            for (int i = 0; i < 16; ++i) { v[i] = gelu_f(v[i]); ss += v[i] * v[i]; }
            ss += __shfl_xor(ss, 1); ss += __shfl_xor(ss, 2);
            const float rstd = rsqrtf(ss * (1.f / 64.f) + EPS);
#pragma unroll
            for (int i = 0; i < 16; ++i) { const int c = 16 * cp + i; const float y = v[i] * rstd * vw[i >> 2][i & 3]; Vt[c * 136 + pp] = (bf16_t)(pk2(y, 0.f) & 0xffffu); }
        }
        {
            const int un = unit + ustep; if (un < uend) { const int g2 = un & 7, n2 = (un >> 3) & 15, b2 = un >> 7;
                const bf16_t* src0 = PROJ + ((size_t)b2 * SEQ + n2 * 128 + pp) * NPROJ + 1024 + 64 * g2 + 16 * cp; va = *(const u32x4*)src0; vb2 = *(const u32x4*)(src0 + 8); } }
        __syncthreads();
        {
            f32x16 acc = {};
            const bf16_t* vrow = Vt + (c0 + r32) * 136 + 8 * hi;
#pragma unroll
            for (int s = 0; s < 8; ++s) { const bf16x8 av = *(const bf16x8*)(vrow + 16 * s);
                acc = __builtin_amdgcn_mfma_f32_32x32x16_bf16(av, wf[s], acc, 0, 0, 0); }
            bf16_t* orow = MIX + (r0 + pos) * DM + 512 + 64 * g + c0 + 4 * hi;
#pragma unroll
            for (int q = 0; q < 4; ++q) {
                const float o0 = gelu_f(bflo(uu[q].x)) * (acc[4 * q + 0] + bias), o1 = gelu_f(bfhi(uu[q].x)) * (acc[4 * q + 1] + bias);
                const float o2 = gelu_f(bflo(uu[q].y)) * (acc[4 * q + 2] + bias), o3 = gelu_f(bfhi(uu[q].y)) * (acc[4 * q + 3] + bias);
                u32x2 ov; ov.x = pk2(o0, o1); ov.y = pk2(o2, o3); *(u32x2*)(orow + 8 * q) = ov; }
        }
        __syncthreads();
    }
}

__device__ __forceinline__ void unpack8(float* v, const u32x4 a) { v[0] = bflo(a.x); v[1] = bfhi(a.x); v[2] = bflo(a.y); v[3] = bfhi(a.y); v[4] = bflo(a.z); v[5] = bfhi(a.z); v[6] = bflo(a.w); v[7] = bfhi(a.w); }
__device__ __forceinline__ u32x4 pack8(const float* v) { u32x4 o; o.x = pk2(v[0], v[1]); o.y = pk2(v[2], v[3]); o.z = pk2(v[4], v[5]); o.w = pk2(v[6], v[7]); return o; }
__device__ __forceinline__ float rope_inv(int f) { return f == 0 ? 1.0f : f == 1 ? 0.316227766f : f == 2 ? 0.1f : f == 3 ? 0.0316227766f : f == 4 ? 0.01f : f == 5 ? 0.00316227766f : f == 6 ? 0.001f : 0.000316227766f; }
__device__ __forceinline__ void kprep_phase(const Params& p) {
    unsigned char* ws = p.ws;
    const bf16_t* KN = (const bf16_t*)(ws + WS_KNOPE); const bf16_t* PROJ = (const bf16_t*)(ws + WS_PROJ); bf16_t* KF = (bf16_t*)(ws + WS_KF);
    const int tid = threadIdx.x, lane = tid & 63, wave = tid >> 6, h = lane >> 3, j = lane & 7;
    const int gw = blockIdx.x * 8 + wave, NGW = gridDim.x * 8;
    float wn[8], wp[8];
#pragma unroll
    for (int i = 0; i < 8; ++i) { wn[i] = p.kn[8 * j + i]; wp[i] = p.kn[64 + 8 * (j & 3) + i]; }
    u32x4 na = {}, ne = {};
    if (gw < MT) { na = *(const u32x4*)(KN + (size_t)gw * 512 + h * 64 + 8 * j); ne = *(const u32x4*)(PROJ + (size_t)gw * NPROJ + 384 + 8 * (j & 3)); }
    for (int row = gw; row < MT; row += NGW) {
        float a[8], e[8];
        unpack8(a, na); unpack8(e, ne);
        { const int rn = row + NGW; if (rn < MT) { na = *(const u32x4*)(KN + (size_t)rn * 512 + h * 64 + 8 * j); ne = *(const u32x4*)(PROJ + (size_t)rn * NPROJ + 384 + 8 * (j & 3)); } }
        float ss = 0.f;
#pragma unroll
        for (int i = 0; i < 8; ++i) ss += a[i] * a[i];
        if (j < 4) {
#pragma unroll
            for (int i = 0; i < 8; ++i) ss += e[i] * e[i];
        }
        ss += __shfl_xor(ss, 1); ss += __shfl_xor(ss, 2); ss += __shfl_xor(ss, 4);
        const float rs = rsqrtf(ss * (1.f / 96.f) + EPS);
#pragma unroll
        for (int i = 0; i < 8; ++i) { a[i] *= rs * wn[i]; e[i] *= rs * wp[i]; }
        bf16_t* ko = KF + (size_t)row * 768 + h * 96;
        *(u32x4*)(ko + 8 * j) = pack8(a);
        const bool lat = row < MX; const int pos = row & (SEQ - 1);
        const float fpos = (float)(((j >> 1) & 1) ? (pos & 63) : (pos >> 6));
#pragma unroll
        for (int f = 0; f < 8; ++f) {
            const float partner = __shfl_xor(e[f], 1);
            float sn = 0.f, cs = 1.f;
            if (lat) { const float rev = (fpos * rope_inv(f)) * 0.15915494309189535f; sn = __builtin_amdgcn_sinf(rev); cs = __builtin_amdgcn_cosf(rev); }
            e[f] = e[f] * cs + ((j & 1) ? partner : -partner) * sn;
        }
        if (j < 4) *(u32x4*)(ko + 64 + 8 * j) = pack8(e);
    }
}

constexpr int KSTR = 208, VSTR = 144, KBUF = 64 * KSTR, VBUF = 64 * VSTR;
__device__ __forceinline__ float max3f(float a, float b, float c) { float r; asm("v_max3_f32 %0, %1, %2, %3" : "=v"(r) : "v"(a), "v"(b), "v"(c)); return r; }
__device__ __forceinline__ float swapmax(float m) { auto rr = __builtin_amdgcn_permlane32_swap(__float_as_uint(m), __float_as_uint(m), false, false); return fmaxf(__uint_as_float(rr[0]), __uint_as_float(rr[1])); }
__device__ __forceinline__ float swapadd(float m) { auto rr = __builtin_amdgcn_permlane32_swap(__float_as_uint(m), __float_as_uint(m), false, false); return __uint_as_float(rr[0]) + __uint_as_float(rr[1]); }
#define ASB() __builtin_amdgcn_sched_barrier(0)
struct AttStage { u32x4 k0, k1, v; };
struct AttCtx {
    const bf16_t* KF; const bf16_t* VT; unsigned char* Ks; unsigned char* Vs;
    int tid, b, h, kkey0, kpart0, kkey1, kpart1, vd, vpart, vdst, koff, voff;
};
__device__ __forceinline__ void att_load(const AttCtx& c, int t, AttStage& s) {
    const size_t kr = (t < 32) ? (size_t)c.b * SEQ + t * 64 : (size_t)MX + (size_t)c.b * CTXL + (t - 32) * 64;
    s.k0 = *(const u32x4*)(c.KF + (kr + c.kkey0) * 768 + c.h * 96 + 8 * c.kpart0);
    if (c.tid < 256) s.k1 = *(const u32x4*)(c.KF + (kr + c.kkey1) * 768 + c.h * 96 + 8 * c.kpart1);
    s.v = *(const u32x4*)(c.VT + (size_t)(c.h * 64 + c.vd) * MT + kr + 8 * c.vpart);
}
__device__ __forceinline__ void att_store(const AttCtx& c, int kbuf, int vbuf, const AttStage& s) {
    *(u32x4*)(c.Ks + kbuf * KBUF + c.kkey0 * KSTR + c.kpart0 * 16) = s.k0;
    if (c.tid < 256) *(u32x4*)(c.Ks + kbuf * KBUF + c.kkey1 * KSTR + c.kpart1 * 16) = s.k1;
    *(u32x2*)(c.Vs + vbuf * VBUF + c.vdst) = (u32x2){s.v.x, s.v.y}; *(u32x2*)(c.Vs + vbuf * VBUF + c.vdst + 16) = (u32x2){s.v.z, s.v.w};
}
#define LDK(s_, A, C) do { A = *(const bf16x8*)(kb + (s_) * 32); C = *(const bf16x8*)(kb + 32 * KSTR + (s_) * 32); } while (0)
#define LDV(s_, A, C) do { A = *(const bf16x8*)(vb + (s_) * 32); C = *(const bf16x8*)(vb + 32 * VSTR + (s_) * 32); } while (0)
#define MMA(Acc, A, B) Acc = __builtin_amdgcn_mfma_f32_32x32x16_bf16(A, B, Acc, 0, 0, 0)
#define EXP4(V, i) do { V[i] = fexp2(V[i]); V[i + 1] = fexp2(V[i + 1]); V[i + 2] = fexp2(V[i + 2]); V[i + 3] = fexp2(V[i + 3]); } while (0)
__device__ __forceinline__ void att_iter(const AttCtx& c, int t, int& vcur, const bf16x8 (&qf)[6], f32x16& s0, f32x16& s1, f32x16& o0, f32x16& o1, float& mref, float& lsum, AttStage& L, const AttStage& S) {
    const bool more = t < 36;
    if (t + 2 < 36) att_load(c, t + 2, L);
    const unsigned char* kb = c.Ks + (t & 1) * KBUF + c.koff;
    const unsigned char* vb = c.Vs + vcur * VBUF + c.voff;
    f32x16 n0 = {}, n1 = {};
    u32x4 pw0, pw1, pw2, pw3;
    bf16x8 ka0, kc0, ka1, kc1, va0, vc0, va1, vc1;
    LDK(0, ka0, kc0);
    ASB();
    LDK(1, ka1, kc1);
    if (more) MMA(n0, ka0, qf[0]);
    float ma = max3f(s0[0], s0[1], s0[2]); ma = max3f(ma, s0[3], s0[4]); ma = max3f(ma, s0[5], s0[6]); ma = max3f(ma, s0[7], s0[8]);
    ASB();
    if (more) MMA(n1, kc0, qf[0]);
    ma = max3f(ma, s0[9], s0[10]); ma = max3f(ma, s0[11], s0[12]); ma = max3f(ma, s0[13], s0[14]); ma = fmaxf(ma, s0[15]);
    ASB();
    LDK(2, ka0, kc0);
    if (more) MMA(n0, ka1, qf[1]);
    float mb = max3f(s1[0], s1[1], s1[2]); mb = max3f(mb, s1[3], s1[4]); mb = max3f(mb, s1[5], s1[6]); mb = max3f(mb, s1[7], s1[8]);
    ASB();
    if (more) MMA(n1, kc1, qf[1]);
    mb = max3f(mb, s1[9], s1[10]); mb = max3f(mb, s1[11], s1[12]); mb = max3f(mb, s1[13], s1[14]); mb = max3f(mb, s1[15], ma);
    const float mx = swapmax(mb);
    if (__any(mx > mref + 8.f)) {
        const float mn = fmaxf(mref, mx), alpha = fexp2(mref - mn); mref = mn; lsum *= alpha;
#pragma unroll
        for (int r = 0; r < 16; ++r) { o0[r] *= alpha; o1[r] *= alpha; }
    }
    ASB();
    LDK(3, ka1, kc1);
    if (more) MMA(n0, ka0, qf[2]);
    s0 = s0 - mref; EXP4(s0, 0);
    ASB();
    if (more) MMA(n1, kc0, qf[2]);
    EXP4(s0, 4);
    pw0 = (u32x4){pk2(s0[0], s0[1]), pk2(s0[2], s0[3]), pk2(s0[4], s0[5]), pk2(s0[6], s0[7])};
    ASB();
    LDK(4, ka0, kc0);
    if (more) MMA(n0, ka1, qf[3]);
    EXP4(s0, 8);
    ASB();
    if (more) MMA(n1, kc1, qf[3]);
    EXP4(s0, 12);
    pw1 = (u32x4){pk2(s0[8], s0[9]), pk2(s0[10], s0[11]), pk2(s0[12], s0[13]), pk2(s0[14], s0[15])};
    ASB();
    LDK(5, ka1, kc1);
    if (more) MMA(n0, ka0, qf[4]);
    s1 = s1 - mref; EXP4(s1, 0);
    ASB();
    if (more) MMA(n1, kc0, qf[4]);
    EXP4(s1, 4);
    pw2 = (u32x4){pk2(s1[0], s1[1]), pk2(s1[2], s1[3]), pk2(s1[4], s1[5]), pk2(s1[6], s1[7])};
    ASB();
    LDV(0, va0, vc0);
    if (more) MMA(n0, ka1, qf[5]);
    EXP4(s1, 8);
    ASB();
    if (more) MMA(n1, kc1, qf[5]);
    EXP4(s1, 12);
    pw3 = (u32x4){pk2(s1[8], s1[9]), pk2(s1[10], s1[11]), pk2(s1[12], s1[13]), pk2(s1[14], s1[15])};
    ASB();
    LDV(1, va1, vc1);
    MMA(o0, va0, __builtin_bit_cast(bf16x8, pw0)); MMA(o1, vc0, __builtin_bit_cast(bf16x8, pw0));
    { const f32x16 sv = s0 + s1; lsum += ((sv[0] + sv[1]) + (sv[2] + sv[3])) + ((sv[4] + sv[5]) + (sv[6] + sv[7])) + ((sv[8] + sv[9]) + (sv[10] + sv[11])) + ((sv[12] + sv[13]) + (sv[14] + sv[15])); }
    ASB();
    LDV(2, va0, vc0);
    MMA(o0, va1, __builtin_bit_cast(bf16x8, pw1)); MMA(o1, vc1, __builtin_bit_cast(bf16x8, pw1));
    ASB();
    LDV(3, va1, vc1);
    MMA(o0, va0, __builtin_bit_cast(bf16x8, pw2)); MMA(o1, vc0, __builtin_bit_cast(bf16x8, pw2));
    ASB();
    MMA(o0, va1, __builtin_bit_cast(bf16x8, pw3)); MMA(o1, vc1, __builtin_bit_cast(bf16x8, pw3));
    ASB();
    if (t + 1 < 36) { const int vn = (vcur == 0) ? 2 : vcur - 1; att_store(c, (t + 1) & 1, vn, S); }
    asm volatile("s_waitcnt lgkmcnt(0)" ::: "memory"); __builtin_amdgcn_s_barrier(); asm volatile("" ::: "memory");
    s0 = n0; s1 = n1; vcur = (vcur == 2) ? 0 : vcur + 1;
}
__device__ __forceinline__ void attn_phase(const Params& p, unsigned char* lds) {
    unsigned char* ws = p.ws;
    const bf16_t* Q = (const bf16_t*)(ws + WS_QRAW); bf16_t* MIX = (bf16_t*)(ws + WS_MIX);
    const int tid = threadIdx.x, lane = tid & 63, wave = tid >> 6, r32 = lane & 31, hi = lane >> 5;
    AttCtx c; c.KF = (const bf16_t*)(ws + WS_KF); c.VT = (const bf16_t*)(ws + WS_VT); c.Ks = lds; c.Vs = lds + 2 * KBUF; c.tid = tid;
    const int bx = blockIdx.x, G = gridDim.x;
    const int vcu = (G % 8 == 0) ? (bx % 8) * (G / 8) + bx / 8 : bx;
    c.kkey0 = tid / 12; c.kpart0 = tid % 12; c.kkey1 = (tid + 512) / 12; c.kpart1 = (tid + 512) % 12;
    c.vd = tid >> 3; c.vpart = tid & 7;
    c.vdst = c.vd * VSTR + (c.vpart >> 1) * 32 + (c.vpart & 1) * 8;
    c.koff = r32 * KSTR + hi * 16; c.voff = r32 * VSTR + hi * 16;
    float* qnl = (float*)(lds + 65536);
    if (tid < 96) qnl[tid] = p.qn[tid];
    __syncthreads();
    for (int unit = vcu; unit < NB * NH * 8; unit += G) {
        const int qb = unit & 7, h = (unit >> 3) & 7, b = unit >> 6;
        c.b = b; c.h = h;
        const size_t qrow = (size_t)b * SEQ + qb * 256 + wave * 32 + r32;
        bf16x8 qf[6];
        {
            float qv[6][8]; float ss = 0.f;
#pragma unroll
            for (int s = 0; s < 6; ++s) { unpack8(qv[s], *(const u32x4*)(Q + qrow * 768 + h * 96 + 16 * s + 8 * hi));
#pragma unroll
                for (int i = 0; i < 8; ++i) ss += qv[s][i] * qv[s][i]; }
            ss += __shfl_xor(ss, 32);
            const float rs = rsqrtf(ss * (1.f / 96.f) + EPS) * QSCALE;
#pragma unroll
            for (int s = 0; s < 6; ++s)
#pragma unroll
                for (int i = 0; i < 8; ++i) qv[s][i] *= rs * qnl[16 * s + 8 * hi + i];
            const int pos = (int)(qrow & (SEQ - 1));
#pragma unroll
            for (int s = 4; s < 6; ++s) { const float fpos = (float)(s == 4 ? (pos >> 6) : (pos & 63));
#pragma unroll
                for (int f = 0; f < 8; ++f) { const float partner = __shfl_xor(qv[s][f], 32);
                    const float rev = (fpos * rope_inv(f)) * 0.15915494309189535f; const float sn = __builtin_amdgcn_sinf(rev), cs = __builtin_amdgcn_cosf(rev);
                    qv[s][f] = qv[s][f] * cs + (hi ? partner : -partner) * sn; } }
#pragma unroll
            for (int s = 0; s < 6; ++s) qf[s] = __builtin_bit_cast(bf16x8, pack8(qv[s]));
        }
        float mref = -1e30f, lsum = 0.f; f32x16 o0 = {}, o1 = {};
        AttStage A, B; A.k1 = (u32x4){0u, 0u, 0u, 0u}; B.k1 = A.k1;
        att_load(c, 0, A); att_store(c, 0, 0, A);
        asm volatile("s_waitcnt lgkmcnt(0)" ::: "memory"); __builtin_amdgcn_s_barrier(); asm volatile("" ::: "memory");
        att_load(c, 1, A); att_load(c, 2, B);
        f32x16 s0 = {}, s1 = {};
        { const unsigned char* kb = c.Ks + c.koff; bf16x8 ka, kc;
#pragma unroll
          for (int s = 0; s < 6; ++s) { LDK(s, ka, kc); MMA(s0, ka, qf[s]); MMA(s1, kc, qf[s]); } }
        att_store(c, 1, 1, A);
        asm volatile("s_waitcnt lgkmcnt(0)" ::: "memory"); __builtin_amdgcn_s_barrier(); asm volatile("" ::: "memory");
        int vcur = 0;
        for (int t = 1; t <= 35; t += 2) {
            att_iter(c, t, vcur, qf, s0, s1, o0, o1, mref, lsum, A, B);
            att_iter(c, t + 1, vcur, qf, s0, s1, o0, o1, mref, lsum, B, A);
        }
        lsum = swapadd(lsum);
        const float il = 1.f / lsum;
        bf16_t* orow = MIX + qrow * DM + h * 64 + 4 * hi;
#pragma unroll
        for (int q = 0; q < 4; ++q) {
            u32x2 a; a.x = pk2(o0[4 * q] * il, o0[4 * q + 1] * il); a.y = pk2(o0[4 * q + 2] * il, o0[4 * q + 3] * il); *(u32x2*)(orow + 8 * q) = a;
            u32x2 cc; cc.x = pk2(o1[4 * q] * il, o1[4 * q + 1] * il); cc.y = pk2(o1[4 * q + 2] * il, o1[4 * q + 3] * il); *(u32x2*)(orow + 32 + 8 * q) = cc;
        }
    }
}
#undef LDK
#undef LDV
#undef MMA
#undef EXP4
#undef ASB

constexpr int NPHASE = 12;
__global__ void __launch_bounds__(512, 2) mega_fwd(Params p) {
    extern __shared__ __attribute__((aligned(16))) unsigned char lds[];
    LAS unsigned char* ldsl = (LAS unsigned char*)lds;
    unsigned char* ws = p.ws;
    const int G = gridDim.x, bx = blockIdx.x;
    float* MOD = (float*)(ws + WS_MOD);
    bf16_t* H = (bf16_t*)(ws + WS_H); bf16_t* ACT = (bf16_t*)(ws + WS_ACT); bf16_t* PROJ = (bf16_t*)(ws + WS_PROJ);
    float* X1C = (float*)(ws + WS_X1C); float* RSQ = (float*)(ws + WS_RSQ); float* RSKV = (float*)(ws + WS_RSKV);
    const int lo = p.ph_lo, hi = p.ph_hi;
#define IN(k) (lo <= (k) && (k) < hi)
#define SEAM(k) do { if (IN(k) && IN((k) + 1)) { cg::this_grid().sync(); } } while (0)
    using pg8::Gemm; using pg8::StaticOrder;

    if (IN(0)) { phase0(p, (float*)lds); } SEAM(0);
    if (IN(1)) { norm_mod_phase(p.x, p.ctx, MT, p.norm1, MOD, 0, H); } SEAM(1);
    if (IN(2)) { Gemm g{H, (const bf16_t*)(ws + WS_W13A), MT, 2 * DFF, DM, DM, DM}; StaticOrder S; S.init(MT, 2 * DFF, G, bx);
        pg8::EpiSwigluT<false> E{ACT, DFF, nullptr, nullptr}; pg8::gemm_phase(ldsl, g, S, E);
        { const int fi = S.nwg % G, np = fi ? G - fi : G, wi = fi ? bx - fi : bx; const int wave = threadIdx.x >> 6, lane = threadIdx.x & 63;
          if (wi >= 0) { tr_set(p, 1, wi * 8 + wave, np * 8, (float*)lds + wave * 4096, lane); } __syncthreads(); } } SEAM(2);
    if (IN(3)) { Gemm g{ACT, (const bf16_t*)(ws + WS_W2A), MT, DM, DFF, DFF, DFF}; StaticOrder S; S.init(MT, DM, G, bx);
        pg8::EpiRes<MX / 256, 1, true> E{p.x, p.ctx, p.out, X1C, MOD + 2 * DM, p.norm2, MOD + 4 * DM, H, (float*)(ws + WS_SS2)}; pg8::gemm_phase<pg8::EpiRes<MX / 256, 1, true>, StaticOrder, true>(ldsl, g, S, E);
        { const int fi = S.nwg % G, np = fi ? G - fi : G, wi = fi ? bx - fi : bx; const int tid = threadIdx.x, wave = tid >> 6, lane = tid & 63;
          if (wi >= 0) {
            for (int it = wi; it < 111; it += np) {
                if (it < 23) rowmat_item<false>(MOD + 3 * DM, NMOD, MOD + (size_t)32 * NMOD + 3 * DM, p.w_in, 1440, it, nullptr, (float*)(ws + WS_SWIN), NPROJ, 1, (float*)lds, tid);
                else if (it < 67) rowmat_item<false>(MOD + 6 * DM, NMOD, MOD + (size_t)32 * NMOD + 6 * DM, p.f2w1, DFF, it - 23, nullptr, (float*)(ws + WS_SW13), 2 * DFF, 2, (float*)lds, tid);
                else rowmat_item<false>(MOD + 6 * DM, NMOD, MOD + (size_t)32 * NMOD + 6 * DM, p.f2w3, DFF, it - 67, nullptr, (float*)(ws + WS_SW13), 2 * DFF, 3, (float*)lds, tid);
            }
            tr_set(p, 2, wi * 8 + wave, np * 8, (float*)lds + wave * 4096, lane); } __syncthreads(); } } SEAM(3);
    if (IN(4)) {
        { Gemm g{H, (const bf16_t*)(ws + WS_WIN), MX, NPROJ, DM, DM, DM}; StaticOrder S; S.init(MX, NPROJ, G, bx);
          pg8::EpiBf16S E{PROJ, NPROJ, (const float*)(ws + WS_SS2), 1.f / DM, nullptr, 0.f, (const float*)(ws + WS_SWIN), NPROJ, -1, RSQ, RSKV, 0}; pg8::gemm_phase(ldsl, g, S, E); }
        { Gemm g{H + (size_t)MX * DM, (const bf16_t*)(ws + WS_WIN) + (size_t)256 * DM, MC, 256, DM, DM, DM}; StaticOrder S; S.init(MC, 256, G, bx);
          pg8::EpiBf16S E{PROJ + (size_t)MX * NPROJ + 256, NPROJ, (const float*)(ws + WS_SS2) + MX, 1.f / DM, nullptr, 0.f, (const float*)(ws + WS_SWIN) + 256, NPROJ, 32, RSKV + MX, RSKV + MX, 1}; pg8::gemm_phase(ldsl, g, S, E); }
    } SEAM(4);
    if (IN(6)) {
        { Gemm g{PROJ, (const bf16_t*)(ws + WS_WUQ), MX, 768, 256, NPROJ, 256}; StaticOrder S; S.init(MX, 768, G, bx);
          pg8::EpiBf16S E{(bf16_t*)(ws + WS_QRAW), 768, RSQ, 1.f / 256.f, nullptr, 0.f, nullptr, 0, 0, nullptr, nullptr, 8}; pg8::gemm_phase(ldsl, g, S, E); }
        { int k128 = 128; asm volatile("" : "+s"(k128));     Gemm g{PROJ + 256, (const bf16_t*)(ws + WS_WK), MT, 512, k128, NPROJ, 256}; StaticOrder S; S.init(MT, 512, G, bx);
          pg8::EpiBf16S E{(bf16_t*)(ws + WS_KNOPE), 512, RSKV, 1.f / 128.f, nullptr, 0.f, nullptr, 0, 0, nullptr, nullptr, 8}; pg8::gemm_phase(ldsl, g, S, E); }
        { int k128 = 128; asm volatile("" : "+s"(k128)); Gemm g{(const bf16_t*)(ws + WS_WV), PROJ + 256, 512, MT, k128, 256, NPROJ}; StaticOrder S; S.init(512, MT, G, bx);
          pg8::EpiBf16S E{(bf16_t*)(ws + WS_VT), MT, nullptr, 0.f, RSKV, 1.f / 128.f, nullptr, 0, 0, nullptr, nullptr, 8}; pg8::gemm_phase(ldsl, g, S, E); }
        gmlp_phase(p, lds);
    } SEAM(6);
    if (IN(7)) { kprep_phase(p); } SEAM(7);
    if (IN(8)) { attn_phase(p, lds); } SEAM(8);
    if (IN(9)) { Gemm g{(const bf16_t*)(ws + WS_MIX), (const bf16_t*)(ws + WS_WOUT), MX, DM, DM, DM, DM}; StaticOrder S; S.init(MX, DM, G, bx);
        pg8::EpiRes<(1 << 30), 2, true> E{p.out, nullptr, p.out, nullptr, MOD + 5 * DM, p.norm3, MOD + 7 * DM, (bf16_t*)(ws + WS_H3), (float*)(ws + WS_SS3)}; pg8::gemm_phase(ldsl, g, S, E); } SEAM(9);
    if (IN(10)) { Gemm g{(const bf16_t*)(ws + WS_H3), (const bf16_t*)(ws + WS_W13B), MX, 2 * DFF, DM, DM, DM}; StaticOrder S; S.init(MX, 2 * DFF, G, bx);
        pg8::EpiSwigluT<true> E{ACT, DFF, (const float*)(ws + WS_SS3), (const float*)(ws + WS_SW13)}; pg8::gemm_phase(ldsl, g, S, E); } SEAM(10);
    if (IN(11)) { Gemm g{ACT, (const bf16_t*)(ws + WS_W2B), MX, DM, DFF, DFF, DFF}; StaticOrder S; S.init(MX, DM, G, bx);
        pg8::EpiRes<(1 << 30), 1, false> E{p.out, nullptr, p.out, nullptr, MOD + 8 * DM, nullptr, nullptr, nullptr, nullptr}; pg8::gemm_phase<pg8::EpiRes<(1 << 30), 1, false>, StaticOrder, true>(ldsl, g, S, E); }
#undef IN
#undef SEAM
}

extern "C" void kernel_launch(void* const* d_in, const int* in_sizes, int n_in, void* d_out, int out_size, void* d_ws, size_t ws_size, hipStream_t stream) {
    static int grid = 0;
    if (grid == 0) {
        if (n_in != 26 || in_sizes[0] != MX * DM || out_size != MX * DM || ws_size < WS_END) { fprintf(stderr, "kernel_launch: unexpected shapes (n_in %d, in0 %d, out %d, ws %zu)\n", n_in, n_in > 0 ? in_sizes[0] : -1, out_size, ws_size); grid = -1; return; }
        int dev = 0, cus = 0, per_cu = 0;
        if (hipGetDevice(&dev) != hipSuccess || hipDeviceGetAttribute(&cus, hipDeviceAttributeMultiprocessorCount, dev) != hipSuccess) { grid = -1; return; }
        if (hipFuncSetAttribute((const void*)mega_fwd, hipFuncAttributeMaxDynamicSharedMemorySize, LDS_BYTES) != hipSuccess) { fprintf(stderr, "kernel_launch: hipFuncSetAttribute failed\n"); grid = -1; return; }
        if (hipOccupancyMaxActiveBlocksPerMultiprocessor(&per_cu, (const void*)mega_fwd, 512, LDS_BYTES) != hipSuccess || per_cu < 1) { fprintf(stderr, "kernel_launch: occupancy query says %d\n", per_cu); per_cu = 1; }
        (void)hipGetLastError();
        grid = cus;
    }
    if (grid < 0) return;
    Params p{};
    const float** pp = (const float**)&p;
    for (int i = 0; i < 26; ++i) pp[i] = (const float*)d_in[i];
    p.out = (float*)d_out; p.ws = (unsigned char*)d_ws;
#if MK_ONE_LAUNCH
    p.ph_lo = 0; p.ph_hi = NPHASE;
    void* args[] = {&p};
    hipError_t e = hipLaunchCooperativeKernel((const void*)mega_fwd, dim3(grid), dim3(512), args, LDS_BYTES, stream);
    if (e != hipSuccess) fprintf(stderr, "cooperative launch failed: %s (grid %d)\n", hipGetErrorString(e), grid);
#else
    for (int ph = 0; ph < NPHASE; ++ph) {
        p.ph_lo = ph; p.ph_hi = ph + 1;
        hipLaunchKernelGGL(mega_fwd, dim3(grid), dim3(512), LDS_BYTES, stream, p);
    }
#endif
}
```

```cpp
#include <hip/hip_runtime.h>
#include <hip/hip_cooperative_groups.h>
#include <cstdio>
#include <cstdint>
namespace cg = cooperative_groups;

#ifndef MK_ONE_LAUNCH
#define MK_ONE_LAUNCH 1
#endif

#define LAS __attribute__((address_space(3)))
typedef unsigned short bf16_t;
typedef short bf16x8 __attribute__((ext_vector_type(8)));
typedef float f32x4 __attribute__((ext_vector_type(4)));
typedef float f32x16 __attribute__((ext_vector_type(16)));
typedef unsigned u32x4 __attribute__((ext_vector_type(4)));
typedef unsigned u32x2 __attribute__((ext_vector_type(2)));

constexpr int DM = 1024, NB = 32, SEQ = 2048, CTXL = 256, DFF = 2816;
constexpr int MX = NB * SEQ;
constexpr int MC = NB * CTXL;
constexpr int MT = MX + MC;
constexpr int NMOD = 9 * DM;
constexpr int NPROJ = 1536;
constexpr int NH = 8, DQK = 96, DV = 64;
constexpr float EPS = 1e-6f;
constexpr float QSCALE = 0.10206207261596577f * 1.4426950408889634f;

constexpr size_t MiB = 1u << 20;
constexpr size_t WS_MOD = 1 * MiB, WS_RSQ = 3 * MiB, WS_RSKV = 3 * MiB + 512 * 1024;
constexpr size_t WS_W13A = 4 * MiB, WS_W2A = 15 * MiB, WS_W13B = 21 * MiB, WS_W2B = 32 * MiB, WS_WIN = 38 * MiB;
constexpr size_t WS_WUQ = 41 * MiB, WS_WK = 41 * MiB + 512 * 1024, WS_WV = 41 * MiB + 768 * 1024, WS_WOUT = 42 * MiB, WS_WS = 44 * MiB;
constexpr size_t WS_X1C = 46 * MiB, WS_H = 80 * MiB, WS_ACT = 224 * MiB;
constexpr size_t WS_PROJ = 224 * MiB, WS_QRAW = 440 * MiB, WS_KNOPE = 536 * MiB;
constexpr size_t WS_KF = 620 * MiB, WS_VT = 728 * MiB, WS_END = 800 * MiB;
constexpr size_t WS_MIX = WS_H;
constexpr size_t WS_SWIN = 44 * MiB + 512 * 1024, WS_SW13 = 45 * MiB, WS_SS2 = 78 * MiB, WS_SS3 = 78 * MiB + 512 * 1024;
constexpr size_t WS_H3 = WS_KF;

constexpr int LDS_BYTES = 147456;

__device__ __forceinline__ unsigned pk2(float lo, float hi) {
    typedef float f2 __attribute__((ext_vector_type(2))); typedef __bf16 b2 __attribute__((ext_vector_type(2)));
    f2 v = {lo, hi}; b2 b = __builtin_convertvector(v, b2); return __builtin_bit_cast(unsigned, b);
}
__device__ __forceinline__ float bflo(unsigned w) { return __uint_as_float(w << 16); }
__device__ __forceinline__ float bfhi(unsigned w) { return __uint_as_float(w & 0xffff0000u); }
__device__ __forceinline__ float fexp2(float x) { return __builtin_amdgcn_exp2f(x); }
__device__ __forceinline__ float frcp(float x) { return __builtin_amdgcn_rcpf(x); }
__device__ __forceinline__ float silu_f(float a) { return a * frcp(1.f + fexp2(-1.4426950408889634f * a)); }
__device__ __forceinline__ float gelu_f(float x) { const float y = 0.7978845608028654f * (x + 0.044715f * x * x * x); return x * frcp(1.f + fexp2(-2.8853900817779268f * y)); }
__device__ __forceinline__ float wave_sum(float v) {
#pragma unroll
    for (int o = 1; o < 64; o <<= 1) v += __shfl_xor(v, o);
    return v;
}
#define LDS_WAIT() asm volatile("s_waitcnt lgkmcnt(0)" ::: "memory")

namespace pg8 {
constexpr int BM = 256, BK = 64, HALF = 128, HTB = HALF * BK * 2, STAGE_BYTES = 8 * HTB, NXCD = 8, WGM = 4;
__host__ __device__ __forceinline__ int lds_byte(int r, int c) { const int st = (r >> 4) * 2 + (c >> 5), rr = r & 15, cc = c & 31, ob = rr * 64 + cc * 2; return st * 1024 + (ob ^ (((ob >> 9) & 1) << 5)); }
__host__ __device__ __forceinline__ void stage_rc(int b, int& R, int& C) { const int st = b / 1024, sb = b % 1024, swz = sb ^ (((sb >> 9) & 1) << 5); R = (st >> 1) * 16 + swz / 64; C = (st & 1) * 32 + (swz % 64) / 2; }
__host__ __device__ __forceinline__ int perm32(int rho) { const int n = rho >> 4, i = rho & 15; return 8 * (i >> 2) + 4 * n + (i & 3); }

struct Unit { int pm, pn; };
struct Gemm { const bf16_t* A; const bf16_t* Bt; int M, N, K, lda, ldb; };

struct StaticOrder {
    int nM, nN, nwg, G, c;
    __device__ void init(int M, int N, int G_, int c_) { nM = M / BM; nN = N / BM; nwg = nM * nN; G = G_; c = c_; }
    __device__ bool next(int i, Unit& u) const {
        const long L = (long)i * G + c; if (L >= nwg) return false;
        int wgid = (int)L; { const int q = nwg / NXCD, r = nwg % NXCD, xcd = wgid % NXCD, off = wgid / NXCD; wgid = (xcd < r ? xcd * (q + 1) : r * (q + 1) + (xcd - r) * q) + off; }
        const int nig = WGM * nN, gid = wgid / nig, fm = gid * WGM, gsz = (nM - fm) < WGM ? (nM - fm) : WGM;
        u.pm = fm + ((wgid % nig) % gsz); u.pn = (wgid % nig) / gsz; return true;
    }
};

template <bool NORM, bool TILED = true> struct EpiSwigluT {
    static constexpr bool PERM = true;
    bf16_t* O; int ldc; const float* SSn; const float* cb;
    __device__ __forceinline__ void operator()(const f32x4 (&acc)[2][2][4][2], const Unit& u, int wr, int wc, int fr, int fq) const {
        const int row0 = u.pm * BM + wr * 64 + fr, col0 = u.pn * HALF + wc * 32 + 8 * fq;
        f32x4 cv[2][2];
        if (NORM) {
            const float* cbp = cb + (size_t)(u.pm >> 3) * (2 * DFF) + u.pn * BM + wc * 32 + 8 * fq;
#pragma unroll
            for (int bj = 0; bj < 2; ++bj)
#pragma unroll
                for (int n = 0; n < 2; ++n) cv[bj][n] = *(const f32x4*)(cbp + bj * HALF + 4 * n);
        }
#pragma unroll
        for (int ai = 0; ai < 2; ++ai)
#pragma unroll
            for (int m = 0; m < 4; ++m) {
                const int row = row0 + ai * HALF + m * 16;
                bf16_t* rowp = TILED ? O + ((size_t)((row >> 4) * (ldc >> 5) + (col0 >> 5)) * 512 + (row & 15) * 32 + (col0 & 31)) : O + (size_t)row * ldc + col0;
                f32x4 a0 = acc[ai][0][m][0], a1 = acc[ai][0][m][1], b0 = acc[ai][1][m][0], b1 = acc[ai][1][m][1];
                if (NORM) { const float r = rsqrtf(SSn[row] * (1.f / DM) + EPS); a0 = a0 * r + cv[0][0]; a1 = a1 * r + cv[0][1]; b0 = b0 * r + cv[1][0]; b1 = b1 * r + cv[1][1]; }
                u32x4 w;
                w.x = pk2(silu_f(a0[0]) * b0[0], silu_f(a0[1]) * b0[1]); w.y = pk2(silu_f(a0[2]) * b0[2], silu_f(a0[3]) * b0[3]);
                w.z = pk2(silu_f(a1[0]) * b1[0], silu_f(a1[1]) * b1[1]); w.w = pk2(silu_f(a1[2]) * b1[2], silu_f(a1[3]) * b1[3]);
                *(u32x4*)rowp = w;
            }
    }
};
template <int ctx_tile0, int COEF2, bool NORM, bool HTILED = false> struct EpiRes {
    static constexpr bool PERM = true;
    const float* bx; const float* bc; float* ox; float* oc; const float* gate;
    const float* nw; const float* nscale; bf16_t* Hn; float* SS;
    __device__ __forceinline__ void operator()(const f32x4 (&acc)[2][2][4][2], const Unit& u, int wr, int wc, int fr, int fq) const {
        asm volatile("" : "+v"(fr), "+v"(fq));
        const bool isc = u.pm >= ctx_tile0;
        const int mrow = isc ? 32 : (u.pm >> 3);
        const int prow = isc ? (u.pm - ctx_tile0) : u.pm;
        const float* base = isc ? bc : bx; float* out = isc ? oc : ox;
        const int col0 = u.pn * BM + wc * 32 + 8 * fq;
        const size_t htile0 = (size_t)((u.pm * 16 + wr * 4) * 32 + u.pn * 8 + wc) * 512 + fr * 32 + 8 * fq;
        f32x4 gv[2][2], G[2][2]; float ssv[2][4];
#pragma unroll
        for (int bj = 0; bj < 2; ++bj)
#pragma unroll
            for (int n = 0; n < 2; ++n) { const int c = col0 + bj * HALF + 4 * n; gv[bj][n] = *(const f32x4*)(gate + (size_t)mrow * NMOD + c) * (0.5f * COEF2);
                if (NORM) G[bj][n] = *(const f32x4*)(nw + c) * (*(const f32x4*)(nscale + (size_t)mrow * NMOD + c) + 1.f); }
#pragma unroll
        for (int ai = 0; ai < 2; ++ai)
#pragma unroll
            for (int m = 0; m < 4; ++m) {
                const int rl = ai * HALF + wr * 64 + m * 16 + fr;
                const size_t off = (size_t)(prow * BM + rl) * DM + col0;
                const size_t hrow = (size_t)u.pm * BM + rl;
                float ss = 0.f;
#pragma unroll
                for (int bj = 0; bj < 2; ++bj) {
                    const f32x4 o0 = *(const f32x4*)(base + off + bj * HALF) + gv[bj][0] * acc[ai][bj][m][0];
                    const f32x4 o1 = *(const f32x4*)(base + off + bj * HALF + 4) + gv[bj][1] * acc[ai][bj][m][1];
                    if (!isc) { *(f32x4*)(out + off + bj * HALF) = o0; *(f32x4*)(out + off + bj * HALF + 4) = o1; }
                    if (NORM) {
                        ss += (o0[0] * o0[0] + o0[1] * o0[1]) + (o0[2] * o0[2] + o0[3] * o0[3]) + (o1[0] * o1[0] + o1[1] * o1[1]) + (o1[2] * o1[2] + o1[3] * o1[3]);
                        const f32x4 h0 = o0 * G[bj][0], h1 = o1 * G[bj][1];
                        u32x4 w; w.x = pk2(h0[0], h0[1]); w.y = pk2(h0[2], h0[3]); w.z = pk2(h1[0], h1[1]); w.w = pk2(h1[2], h1[3]);
                        if (HTILED) *(u32x4*)(Hn + htile0 + (size_t)((ai * 8 + m) * 32 + bj * 4) * 512) = w;
                        else *(u32x4*)(Hn + hrow * DM + col0 + bj * HALF) = w;
                    }
                }
                if (NORM) { ss += __shfl_xor(ss, 16); ss += __shfl_xor(ss, 32); ssv[ai][m] = ss; }
            }
        if (NORM) {
            asm volatile("" ::: "memory");
#pragma unroll
            for (int ai = 0; ai < 2; ++ai)
#pragma unroll
                for (int m = 0; m < 4; ++m)
                    if (fq == 0) __hip_atomic_fetch_add(SS + (size_t)u.pm * BM + ai * HALF + wr * 64 + m * 16 + fr, ssv[ai][m], __ATOMIC_RELAXED, __HIP_MEMORY_SCOPE_AGENT);
        }
    }
};
struct EpiBf16S {
    static constexpr bool PERM = true;
    bf16_t* O; int ldc; const float* SSr; float inv_r; const float* SSc; float inv_c; const float* cb; int ldcb; int mrow_fixed; float* st0; float* st1; int pn_off;
    __device__ __forceinline__ void operator()(const f32x4 (&acc)[2][2][4][2], const Unit& u, int wr, int wc, int fr, int fq) const {
        const int row0 = u.pm * BM + wr * 64 + fr, col0 = u.pn * BM + wc * 32 + 8 * fq;
        const int mrow = mrow_fixed >= 0 ? mrow_fixed : (u.pm >> 3);
        const int gp = u.pn + pn_off;
        float* sp = (gp == 0) ? st0 : ((gp == 1) ? st1 : nullptr);
        f32x4 cv[2][2], bv[2][2];
#pragma unroll
        for (int bj = 0; bj < 2; ++bj)
#pragma unroll
            for (int n = 0; n < 2; ++n) {
                if (SSc) { const f32x4 s = *(const f32x4*)(SSc + col0 + bj * HALF + 4 * n); cv[bj][n] = (f32x4){rsqrtf(s[0] * inv_c + EPS), rsqrtf(s[1] * inv_c + EPS), rsqrtf(s[2] * inv_c + EPS), rsqrtf(s[3] * inv_c + EPS)}; }
                else cv[bj][n] = (f32x4){1.f, 1.f, 1.f, 1.f};
                bv[bj][n] = cb ? *(const f32x4*)(cb + (size_t)mrow * ldcb + col0 + bj * HALF + 4 * n) : (f32x4){0.f, 0.f, 0.f, 0.f}; }
#pragma unroll
        for (int ai = 0; ai < 2; ++ai)
#pragma unroll
            for (int m = 0; m < 4; ++m) {
                const int row = row0 + ai * HALF + m * 16;
                const float r = SSr ? rsqrtf(SSr[row] * inv_r + EPS) : 1.f;
                bf16_t* rowp = O + (size_t)row * ldc + col0;
                float ss = 0.f;
#pragma unroll
                for (int bj = 0; bj < 2; ++bj) {
                    const f32x4 v0 = acc[ai][bj][m][0] * cv[bj][0] * r + bv[bj][0], v1 = acc[ai][bj][m][1] * cv[bj][1] * r + bv[bj][1];
                    u32x4 w; w.x = pk2(v0[0], v0[1]); w.y = pk2(v0[2], v0[3]); w.z = pk2(v1[0], v1[1]); w.w = pk2(v1[2], v1[3]);
                    *(u32x4*)(rowp + bj * HALF) = w;
                    if (sp && (bj == 0 || gp == 0)) ss += (v0[0] * v0[0] + v0[1] * v0[1]) + (v0[2] * v0[2] + v0[3] * v0[3]) + (v1[0] * v1[0] + v1[1] * v1[1]) + (v1[2] * v1[2] + v1[3] * v1[3]);
                }
                if (sp) { ss += __shfl_xor(ss, 16); ss += __shfl_xor(ss, 32);
                    if (fq == 0) __hip_atomic_fetch_add(sp + row, ss, __ATOMIC_RELAXED, __HIP_MEMORY_SCOPE_AGENT); }
            }
    }
};

template <class Epi, class Sched, bool TILEDA = false>
__device__ __forceinline__ void gemm_phase(LAS unsigned char* lds, const Gemm g, const Sched& S, const Epi& E) {
    const int tid = threadIdx.x, wid = __builtin_amdgcn_readfirstlane(tid >> 6), lane = tid & 63, wr = wid >> 2, wc = wid & 3, fr = lane & 15, fq = lane >> 4;
    const int K = g.K, nt = K / BK;
    unsigned voffA[2], voffB[2];
#pragma unroll
    for (int i = 0; i < 2; ++i) { int R, C; stage_rc(tid * 16 + i * 8192, R, C); const int Rb = Epi::PERM ? ((R & ~31) + perm32(R & 31)) : R;
        voffA[i] = TILEDA ? (unsigned)(((R >> 4) * (g.lda >> 5) + (C >> 5)) * 1024 + (R & 15) * 64 + (C & 31) * 2) : (unsigned)(R * g.lda + C) * 2u;
        voffB[i] = (unsigned)(Rb * g.ldb + C) * 2u; }
    const size_t kstep = (size_t)(BK * 2), kstepA = TILEDA ? (size_t)2048 : kstep;
    const size_t hA = TILEDA ? (size_t)(HALF / 16) * (g.lda >> 5) * 1024 : (size_t)HALF * g.lda * 2, hB = (size_t)HALF * g.ldb * 2;
    const size_t tA = 2 * hA, tB = 2 * hB;
    const unsigned ldsw = (unsigned)wid * 1024u;
    const int aoff = lds_byte(wr * 64 + fr, fq * 8), boff = lds_byte(wc * 32 + fr, fq * 8);
#define PG8_SA(b, h) (((b) * 2 + (h)) * HTB)
#define PG8_SB(b, h) ((4 + (b) * 2 + (h)) * HTB)
#define PG8_STAGE(bufoff, gbase, voff) do { _Pragma("unroll") for (int _i = 0; _i < 2; ++_i) \
        __builtin_amdgcn_global_load_lds((const unsigned*)((const char*)(gbase) + (voff)[_i]), (LAS unsigned*)(lds + (bufoff) + ldsw + _i * 8192), 16, 0, 0); } while (0)
#define PG8_LDA(dst, b, h) do { _Pragma("unroll") for (int m = 0; m < 4; ++m) _Pragma("unroll") for (int k = 0; k < 2; ++k) dst[m][k] = *(const LAS bf16x8*)(lds + PG8_SA(b, h) + aoff + m * 2048 + k * 1024); } while (0)
#define PG8_LDB(dst, b, h) do { _Pragma("unroll") for (int n = 0; n < 2; ++n) _Pragma("unroll") for (int k = 0; k < 2; ++k) dst[n][k] = *(const LAS bf16x8*)(lds + PG8_SB(b, h) + boff + n * 2048 + k * 1024); } while (0)
#define PG8_MMA(ai, bj, At, Bt) do { __builtin_amdgcn_s_setprio(1); _Pragma("unroll") for (int m = 0; m < 4; ++m) _Pragma("unroll") for (int n = 0; n < 2; ++n) _Pragma("unroll") for (int k = 0; k < 2; ++k) \
        acc[ai][bj][m][n] = __builtin_amdgcn_mfma_f32_16x16x32_bf16(Bt[n][k], At[m][k], acc[ai][bj][m][n], 0, 0, 0); __builtin_amdgcn_s_setprio(0); } while (0)
#define PG8_WAIT_V(n) asm volatile("s_waitcnt vmcnt(" #n ")" ::: "memory")
#define PG8_WAIT_L(n) asm volatile("s_waitcnt lgkmcnt(" #n ")" ::: "memory")
#define PG8_BAR __builtin_amdgcn_s_barrier()
#define PG8_SCHED __builtin_amdgcn_sched_barrier(0)
    Unit cur, nxt; int ui = 0;
    if (!S.next(0, cur)) return;
    f32x4 acc[2][2][4][2];
#pragma unroll
    for (int a = 0; a < 2; ++a)
#pragma unroll
        for (int b = 0; b < 2; ++b)
#pragma unroll
            for (int m = 0; m < 4; ++m)
#pragma unroll
                for (int n = 0; n < 2; ++n) acc[a][b][m][n] = (f32x4){0.f, 0.f, 0.f, 0.f};
    bf16x8 At[4][2], B0[2][2], B1[2][2];
    const char* cA = (const char*)g.A + (size_t)cur.pm * tA; const char* cB = (const char*)g.Bt + (size_t)cur.pn * tB;
    PG8_STAGE(PG8_SB(0, 0), cB, voffB); PG8_STAGE(PG8_SB(0, 1), cB + hB, voffB); PG8_STAGE(PG8_SA(0, 0), cA, voffA); PG8_STAGE(PG8_SA(0, 1), cA + hA, voffA);
    if (wr == 1) PG8_BAR;
    PG8_WAIT_V(2); PG8_BAR;
    PG8_STAGE(PG8_SB(1, 0), cB + kstep, voffB); PG8_STAGE(PG8_SA(1, 0), cA + kstepA, voffA); PG8_STAGE(PG8_SB(1, 1), cB + hB + kstep, voffB);
    PG8_WAIT_V(6); PG8_BAR;
    for (;;) {
        const bool has_next = S.next(ui + 1, nxt);
        const char* nA = has_next ? (const char*)g.A + (size_t)nxt.pm * tA : cA; const char* nB = has_next ? (const char*)g.Bt + (size_t)nxt.pn * tB : cB;
        for (int t = 0; t < nt; t += 2) {
            const bool last = (t == nt - 2);
            const char* a1 = cA + (size_t)(t + 1) * kstepA;
            const char* a2 = last ? nA : cA + (size_t)(t + 2) * kstepA; const char* b2 = last ? nB : cB + (size_t)(t + 2) * kstep;
            const char* a3 = a2 + kstepA; const char* b3 = b2 + kstep;
            PG8_LDB(B0, 0, 0); PG8_LDB(B1, 0, 1); PG8_SCHED; PG8_LDA(At, 0, 0); PG8_STAGE(PG8_SA(1, 1), a1 + hA, voffA);
            PG8_WAIT_V(8); PG8_WAIT_L(0); PG8_BAR; PG8_MMA(0, 0, At, B0); PG8_MMA(0, 1, At, B1); PG8_BAR; PG8_SCHED;
            PG8_LDA(At, 0, 1); PG8_STAGE(PG8_SB(0, 0), b2, voffB); PG8_STAGE(PG8_SB(0, 1), b2 + hB, voffB); PG8_STAGE(PG8_SA(0, 0), a2, voffA);
            PG8_WAIT_V(8); PG8_WAIT_L(0); PG8_BAR; PG8_MMA(1, 0, At, B0); PG8_MMA(1, 1, At, B1); PG8_BAR; PG8_SCHED;
            PG8_LDB(B0, 1, 0); PG8_LDB(B1, 1, 1); PG8_SCHED; PG8_LDA(At, 1, 0); PG8_STAGE(PG8_SA(0, 1), a2 + hA, voffA);
            PG8_WAIT_V(8); PG8_WAIT_L(0); PG8_BAR; PG8_MMA(0, 0, At, B0); PG8_MMA(0, 1, At, B1); PG8_BAR; PG8_SCHED;
            PG8_LDA(At, 1, 1); PG8_STAGE(PG8_SB(1, 0), b3, voffB); PG8_STAGE(PG8_SB(1, 1), b3 + hB, voffB); PG8_STAGE(PG8_SA(1, 0), a3, voffA);
            PG8_WAIT_V(8); PG8_WAIT_L(0); PG8_BAR; PG8_MMA(1, 0, At, B0); PG8_MMA(1, 1, At, B1); PG8_BAR; PG8_SCHED;
        }
        if (wr == 0) PG8_BAR;
        E(acc, cur, wr, wc, fr, fq);
        if (!has_next) break;
#pragma unroll
        for (int a = 0; a < 2; ++a)
#pragma unroll
            for (int b = 0; b < 2; ++b)
#pragma unroll
                for (int m = 0; m < 4; ++m)
#pragma unroll
                    for (int n = 0; n < 2; ++n) acc[a][b][m][n] = (f32x4){0.f, 0.f, 0.f, 0.f};
        cur = nxt; cA = nA; cB = nB; ++ui;
        if (wr == 1) PG8_BAR;
    }
    PG8_WAIT_V(0);
    PG8_BAR;
#undef PG8_SA
#undef PG8_SB
#undef PG8_STAGE
#undef PG8_LDA
#undef PG8_LDB
#undef PG8_MMA
#undef PG8_WAIT_V
#undef PG8_WAIT_L
#undef PG8_BAR
#undef PG8_SCHED
}
}

struct Params {
    const float *x, *c, *ctx, *cctx, *w_ada, *b_ada, *norm1, *f1w1, *f1w3, *f1w2, *norm2, *w_in, *qan, *w_uq, *kvan, *w_ukv, *qn, *kn, *vn, *w_s, *b_s, *w_out, *norm3, *f2w1, *f2w3, *f2w2;
    float* out; unsigned char* ws; int ph_lo, ph_hi;
};

__device__ __forceinline__ void tr_item(const float* W, int N, int k0, int n0, bf16_t* dst, int ldd, const float* kscale, float* scr, int lane) {
#pragma unroll 8
    for (int i = 0; i < 32; ++i) { const int kk = 2 * i + (lane >> 5); float v = W[(size_t)(k0 + kk) * N + n0 + (lane & 31)]; if (kscale) v *= kscale[k0 + kk]; scr[kk * 33 + (lane & 31)] = v; }
    LDS_WAIT();
    const int c = lane & 7;
#pragma unroll
    for (int j = 0; j < 4; ++j) { const int n = (lane >> 3) + 8 * j; const float* s = scr + (8 * c) * 33 + n;
        u32x4 o; o.x = pk2(s[0 * 33], s[1 * 33]); o.y = pk2(s[2 * 33], s[3 * 33]); o.z = pk2(s[4 * 33], s[5 * 33]); o.w = pk2(s[6 * 33], s[7 * 33]);
        *(u32x4*)(dst + (size_t)n * ldd + 8 * c) = o; }
    LDS_WAIT();
}
__device__ __forceinline__ int win_row(int n) {
    if (n < 128) return 256 + n;
    if (n < 160) return 384 + (n - 128);
    if (n < 416) return n - 160;
    if (n < 928) return 512 + (n - 416);
    return 1024 + (n - 928);
}
template <bool SILU>
__device__ __forceinline__ void rowmat_item(const float* in, int istr, const float* in32, const float* W, int N, int j, const float* bias, float* out, int ldo, int cmap, float* lds, int tid) {
    const int wave = tid >> 6, lane = tid & 63, col = 64 * j + lane; const bool cok = col < N; const int colc = cok ? col : N - 1;
    float acc[33];
#pragma unroll
    for (int r = 0; r < 33; ++r) acc[r] = 0.f;
    for (int pass = 0; pass < 2; ++pass) {
        __syncthreads();
        {
            float cvv[33];
#pragma unroll
            for (int r = 0; r < 33; ++r) cvv[r] = (r < 32) ? in[(size_t)r * istr + 512 * pass + tid] : in32[512 * pass + tid];
#pragma unroll
            for (int r = 0; r < 33; ++r) lds[r * 512 + tid] = SILU ? cvv[r] / (1.f + __expf(-cvv[r])) : cvv[r];
        }
        __syncthreads();
        const int kb = 512 * pass + 64 * wave;
        const float* Wc = W + (size_t)kb * N + colc;
        float w0 = Wc[0], w1 = Wc[(size_t)N], w2 = Wc[(size_t)2 * N], w3 = Wc[(size_t)3 * N];
        float x0 = Wc[(size_t)4 * N], x1 = Wc[(size_t)5 * N], x2 = Wc[(size_t)6 * N], x3 = Wc[(size_t)7 * N];
        for (int k4 = 0; k4 < 16; ++k4) {
            const int kn = (k4 + 2 < 16) ? 4 * (k4 + 2) : 0;
            const float y0 = Wc[(size_t)(kn + 0) * N], y1 = Wc[(size_t)(kn + 1) * N], y2 = Wc[(size_t)(kn + 2) * N], y3 = Wc[(size_t)(kn + 3) * N];
#pragma unroll
            for (int r = 0; r < 33; ++r) { const f32x4 s = *(const f32x4*)(lds + r * 512 + 64 * wave + 4 * k4); acc[r] += s[0] * w0 + s[1] * w1 + s[2] * w2 + s[3] * w3; }
            w0 = x0; w1 = x1; w2 = x2; w3 = x3; x0 = y0; x1 = y1; x2 = y2; x3 = y3;
        }
    }
    __syncthreads();
#pragma unroll
    for (int r = 0; r < 33; ++r) lds[(wave * 33 + r) * 64 + lane] = acc[r];
    __syncthreads();
    for (int idx = tid; idx < 33 * 64; idx += 512) { const int r = idx >> 6, l = idx & 63, c = 64 * j + l; float s = 0.f;
#pragma unroll
        for (int w = 0; w < 8; ++w) s += lds[(w * 33 + r) * 64 + l];
        if (c < N) { const int oc = cmap == 0 ? c : cmap == 1 ? win_row(c) : (256 * (c >> 7) + (c & 127) + (cmap == 3 ? 128 : 0));
            out[(size_t)r * ldo + oc] = s + (bias ? bias[c] : 0.f); } }
    __syncthreads();
}
constexpr int I_UP = 16 * 88, I_DN = 44 * 32, I_IN = 16 * 45, I_UQ = 4 * 24, I_UKV = 2 * 32, I_OUT = 16 * 32;
constexpr int NITEMS = 4 * I_UP + 2 * I_DN + I_IN + I_UQ + I_UKV + I_OUT;
__device__ __forceinline__ void tr_dispatch(const Params& p, int it, float* scr, int lane) {
    unsigned char* ws = p.ws;
    int r = it;
    if (r < 4 * I_UP) { const int which = r / I_UP; r -= which * I_UP; const int kb = r / 88, nb = r % 88, k0 = 64 * kb, n0 = 32 * nb;
        const float* W = which == 0 ? p.f1w1 : which == 1 ? p.f1w3 : which == 2 ? p.f2w1 : p.f2w3;
        bf16_t* D = (bf16_t*)(ws + (which < 2 ? WS_W13A : WS_W13B));
        const int row = 256 * (n0 >> 7) + (n0 & 127) + ((which & 1) ? 128 : 0);
        tr_item(W, DFF, k0, n0, D + (size_t)row * DM + k0, DM, nullptr, scr, lane); return; }
    r -= 4 * I_UP;
    if (r < 2 * I_DN) { const int which = r / I_DN; r -= which * I_DN; const int kb = r / 32, nb = r % 32, k0 = 64 * kb, n0 = 32 * nb;
        tr_item(which ? p.f2w2 : p.f1w2, DM, k0, n0, (bf16_t*)(ws + (which ? WS_W2B : WS_W2A)) + (size_t)n0 * DFF + k0, DFF, nullptr, scr, lane); return; }
    r -= 2 * I_DN;
    if (r < I_IN) { const int kb = r / 45, nb = r % 45, k0 = 64 * kb, n0 = 32 * nb;
        tr_item(p.w_in, 1440, k0, n0, (bf16_t*)(ws + WS_WIN) + (size_t)win_row(n0) * DM + k0, DM, nullptr, scr, lane); return; }
    r -= I_IN;
    if (r < I_UQ) { const int kb = r / 24, nb = r % 24, k0 = 64 * kb, n0 = 32 * nb;
        tr_item(p.w_uq, 768, k0, n0, (bf16_t*)(ws + WS_WUQ) + (size_t)n0 * 256 + k0, 256, p.qan, scr, lane); return; }
    r -= I_UQ;
    if (r < I_UKV) { const int kb = r / 32, nb = r % 32, k0 = 64 * kb, n0 = 32 * nb; const int h = n0 >> 7, j = n0 & 127;
        bf16_t* D = (j < 64) ? (bf16_t*)(ws + WS_WK) + (size_t)(h * 64 + j) * 256 : (bf16_t*)(ws + WS_WV) + (size_t)(h * 64 + j - 64) * 256;
        tr_item(p.w_ukv, 1024, k0, n0, D + k0, 256, p.kvan, scr, lane); return; }
    r -= I_UKV;
    { const int kb = r / 32, nb = r % 32, k0 = 64 * kb, n0 = 32 * nb;
        tr_item(p.w_out, DM, k0, n0, (bf16_t*)(ws + WS_WOUT) + (size_t)n0 * DM + k0, DM, nullptr, scr, lane); }
}
__device__ __forceinline__ void tr_set(const Params& p, int set, int widx, int nw, float* scr, int lane, int j0 = 0, int j1 = 1 << 30) {
    const int nall = set == 1 ? (I_IN + I_UQ + I_UKV + I_OUT) : (2 * I_UP + I_DN); const int n = j1 < nall ? j1 : nall;
    for (int j = j0 + widx; j < n; j += nw) {
        const int it = set == 0 ? (j < 2 * I_UP ? j : 4 * I_UP + (j - 2 * I_UP))
                     : set == 1 ? (4 * I_UP + 2 * I_DN + j)
                     : (j < 2 * I_UP ? 2 * I_UP + j : 4 * I_UP + I_DN + (j - 2 * I_UP));
        tr_dispatch(p, it, scr, lane);
    }
}
__device__ __forceinline__ void phase0(const Params& p, float* lds) {
    unsigned char* ws = p.ws;
    const int tid = threadIdx.x, lane = tid & 63, wave = tid >> 6, G = gridDim.x;
    float* MOD = (float*)(ws + WS_MOD);
    if ((int)blockIdx.x < 144) rowmat_item<true>(p.c, DM, p.cctx, p.w_ada, NMOD, blockIdx.x, p.b_ada, MOD, NMOD, 0, lds, tid);
    {
        const int gt = blockIdx.x * 512 + tid, NT = G * 512;
        { f32x4* zs = (f32x4*)(ws + WS_SWIN); for (int i = gt; i < 33 * NPROJ / 4; i += NT) zs[i] = (f32x4){0.f, 0.f, 0.f, 0.f}; }
        { f32x4* zs = (f32x4*)(ws + WS_SS2); for (int i = gt; i < MT / 4; i += NT) zs[i] = (f32x4){0.f, 0.f, 0.f, 0.f}; }
        { f32x4* zs = (f32x4*)(ws + WS_RSQ); for (int i = gt; i < MX / 4; i += NT) zs[i] = (f32x4){0.f, 0.f, 0.f, 0.f}; }
        { f32x4* zs = (f32x4*)(ws + WS_RSKV); for (int i = gt; i < MT / 4; i += NT) zs[i] = (f32x4){0.f, 0.f, 0.f, 0.f}; }
        { f32x4* zs = (f32x4*)(ws + WS_SS3); for (int i = gt; i < MX / 4; i += NT) zs[i] = (f32x4){0.f, 0.f, 0.f, 0.f}; }
        u32x4* z0 = (u32x4*)((bf16_t*)(ws + WS_WIN) + (size_t)416 * 1024);
        for (int i = gt; i < 96 * 1024 / 8; i += NT) z0[i] = (u32x4){0u, 0u, 0u, 0u};
        for (int i = gt; i < 8 * 128 * 128 / 8; i += NT) { const f32x4 a = *(const f32x4*)(p.w_s + (size_t)i * 8), b = *(const f32x4*)(p.w_s + (size_t)i * 8 + 4);
            u32x4 o; o.x = pk2(a[0], a[1]); o.y = pk2(a[2], a[3]); o.z = pk2(b[0], b[1]); o.w = pk2(b[2], b[3]); *(u32x4*)((bf16_t*)(ws + WS_WS) + (size_t)i * 8) = o; }
    }
    if (G > 144) { if ((int)blockIdx.x >= 144) tr_set(p, 0, ((int)blockIdx.x - 144) * 8 + wave, (G - 144) * 8, lds + wave * 4096, lane, 1152);
                   else tr_set(p, 0, (int)blockIdx.x * 8 + wave, 1152, lds + wave * 4096, lane, 0, 1152); }
    else tr_set(p, 0, blockIdx.x * 8 + wave, G * 8, lds + wave * 4096, lane);
    __syncthreads();
}

__device__ __forceinline__ void norm_mod_phase(const float* srcx, const float* srcc, int nrows, const float* w, const float* MOD, int ishift, bf16_t* H) {
    const int tid = threadIdx.x, lane = tid & 63, wave = tid >> 6;
    const int gw = blockIdx.x * 8 + wave, NGW = gridDim.x * 8, nch = nrows / 8;
    for (int ch = gw; ch < nch; ch += NGW) {
        const int row0 = ch * 8; const bool isc = row0 >= MX; const int mrow = isc ? 32 : (row0 >> 11);
        const float* src = isc ? srcc + (size_t)(row0 - MX) * DM : srcx + (size_t)row0 * DM;
        const float* sh = MOD + (size_t)mrow * NMOD + ishift * DM; const float* sc = sh + DM;
        f32x4 g[4], s[4];
#pragma unroll
        for (int j = 0; j < 4; ++j) { const int c = 4 * lane + 256 * j; const f32x4 wv = *(const f32x4*)(w + c), scv = *(const f32x4*)(sc + c); g[j] = wv * (scv + 1.f); s[j] = *(const f32x4*)(sh + c); }
        f32x4 nx[4];
#pragma unroll
        for (int j = 0; j < 4; ++j) nx[j] = ((const f32x4*)src + lane)[64 * j];
        for (int rr = 0; rr < 8; ++rr) {
            f32x4 v[4]; float ss = 0.f;
#pragma unroll
            for (int j = 0; j < 4; ++j) v[j] = nx[j];
            if (rr < 7) { const f32x4* xr = (const f32x4*)(src + (size_t)(rr + 1) * DM) + lane;
#pragma unroll
                for (int j = 0; j < 4; ++j) nx[j] = xr[64 * j]; }
#pragma unroll
            for (int j = 0; j < 4; ++j) ss += (v[j][0] * v[j][0] + v[j][1] * v[j][1]) + (v[j][2] * v[j][2] + v[j][3] * v[j][3]);
            const float rstd = rsqrtf(wave_sum(ss) * (1.f / DM) + EPS);
            u32x2* o = (u32x2*)(H + (size_t)(row0 + rr) * DM) + lane;
#pragma unroll
            for (int j = 0; j < 4; ++j) { const f32x4 y = v[j] * rstd * g[j] + s[j]; u32x2 ov; ov.x = pk2(y[0], y[1]); ov.y = pk2(y[2], y[3]); o[64 * j] = ov; }
        }
    }
}

__device__ __forceinline__ void rstd_phase(const bf16_t* PROJ, float* RSQ, float* RSKV) {
    const int tid = threadIdx.x, lane = tid & 63, wave = tid >> 6;
    const int gw = blockIdx.x * 8 + wave, NGW = gridDim.x * 8;
    for (int r4 = gw; r4 < MT / 4; r4 += NGW) {
        unsigned kv[4]; u32x2 q[4];
#pragma unroll
        for (int i = 0; i < 4; ++i) { const int row = 4 * r4 + i; const bf16_t* pr = PROJ + (size_t)row * NPROJ;
            kv[i] = *((const unsigned*)(pr + 256) + lane); q[i] = (row < MX) ? *((const u32x2*)pr + lane) : (u32x2){0u, 0u}; }
#pragma unroll
        for (int i = 0; i < 4; ++i) { const int row = 4 * r4 + i;
            float s2 = bflo(kv[i]) * bflo(kv[i]) + bfhi(kv[i]) * bfhi(kv[i]);
            float s1 = (bflo(q[i].x) * bflo(q[i].x) + bfhi(q[i].x) * bfhi(q[i].x)) + (bflo(q[i].y) * bflo(q[i].y) + bfhi(q[i].y) * bfhi(q[i].y));
            s2 = wave_sum(s2); s1 = wave_sum(s1);
            if (lane == 0) { RSKV[row] = rsqrtf(s2 * (1.f / 128.f) + EPS); if (row < MX) RSQ[row] = rsqrtf(s1 * (1.f / 256.f) + EPS); } }
    }
}

__device__ __forceinline__ void gmlp_phase(const Params& p, unsigned char* lds) {
    unsigned char* ws = p.ws;
    const bf16_t* PROJ = (const bf16_t*)(ws + WS_PROJ); const bf16_t* WSb = (const bf16_t*)(ws + WS_WS); bf16_t* MIX = (bf16_t*)(ws + WS_MIX);
    const int tid = threadIdx.x, lane = tid & 63, wave = tid >> 6, r32 = lane & 31, hi = lane >> 5;
    bf16_t* Vt = (bf16_t*)lds;
    float* vnl = (float*)(lds + 32768); float* bsl = vnl + 512;
    { vnl[tid] = p.vn[tid]; bsl[tid] = p.b_s[tid]; bsl[tid + 512] = p.b_s[tid + 512]; }
    __syncthreads();
    const int pp = tid >> 2, cp = tid & 3;
    const int c0 = 32 * (wave >> 2), p0 = 32 * (wave & 3), pos = p0 + r32;
    u32x4 va, vb2;
    constexpr int NU = NB * 16 * 8;
    const bool bal = gridDim.x == 256;
    const int ubase = bal ? ((int)blockIdx.x < 64 ? (int)blockIdx.x * 13 : 832 + ((int)blockIdx.x - 64) * 17) : (int)blockIdx.x;
    const int ustep = bal ? 1 : (int)gridDim.x;
    const int uend = bal ? ubase + ((int)blockIdx.x < 64 ? 13 : 17) : NU;
    { const int unit = ubase; if (unit < uend) { const int g = unit & 7, n = (unit >> 3) & 15, b = unit >> 7;
        const bf16_t* src0 = PROJ + ((size_t)b * SEQ + n * 128 + pp) * NPROJ + 1024 + 64 * g + 16 * cp; va = *(const u32x4*)src0; vb2 = *(const u32x4*)(src0 + 8); } }
    for (int unit = ubase; unit < uend; unit += ustep) {
        const int g = unit & 7, n = (unit >> 3) & 15, b = unit >> 7;
        const size_t r0 = (size_t)b * SEQ + n * 128;
        bf16x8 wf[8];
        const bf16_t* wrow = WSb + ((size_t)g * 128 + pos) * 128 + 8 * hi;
#pragma unroll
        for (int s = 0; s < 8; ++s) wf[s] = *(const bf16x8*)(wrow + 16 * s);
        const bf16_t* urow = PROJ + (r0 + pos) * NPROJ + 512 + 64 * g + c0 + 4 * hi;
        u32x2 uu[4];
#pragma unroll
        for (int q = 0; q < 4; ++q) uu[q] = *(const u32x2*)(urow + 8 * q);
        const float bias = bsl[g * 128 + pos];
        f32x4 vw[4];
#pragma unroll
        for (int i = 0; i < 4; ++i) vw[i] = *(const f32x4*)(vnl + 64 * g + 16 * cp + 4 * i);
        {
            float v[16];
            v[0] = bflo(va.x); v[1] = bfhi(va.x); v[2] = bflo(va.y); v[3] = bfhi(va.y); v[4] = bflo(va.z); v[5] = bfhi(va.z); v[6] = bflo(va.w); v[7] = bfhi(va.w);
            v[8] = bflo(vb2.x); v[9] = bfhi(vb2.x); v[10] = bflo(vb2.y); v[11] = bfhi(vb2.y); v[12] = bflo(vb2.z); v[13] = bfhi(vb2.z); v[14] = bflo(vb2.w); v[15] = bfhi(vb2.w);
            float ss = 0.f;
#pragma unroll
            for (int i = 0; i < 16; ++i) { v[i] = gelu_f(v[i]); ss += v[i] * v[i]; }
            ss += __shfl_xor(ss, 1); ss += __shfl_xor(ss, 2);
            const float rstd = rsqrtf(ss * (1.f / 64.f) + EPS);
#pragma unroll
            for (int i = 0; i < 16; ++i) { const int c = 16 * cp + i; const float y = v[i] * rstd * vw[i >> 2][i & 3]; Vt[c * 136 + pp] = (bf16_t)(pk2(y, 0.f) & 0xffffu); }
        }
        {
            const int un = unit + ustep; if (un < uend) { const int g2 = un & 7, n2 = (un >> 3) & 15, b2 = un >> 7;
                const bf16_t* src0 = PROJ + ((size_t)b2 * SEQ + n2 * 128 + pp) * NPROJ + 1024 + 64 * g2 + 16 * cp; va = *(const u32x4*)src0; vb2 = *(const u32x4*)(src0 + 8); } }
        __syncthreads();
        {
            f32x16 acc = {};
            const bf16_t* vrow = Vt + (c0 + r32) * 136 + 8 * hi;
#pragma unroll
            for (int s = 0; s < 8; ++s) { const bf16x8 av = *(const bf16x8*)(vrow + 16 * s);
                acc = __builtin_amdgcn_mfma_f32_32x32x16_bf16(av, wf[s], acc, 0, 0, 0); }
            bf16_t* orow = MIX + (r0 + pos) * DM + 512 + 64 * g + c0 + 4 * hi;
#pragma unroll
            for (int q = 0; q < 4; ++q) {
                const float o0 = gelu_f(bflo(uu[q].x)) * (acc[4 * q + 0] + bias), o1 = gelu_f(bfhi(uu[q].x)) * (acc[4 * q + 1] + bias);
                const float o2 = gelu_f(bflo(uu[q].y)) * (acc[4 * q + 2] + bias), o3 = gelu_f(bfhi(uu[q].y)) * (acc[4 * q + 3] + bias);
                u32x2 ov; ov.x = pk2(o0, o1); ov.y = pk2(o2, o3); *(u32x2*)(orow + 8 * q) = ov; }
        }
        __syncthreads();
    }
}

__device__ __forceinline__ void unpack8(float* v, const u32x4 a) { v[0] = bflo(a.x); v[1] = bfhi(a.x); v[2] = bflo(a.y); v[3] = bfhi(a.y); v[4] = bflo(a.z); v[5] = bfhi(a.z); v[6] = bflo(a.w); v[7] = bfhi(a.w); }
__device__ __forceinline__ u32x4 pack8(const float* v) { u32x4 o; o.x = pk2(v[0], v[1]); o.y = pk2(v[2], v[3]); o.z = pk2(v[4], v[5]); o.w = pk2(v[6], v[7]); return o; }
__device__ __forceinline__ float rope_inv(int f) { return f == 0 ? 1.0f : f == 1 ? 0.316227766f : f == 2 ? 0.1f : f == 3 ? 0.0316227766f : f == 4 ? 0.01f : f == 5 ? 0.00316227766f : f == 6 ? 0.001f : 0.000316227766f; }
__device__ __forceinline__ void kprep_phase(const Params& p) {
    unsigned char* ws = p.ws;
    const bf16_t* KN = (const bf16_t*)(ws + WS_KNOPE); const bf16_t* PROJ = (const bf16_t*)(ws + WS_PROJ); bf16_t* KF = (bf16_t*)(ws + WS_KF);
    const int tid = threadIdx.x, lane = tid & 63, wave = tid >> 6, h = lane >> 3, j = lane & 7;
    const int gw = blockIdx.x * 8 + wave, NGW = gridDim.x * 8;
    float wn[8], wp[8];
#pragma unroll
    for (int i = 0; i < 8; ++i) { wn[i] = p.kn[8 * j + i]; wp[i] = p.kn[64 + 8 * (j & 3) + i]; }
    u32x4 na = {}, ne = {};
    if (gw < MT) { na = *(const u32x4*)(KN + (size_t)gw * 512 + h * 64 + 8 * j); ne = *(const u32x4*)(PROJ + (size_t)gw * NPROJ + 384 + 8 * (j & 3)); }
    for (int row = gw; row < MT; row += NGW) {
        float a[8], e[8];
        unpack8(a, na); unpack8(e, ne);
        { const int rn = row + NGW; if (rn < MT) { na = *(const u32x4*)(KN + (size_t)rn * 512 + h * 64 + 8 * j); ne = *(const u32x4*)(PROJ + (size_t)rn * NPROJ + 384 + 8 * (j & 3)); } }
        float ss = 0.f;
#pragma unroll
        for (int i = 0; i < 8; ++i) ss += a[i] * a[i];
        if (j < 4) {
#pragma unroll
            for (int i = 0; i < 8; ++i) ss += e[i] * e[i];
        }
        ss += __shfl_xor(ss, 1); ss += __shfl_xor(ss, 2); ss += __shfl_xor(ss, 4);
        const float rs = rsqrtf(ss * (1.f / 96.f) + EPS);
#pragma unroll
        for (int i = 0; i < 8; ++i) { a[i] *= rs * wn[i]; e[i] *= rs * wp[i]; }
        bf16_t* ko = KF + (size_t)row * 768 + h * 96;
        *(u32x4*)(ko + 8 * j) = pack8(a);
        const bool lat = row < MX; const int pos = row & (SEQ - 1);
        const float fpos = (float)(((j >> 1) & 1) ? (pos & 63) : (pos >> 6));
#pragma unroll
        for (int f = 0; f < 8; ++f) {
            const float partner = __shfl_xor(e[f], 1);
            float sn = 0.f, cs = 1.f;
            if (lat) { const float rev = (fpos * rope_inv(f)) * 0.15915494309189535f; sn = __builtin_amdgcn_sinf(rev); cs = __builtin_amdgcn_cosf(rev); }
            e[f] = e[f] * cs + ((j & 1) ? partner : -partner) * sn;
        }
        if (j < 4) *(u32x4*)(ko + 64 + 8 * j) = pack8(e);
    }
}

constexpr int KSTR = 208, VSTR = 144, KBUF = 64 * KSTR, VBUF = 64 * VSTR;
__device__ __forceinline__ float max3f(float a, float b, float c) { float r; asm("v_max3_f32 %0, %1, %2, %3" : "=v"(r) : "v"(a), "v"(b), "v"(c)); return r; }
__device__ __forceinline__ float swapmax(float m) { auto rr = __builtin_amdgcn_permlane32_swap(__float_as_uint(m), __float_as_uint(m), false, false); return fmaxf(__uint_as_float(rr[0]), __uint_as_float(rr[1])); }
__device__ __forceinline__ float swapadd(float m) { auto rr = __builtin_amdgcn_permlane32_swap(__float_as_uint(m), __float_as_uint(m), false, false); return __uint_as_float(rr[0]) + __uint_as_float(rr[1]); }
#define ASB() __builtin_amdgcn_sched_barrier(0)
struct AttStage { u32x4 k0, k1, v; };
struct AttCtx {
    const bf16_t* KF; const bf16_t* VT; unsigned char* Ks; unsigned char* Vs;
    int tid, b, h, kkey0, kpart0, kkey1, kpart1, vd, vpart, vdst, koff, voff;
};
__device__ __forceinline__ void att_load(const AttCtx& c, int t, AttStage& s) {
    const size_t kr = (t < 32) ? (size_t)c.b * SEQ + t * 64 : (size_t)MX + (size_t)c.b * CTXL + (t - 32) * 64;
    s.k0 = *(const u32x4*)(c.KF + (kr + c.kkey0) * 768 + c.h * 96 + 8 * c.kpart0);
    if (c.tid < 256) s.k1 = *(const u32x4*)(c.KF + (kr + c.kkey1) * 768 + c.h * 96 + 8 * c.kpart1);
    s.v = *(const u32x4*)(c.VT + (size_t)(c.h * 64 + c.vd) * MT + kr + 8 * c.vpart);
}
__device__ __forceinline__ void att_store(const AttCtx& c, int kbuf, int vbuf, const AttStage& s) {
    *(u32x4*)(c.Ks + kbuf * KBUF + c.kkey0 * KSTR + c.kpart0 * 16) = s.k0;
    if (c.tid < 256) *(u32x4*)(c.Ks + kbuf * KBUF + c.kkey1 * KSTR + c.kpart1 * 16) = s.k1;
    *(u32x2*)(c.Vs + vbuf * VBUF + c.vdst) = (u32x2){s.v.x, s.v.y}; *(u32x2*)(c.Vs + vbuf * VBUF + c.vdst + 16) = (u32x2){s.v.z, s.v.w};
}
#define LDK(s_, A, C) do { A = *(const bf16x8*)(kb + (s_) * 32); C = *(const bf16x8*)(kb + 32 * KSTR + (s_) * 32); } while (0)
#define LDV(s_, A, C) do { A = *(const bf16x8*)(vb + (s_) * 32); C = *(const bf16x8*)(vb + 32 * VSTR + (s_) * 32); } while (0)
#define MMA(Acc, A, B) Acc = __builtin_amdgcn_mfma_f32_32x32x16_bf16(A, B, Acc, 0, 0, 0)
#define EXP4(V, i) do { V[i] = fexp2(V[i]); V[i + 1] = fexp2(V[i + 1]); V[i + 2] = fexp2(V[i + 2]); V[i + 3] = fexp2(V[i + 3]); } while (0)
__device__ __forceinline__ void att_iter(const AttCtx& c, int t, int& vcur, const bf16x8 (&qf)[6], f32x16& s0, f32x16& s1, f32x16& o0, f32x16& o1, float& mref, float& lsum, AttStage& L, const AttStage& S) {
    const bool more = t < 36;
    if (t + 2 < 36) att_load(c, t + 2, L);
    const unsigned char* kb = c.Ks + (t & 1) * KBUF + c.koff;
    const unsigned char* vb = c.Vs + vcur * VBUF + c.voff;
    f32x16 n0 = {}, n1 = {};
    u32x4 pw0, pw1, pw2, pw3;
    bf16x8 ka0, kc0, ka1, kc1, va0, vc0, va1, vc1;
    LDK(0, ka0, kc0);
    ASB();
    LDK(1, ka1, kc1);
    if (more) MMA(n0, ka0, qf[0]);
    float ma = max3f(s0[0], s0[1], s0[2]); ma = max3f(ma, s0[3], s0[4]); ma = max3f(ma, s0[5], s0[6]); ma = max3f(ma, s0[7], s0[8]);
    ASB();
    if (more) MMA(n1, kc0, qf[0]);
    ma = max3f(ma, s0[9], s0[10]); ma = max3f(ma, s0[11], s0[12]); ma = max3f(ma, s0[13], s0[14]); ma = fmaxf(ma, s0[15]);
    ASB();
    LDK(2, ka0, kc0);
    if (more) MMA(n0, ka1, qf[1]);
    float mb = max3f(s1[0], s1[1], s1[2]); mb = max3f(mb, s1[3], s1[4]); mb = max3f(mb, s1[5], s1[6]); mb = max3f(mb, s1[7], s1[8]);
    ASB();
    if (more) MMA(n1, kc1, qf[1]);
    mb = max3f(mb, s1[9], s1[10]); mb = max3f(mb, s1[11], s1[12]); mb = max3f(mb, s1[13], s1[14]); mb = max3f(mb, s1[15], ma);
    const float mx = swapmax(mb);
    if (__any(mx > mref + 8.f)) {
        const float mn = fmaxf(mref, mx), alpha = fexp2(mref - mn); mref = mn; lsum *= alpha;
#pragma unroll
        for (int r = 0; r < 16; ++r) { o0[r] *= alpha; o1[r] *= alpha; }
    }
    ASB();
    LDK(3, ka1, kc1);
    if (more) MMA(n0, ka0, qf[2]);
    s0 = s0 - mref; EXP4(s0, 0);
    ASB();
    if (more) MMA(n1, kc0, qf[2]);
    EXP4(s0, 4);
    pw0 = (u32x4){pk2(s0[0], s0[1]), pk2(s0[2], s0[3]), pk2(s0[4], s0[5]), pk2(s0[6], s0[7])};
    ASB();
    LDK(4, ka0, kc0);
    if (more) MMA(n0, ka1, qf[3]);
    EXP4(s0, 8);
    ASB();
    if (more) MMA(n1, kc1, qf[3]);
    EXP4(s0, 12);
    pw1 = (u32x4){pk2(s0[8], s0[9]), pk2(s0[10], s0[11]), pk2(s0[12], s0[13]), pk2(s0[14], s0[15])};
    ASB();
    LDK(5, ka1, kc1);
    if (more) MMA(n0, ka0, qf[4]);
    s1 = s1 - mref; EXP4(s1, 0);
    ASB();
    if (more) MMA(n1, kc0, qf[4]);
    EXP4(s1, 4);
    pw2 = (u32x4){pk2(s1[0], s1[1]), pk2(s1[2], s1[3]), pk2(s1[4], s1[5]), pk2(s1[6], s1[7])};
    ASB();
    LDV(0, va0, vc0);
    if (more) MMA(n0, ka1, qf[5]);
    EXP4(s1, 8);
    ASB();
    if (more) MMA(n1, kc1, qf[5]);
    EXP4(s1, 12);
    pw3 = (u32x4){pk2(s1[8], s1[9]), pk2(s1[10], s1[11]), pk2(s1[12], s1[13]), pk2(s1[14], s1[15])};
    ASB();
    LDV(1, va1, vc1);
    MMA(o0, va0, __builtin_bit_cast(bf16x8, pw0)); MMA(o1, vc0, __builtin_bit_cast(bf16x8, pw0));
    { const f32x16 sv = s0 + s1; lsum += ((sv[0] + sv[1]) + (sv[2] + sv[3])) + ((sv[4] + sv[5]) + (sv[6] + sv[7])) + ((sv[8] + sv[9]) + (sv[10] + sv[11])) + ((sv[12] + sv[13]) + (sv[14] + sv[15])); }
    ASB();
    LDV(2, va0, vc0);
    MMA(o0, va1, __builtin_bit_cast(bf16x8, pw1)); MMA(o1, vc1, __builtin_bit_cast(bf16x8, pw1));
    ASB();
    LDV(3, va1, vc1);
    MMA(o0, va0, __builtin_bit_cast(bf16x8, pw2)); MMA(o1, vc0, __builtin_bit_cast(bf16x8, pw2));
    ASB();
    MMA(o0, va1, __builtin_bit_cast(bf16x8, pw3)); MMA(o1, vc1, __builtin_bit_cast(bf16x8, pw3));
    ASB();
    if (t + 1 < 36) { const int vn = (vcur == 0) ? 2 : vcur - 1; att_store(c, (t + 1) & 1, vn, S); }
    asm volatile("s_waitcnt lgkmcnt(0)" ::: "memory"); __builtin_amdgcn_s_barrier(); asm volatile("" ::: "memory");
    s0 = n0; s1 = n1; vcur = (vcur == 2) ? 0 : vcur + 1;
}
__device__ __forceinline__ void attn_phase(const Params& p, unsigned char* lds) {
    unsigned char* ws = p.ws;
    const bf16_t* Q = (const bf16_t*)(ws + WS_QRAW); bf16_t* MIX = (bf16_t*)(ws + WS_MIX);
    const int tid = threadIdx.x, lane = tid & 63, wave = tid >> 6, r32 = lane & 31, hi = lane >> 5;
    AttCtx c; c.KF = (const bf16_t*)(ws + WS_KF); c.VT = (const bf16_t*)(ws + WS_VT); c.Ks = lds; c.Vs = lds + 2 * KBUF; c.tid = tid;
    const int bx = blockIdx.x, G = gridDim.x;
    const int vcu = (G % 8 == 0) ? (bx % 8) * (G / 8) + bx / 8 : bx;
    c.kkey0 = tid / 12; c.kpart0 = tid % 12; c.kkey1 = (tid + 512) / 12; c.kpart1 = (tid + 512) % 12;
    c.vd = tid >> 3; c.vpart = tid & 7;
    c.vdst = c.vd * VSTR + (c.vpart >> 1) * 32 + (c.vpart & 1) * 8;
    c.koff = r32 * KSTR + hi * 16; c.voff = r32 * VSTR + hi * 16;
    float* qnl = (float*)(lds + 65536);
    if (tid < 96) qnl[tid] = p.qn[tid];
    __syncthreads();
    for (int unit = vcu; unit < NB * NH * 8; unit += G) {
        const int qb = unit & 7, h = (unit >> 3) & 7, b = unit >> 6;
        c.b = b; c.h = h;
        const size_t qrow = (size_t)b * SEQ + qb * 256 + wave * 32 + r32;
        bf16x8 qf[6];
        {
            float qv[6][8]; float ss = 0.f;
#pragma unroll
            for (int s = 0; s < 6; ++s) { unpack8(qv[s], *(const u32x4*)(Q + qrow * 768 + h * 96 + 16 * s + 8 * hi));
#pragma unroll
                for (int i = 0; i < 8; ++i) ss += qv[s][i] * qv[s][i]; }
            ss += __shfl_xor(ss, 32);
            const float rs = rsqrtf(ss * (1.f / 96.f) + EPS) * QSCALE;
#pragma unroll
            for (int s = 0; s < 6; ++s)
#pragma unroll
                for (int i = 0; i < 8; ++i) qv[s][i] *= rs * qnl[16 * s + 8 * hi + i];
            const int pos = (int)(qrow & (SEQ - 1));
#pragma unroll
            for (int s = 4; s < 6; ++s) { const float fpos = (float)(s == 4 ? (pos >> 6) : (pos & 63));
#pragma unroll
                for (int f = 0; f < 8; ++f) { const float partner = __shfl_xor(qv[s][f], 32);
                    const float rev = (fpos * rope_inv(f)) * 0.15915494309189535f; const float sn = __builtin_amdgcn_sinf(rev), cs = __builtin_amdgcn_cosf(rev);
                    qv[s][f] = qv[s][f] * cs + (hi ? partner : -partner) * sn; } }
#pragma unroll
            for (int s = 0; s < 6; ++s) qf[s] = __builtin_bit_cast(bf16x8, pack8(qv[s]));
        }
        float mref = -1e30f, lsum = 0.f; f32x16 o0 = {}, o1 = {};
        AttStage A, B; A.k1 = (u32x4){0u, 0u, 0u, 0u}; B.k1 = A.k1;
        att_load(c, 0, A); att_store(c, 0, 0, A);
        asm volatile("s_waitcnt lgkmcnt(0)" ::: "memory"); __builtin_amdgcn_s_barrier(); asm volatile("" ::: "memory");
        att_load(c, 1, A); att_load(c, 2, B);
        f32x16 s0 = {}, s1 = {};
        { const unsigned char* kb = c.Ks + c.koff; bf16x8 ka, kc;
#pragma unroll
          for (int s = 0; s < 6; ++s) { LDK(s, ka, kc); MMA(s0, ka, qf[s]); MMA(s1, kc, qf[s]); } }
        att_store(c, 1, 1, A);
        asm volatile("s_waitcnt lgkmcnt(0)" ::: "memory"); __builtin_amdgcn_s_barrier(); asm volatile("" ::: "memory");
        int vcur = 0;
        for (int t = 1; t <= 35; t += 2) {
            att_iter(c, t, vcur, qf, s0, s1, o0, o1, mref, lsum, A, B);
            att_iter(c, t + 1, vcur, qf, s0, s1, o0, o1, mref, lsum, B, A);
        }
        lsum = swapadd(lsum);
        const float il = 1.f / lsum;
        bf16_t* orow = MIX + qrow * DM + h * 64 + 4 * hi;
#pragma unroll
        for (int q = 0; q < 4; ++q) {
            u32x2 a; a.x = pk2(o0[4 * q] * il, o0[4 * q + 1] * il); a.y = pk2(o0[4 * q + 2] * il, o0[4 * q + 3] * il); *(u32x2*)(orow + 8 * q) = a;
            u32x2 cc; cc.x = pk2(o1[4 * q] * il, o1[4 * q + 1] * il); cc.y = pk2(o1[4 * q + 2] * il, o1[4 * q + 3] * il); *(u32x2*)(orow + 32 + 8 * q) = cc;
        }
    }
}
#undef LDK
#undef LDV
#undef MMA
#undef EXP4
#undef ASB

constexpr int NPHASE = 12;
__global__ void __launch_bounds__(512, 2) mega_fwd(Params p) {
    extern __shared__ __attribute__((aligned(16))) unsigned char lds[];
    LAS unsigned char* ldsl = (LAS unsigned char*)lds;
    unsigned char* ws = p.ws;
    const int G = gridDim.x, bx = blockIdx.x;
    float* MOD = (float*)(ws + WS_MOD);
    bf16_t* H = (bf16_t*)(ws + WS_H); bf16_t* ACT = (bf16_t*)(ws + WS_ACT); bf16_t* PROJ = (bf16_t*)(ws + WS_PROJ);
    float* X1C = (float*)(ws + WS_X1C); float* RSQ = (float*)(ws + WS_RSQ); float* RSKV = (float*)(ws + WS_RSKV);
    const int lo = p.ph_lo, hi = p.ph_hi;
#define IN(k) (lo <= (k) && (k) < hi)
#define SEAM(k) do { if (IN(k) && IN((k) + 1)) { cg::this_grid().sync(); } } while (0)
    using pg8::Gemm; using pg8::StaticOrder;

    if (IN(0)) { phase0(p, (float*)lds); } SEAM(0);
    if (IN(1)) { norm_mod_phase(p.x, p.ctx, MT, p.norm1, MOD, 0, H); } SEAM(1);
    if (IN(2)) { Gemm g{H, (const bf16_t*)(ws + WS_W13A), MT, 2 * DFF, DM, DM, DM}; StaticOrder S; S.init(MT, 2 * DFF, G, bx);
        pg8::EpiSwigluT<false> E{ACT, DFF, nullptr, nullptr}; pg8::gemm_phase(ldsl, g, S, E);
        { const int fi = S.nwg % G, np = fi ? G - fi : G, wi = fi ? bx - fi : bx; const int wave = threadIdx.x >> 6, lane = threadIdx.x & 63;
          if (wi >= 0) { tr_set(p, 1, wi * 8 + wave, np * 8, (float*)lds + wave * 4096, lane); } __syncthreads(); } } SEAM(2);
    if (IN(3)) { Gemm g{ACT, (const bf16_t*)(ws + WS_W2A), MT, DM, DFF, DFF, DFF}; StaticOrder S; S.init(MT, DM, G, bx);
        pg8::EpiRes<MX / 256, 1, true> E{p.x, p.ctx, p.out, X1C, MOD + 2 * DM, p.norm2, MOD + 4 * DM, H, (float*)(ws + WS_SS2)}; pg8::gemm_phase<pg8::EpiRes<MX / 256, 1, true>, StaticOrder, true>(ldsl, g, S, E);
        { const int fi = S.nwg % G, np = fi ? G - fi : G, wi = fi ? bx - fi : bx; const int tid = threadIdx.x, wave = tid >> 6, lane = tid & 63;
          if (wi >= 0) {
            for (int it = wi; it < 111; it += np) {
                if (it < 23) rowmat_item<false>(MOD + 3 * DM, NMOD, MOD + (size_t)32 * NMOD + 3 * DM, p.w_in, 1440, it, nullptr, (float*)(ws + WS_SWIN), NPROJ, 1, (float*)lds, tid);
                else if (it < 67) rowmat_item<false>(MOD + 6 * DM, NMOD, MOD + (size_t)32 * NMOD + 6 * DM, p.f2w1, DFF, it - 23, nullptr, (float*)(ws + WS_SW13), 2 * DFF, 2, (float*)lds, tid);
                else rowmat_item<false>(MOD + 6 * DM, NMOD, MOD + (size_t)32 * NMOD + 6 * DM, p.f2w3, DFF, it - 67, nullptr, (float*)(ws + WS_SW13), 2 * DFF, 3, (float*)lds, tid);
            }
            tr_set(p, 2, wi * 8 + wave, np * 8, (float*)lds + wave * 4096, lane); } __syncthreads(); } } SEAM(3);
    if (IN(4)) {
        { Gemm g{H, (const bf16_t*)(ws + WS_WIN), MX, NPROJ, DM, DM, DM}; StaticOrder S; S.init(MX, NPROJ, G, bx);
          pg8::EpiBf16S E{PROJ, NPROJ, (const float*)(ws + WS_SS2), 1.f / DM, nullptr, 0.f, (const float*)(ws + WS_SWIN), NPROJ, -1, RSQ, RSKV, 0}; pg8::gemm_phase(ldsl, g, S, E); }
        { Gemm g{H + (size_t)MX * DM, (const bf16_t*)(ws + WS_WIN) + (size_t)256 * DM, MC, 256, DM, DM, DM}; StaticOrder S; S.init(MC, 256, G, bx);
          pg8::EpiBf16S E{PROJ + (size_t)MX * NPROJ + 256, NPROJ, (const float*)(ws + WS_SS2) + MX, 1.f / DM, nullptr, 0.f, (const float*)(ws + WS_SWIN) + 256, NPROJ, 32, RSKV + MX, RSKV + MX, 1}; pg8::gemm_phase(ldsl, g, S, E); }
    } SEAM(4);
    if (IN(6)) {
        { Gemm g{PROJ, (const bf16_t*)(ws + WS_WUQ), MX, 768, 256, NPROJ, 256}; StaticOrder S; S.init(MX, 768, G, bx);
          pg8::EpiBf16S E{(bf16_t*)(ws + WS_QRAW), 768, RSQ, 1.f / 256.f, nullptr, 0.f, nullptr, 0, 0, nullptr, nullptr, 8}; pg8::gemm_phase(ldsl, g, S, E); }
        { int k128 = 128; asm volatile("" : "+s"(k128));     Gemm g{PROJ + 256, (const bf16_t*)(ws + WS_WK), MT, 512, k128, NPROJ, 256}; StaticOrder S; S.init(MT, 512, G, bx);
          pg8::EpiBf16S E{(bf16_t*)(ws + WS_KNOPE), 512, RSKV, 1.f / 128.f, nullptr, 0.f, nullptr, 0, 0, nullptr, nullptr, 8}; pg8::gemm_phase(ldsl, g, S, E); }
        { int k128 = 128; asm volatile("" : "+s"(k128)); Gemm g{(const bf16_t*)(ws + WS_WV), PROJ + 256, 512, MT, k128, 256, NPROJ}; StaticOrder S; S.init(512, MT, G, bx);
          pg8::EpiBf16S E{(bf16_t*)(ws + WS_VT), MT, nullptr, 0.f, RSKV, 1.f / 128.f, nullptr, 0, 0, nullptr, nullptr, 8}; pg8::gemm_phase(ldsl, g, S, E); }
        gmlp_phase(p, lds);
    } SEAM(6);
    if (IN(7)) { kprep_phase(p); } SEAM(7);
    if (IN(8)) { attn_phase(p, lds); } SEAM(8);
    if (IN(9)) { Gemm g{(const bf16_t*)(ws + WS_MIX), (const bf16_t*)(ws + WS_WOUT), MX, DM, DM, DM, DM}; StaticOrder S; S.init(MX, DM, G, bx);
        pg8::EpiRes<(1 << 30), 2, true, true> E{p.out, nullptr, p.out, nullptr, MOD + 5 * DM, p.norm3, MOD + 7 * DM, (bf16_t*)(ws + WS_H3), (float*)(ws + WS_SS3)}; pg8::gemm_phase(ldsl, g, S, E); } SEAM(9);
    if (IN(10)) { Gemm g{(const bf16_t*)(ws + WS_H3), (const bf16_t*)(ws + WS_W13B), MX, 2 * DFF, DM, DM, DM}; StaticOrder S; S.init(MX, 2 * DFF, G, bx);
        pg8::EpiSwigluT<true> E{ACT, DFF, (const float*)(ws + WS_SS3), (const float*)(ws + WS_SW13)}; pg8::gemm_phase<pg8::EpiSwigluT<true>, StaticOrder, true>(ldsl, g, S, E); } SEAM(10);
    if (IN(11)) { Gemm g{ACT, (const bf16_t*)(ws + WS_W2B), MX, DM, DFF, DFF, DFF}; StaticOrder S; S.init(MX, DM, G, bx);
        pg8::EpiRes<(1 << 30), 1, false> E{p.out, nullptr, p.out, nullptr, MOD + 8 * DM, nullptr, nullptr, nullptr, nullptr}; pg8::gemm_phase<pg8::EpiRes<(1 << 30), 1, false>, StaticOrder, true>(ldsl, g, S, E); }
#undef IN
#undef SEAM
}

extern "C" void kernel_launch(void* const* d_in, const int* in_sizes, int n_in, void* d_out, int out_size, void* d_ws, size_t ws_size, hipStream_t stream) {
    static int grid = 0;
    if (grid == 0) {
        if (n_in != 26 || in_sizes[0] != MX * DM || out_size != MX * DM || ws_size < WS_END) { fprintf(stderr, "kernel_launch: unexpected shapes (n_in %d, in0 %d, out %d, ws %zu)\n", n_in, n_in > 0 ? in_sizes[0] : -1, out_size, ws_size); grid = -1; return; }
        int dev = 0, cus = 0, per_cu = 0;
        if (hipGetDevice(&dev) != hipSuccess || hipDeviceGetAttribute(&cus, hipDeviceAttributeMultiprocessorCount, dev) != hipSuccess) { grid = -1; return; }
        if (hipFuncSetAttribute((const void*)mega_fwd, hipFuncAttributeMaxDynamicSharedMemorySize, LDS_BYTES) != hipSuccess) { fprintf(stderr, "kernel_launch: hipFuncSetAttribute failed\n"); grid = -1; return; }
        if (hipOccupancyMaxActiveBlocksPerMultiprocessor(&per_cu, (const void*)mega_fwd, 512, LDS_BYTES) != hipSuccess || per_cu < 1) { fprintf(stderr, "kernel_launch: occupancy query says %d\n", per_cu); per_cu = 1; }
        (void)hipGetLastError();
        grid = cus;
    }
    if (grid < 0) return;
    Params p{};
    const float** pp = (const float**)&p;
    for (int i = 0; i < 26; ++i) pp[i] = (const float*)d_in[i];
    p.out = (float*)d_out; p.ws = (unsigned char*)d_ws;
#if MK_ONE_LAUNCH
    p.ph_lo = 0; p.ph_hi = NPHASE;
    void* args[] = {&p};
    hipError_t e = hipLaunchCooperativeKernel((const void*)mega_fwd, dim3(grid), dim3(512), args, LDS_BYTES, stream);
    if (e != hipSuccess) fprintf(stderr, "cooperative launch failed: %s (grid %d)\n", hipGetErrorString(e), grid);
#else
    for (int ph = 0; ph < NPHASE; ++ph) {
        p.ph_lo = ph; p.ph_hi = ph + 1;
        hipLaunchKernelGGL(mega_fwd, dim3(grid), dim3(512), LDS_BYTES, stream, p);
    }
#endif
}
```
